# Optimizing an MI355X kernel written in HIP

```python
import math
import jax, jax.numpy as jnp
from jax import lax
import numpy as np

D_MODEL = 1024
BATCH = 8
SEQ = 4096
DEPTH = 1

HEAD_DIM = 64
ATTN_WIDTH = D_MODEL // 2
CONV_WIDTH = D_MODEL - ATTN_WIDTH
N_Q_HEADS = ATTN_WIDTH // HEAD_DIM
N_KV_HEADS = max(1, N_Q_HEADS // 4)
Q_PER_KV = N_Q_HEADS // N_KV_HEADS
KV_WIDTH = N_KV_HEADS * HEAD_DIM
IN_COLS = ATTN_WIDTH + 2 * KV_WIDTH + 2 * CONV_WIDTH
WINDOW = 128
ATTN_BLOCK = 128
CONV_KERNEL = 31

N_EXPERTS = 256
TOP_K = 8
N_EXPERT_GROUPS = 8
TOPK_EXPERT_GROUPS = 4
D_EXPERT = D_MODEL // 4
D_SHARED = D_EXPERT
ROUTED_SCALE = 2.5
MOE_BLOCK = 128

LN_EPS = 1e-5
DEEPNORM_ALPHA = (2.0 * DEPTH) ** 0.25
DEEPNORM_BETA = (8.0 * DEPTH) ** -0.25

kernel_name = "hybrid_swa_conformer_moe_deepnorm_adaln"


def layer_norm(x, g, b):
    xf = x.astype(jnp.float32)
    mu = jnp.mean(xf, axis=-1, keepdims=True)
    var = jnp.mean(jnp.square(xf - mu), axis=-1, keepdims=True)
    y = (xf - mu) * lax.rsqrt(var + LN_EPS) * g.astype(jnp.float32) + b.astype(jnp.float32)
    return y.astype(x.dtype)


def alibi_slopes(n_heads):
    return jnp.asarray([2.0 ** (-8.0 * (i + 1) / n_heads) for i in range(n_heads)], dtype=jnp.float32)


def sliding_window_attention(q, k, v, sinks):
    B, S = q.shape[0], q.shape[1]
    nb = S // ATTN_BLOCK
    qb = q.reshape(B, nb, ATTN_BLOCK, N_KV_HEADS, Q_PER_KV, HEAD_DIM)

    def band(t):
        tp = jnp.pad(t, ((0, 0), (ATTN_BLOCK, 0), (0, 0), (0, 0)))[:, :S]
        prev = tp.reshape(B, nb, ATTN_BLOCK, N_KV_HEADS, HEAD_DIM)
        cur = t.reshape(B, nb, ATTN_BLOCK, N_KV_HEADS, HEAD_DIM)
        return jnp.concatenate([prev, cur], axis=2)

    kb, vb = band(k), band(v)
    scale = 1.0 / math.sqrt(HEAD_DIM)
    scores = jnp.einsum('bnqkgd,bnjkd->bkgnqj', qb, kb).astype(jnp.float32) * scale

    qi = jnp.arange(ATTN_BLOCK)[:, None]
    kj = jnp.arange(2 * ATTN_BLOCK)[None, :]
    dist = ATTN_BLOCK + qi - kj
    key_pos = (jnp.arange(nb)[:, None, None] - 1) * ATTN_BLOCK + kj[None]
    valid = (dist[None] >= 0) & (dist[None] < WINDOW) & (key_pos >= 0)

    slopes = alibi_slopes(N_Q_HEADS).reshape(N_KV_HEADS, Q_PER_KV, 1, 1, 1)
    scores = scores - slopes * dist.astype(jnp.float32)
    scores = jnp.where(valid, scores, -jnp.inf)

    sink = sinks.astype(jnp.float32).reshape(N_KV_HEADS, Q_PER_KV, 1, 1, 1)
    m = jnp.maximum(jnp.max(scores, axis=-1, keepdims=True), sink)
    p = jnp.exp(scores - m)
    denom = jnp.sum(p, axis=-1, keepdims=True) + jnp.exp(sink - m)
    probs = (p / denom).astype(v.dtype)
    out = jnp.einsum('bkgnqj,bnjkd->bnqkgd', probs, vb)
    return out.reshape(B, S, N_Q_HEADS * HEAD_DIM)


def conformer_conv(u, conv_w, conv_b, ln_g, ln_b):
    a, b = jnp.split(u, 2, axis=-1)
    h = a * jax.nn.sigmoid(b)
    h = jnp.pad(h, ((0, 0), (CONV_KERNEL - 1, 0), (0, 0)))
    y = lax.conv_general_dilated(h, conv_w[:, None, :], window_strides=(1,), padding='VALID',
                                 dimension_numbers=('NWC', 'WIO', 'NWC'),
                                 feature_group_count=CONV_WIDTH)
    y = y + conv_b
    y = layer_norm(y, ln_g, ln_b)
    return jax.nn.silu(y)


def route(h, w_router, router_bias):
    T = h.shape[0]
    scores = jax.nn.sigmoid((h @ w_router).astype(jnp.float32))
    sel = scores + router_bias.astype(jnp.float32)
    per_group = N_EXPERTS // N_EXPERT_GROUPS
    grp = sel.reshape(T, N_EXPERT_GROUPS, per_group)
    grp_score = jnp.sum(lax.top_k(grp, 2)[0], axis=-1)
    _, gidx = lax.top_k(grp_score, TOPK_EXPERT_GROUPS)
    gmask = jnp.sum(jax.nn.one_hot(gidx, N_EXPERT_GROUPS, dtype=jnp.float32), axis=1) > 0
    emask = jnp.repeat(gmask, per_group, axis=1)
    _, eidx = lax.top_k(jnp.where(emask, sel, -jnp.inf), TOP_K)
    w = jnp.take_along_axis(scores, eidx, axis=-1)
    w = w / jnp.sum(w, axis=-1, keepdims=True) * ROUTED_SCALE
    return eidx, w


def routed_experts(h, eidx, w, w_gate, w_up, w_down):
    T, D = h.shape
    A = T * TOP_K
    e_flat = eidx.reshape(-1)
    tok = jnp.repeat(jnp.arange(T, dtype=jnp.int32), TOP_K)
    w_flat = w.reshape(-1)
    order = jnp.argsort(e_flat)
    e_sorted = e_flat[order]
    counts = jnp.bincount(e_flat, length=N_EXPERTS)
    padded = (counts + MOE_BLOCK - 1) // MOE_BLOCK * MOE_BLOCK
    pad_end = jnp.cumsum(padded)
    pad_start = pad_end - padded
    start = jnp.cumsum(counts) - counts
    dest = pad_start[e_sorted] + jnp.arange(A, dtype=jnp.int32) - start[e_sorted]
    n_blocks = -(-(A + N_EXPERTS * (MOE_BLOCK - 1)) // MOE_BLOCK)
    n_rows = n_blocks * MOE_BLOCK
    row_tok = jnp.full((n_rows,), T, dtype=jnp.int32).at[dest].set(tok[order])
    row_w = jnp.zeros((n_rows,), h.dtype).at[dest].set(w_flat[order].astype(h.dtype))
    block_start = jnp.arange(n_blocks, dtype=jnp.int32) * MOE_BLOCK
    block_exp = jnp.minimum(jnp.searchsorted(pad_end, block_start, side='right'), N_EXPERTS - 1)
    h_ext = jnp.concatenate([h, jnp.zeros((1, D), h.dtype)], axis=0)

    def expert_block(args):
        rows, e = args
        xb = h_ext[rows]
        return (jax.nn.silu(xb @ w_gate[e]) * (xb @ w_up[e])) @ w_down[e]

    y = lax.map(expert_block, (row_tok.reshape(n_blocks, MOE_BLOCK), block_exp))
    y = y.reshape(n_rows, D) * row_w[:, None]
    return jax.ops.segment_sum(y, row_tok, num_segments=T + 1)[:T]


def setup_inputs(seed: int = 0) -> dict:
    key = jax.random.key(seed)
    ks = jax.random.split(key, 24)
    L, D, E, F = DEPTH, D_MODEL, N_EXPERTS, D_EXPERT
    nrm = lambda k, shape, s: jax.random.normal(k, shape, jnp.float32) * s
    return {
        "x": nrm(ks[0], (BATCH, SEQ, D), 1.0),
        "c": nrm(ks[1], (BATCH, D), 1.0),
        "w_ada": nrm(ks[2], (L, D, 6 * D), 0.1 * D ** -0.5),
        "b_ada": nrm(ks[3], (L, 6 * D), 0.02),
        "w_in": nrm(ks[4], (L, D, IN_COLS), D ** -0.5),
        "sinks": nrm(ks[5], (L, N_Q_HEADS), 0.5),
        "conv_w": nrm(ks[6], (L, CONV_KERNEL, CONV_WIDTH), CONV_KERNEL ** -0.5),
        "conv_b": nrm(ks[7], (L, CONV_WIDTH), 0.02),
        "conv_ln_g": 1.0 + nrm(ks[8], (L, CONV_WIDTH), 0.02),
        "conv_ln_b": nrm(ks[9], (L, CONV_WIDTH), 0.02),
        "w_o": nrm(ks[10], (L, D, D), DEEPNORM_BETA * D ** -0.5),
        "ln1_g": 1.0 + nrm(ks[11], (L, D), 0.02),
        "ln1_b": nrm(ks[12], (L, D), 0.02),
        "w_router": nrm(ks[13], (L, D, E), D ** -0.5),
        "router_bias": nrm(ks[14], (L, E), 0.01),
        "w_gate_e": nrm(ks[15], (L, E, D, F), D ** -0.5),
        "w_up_e": nrm(ks[16], (L, E, D, F), D ** -0.5),
        "w_down_e": nrm(ks[17], (L, E, F, D), DEEPNORM_BETA * F ** -0.5),
        "w_gate_s": nrm(ks[18], (L, D, D_SHARED), D ** -0.5),
        "w_up_s": nrm(ks[19], (L, D, D_SHARED), D ** -0.5),
        "w_down_s": nrm(ks[20], (L, D_SHARED, D), DEEPNORM_BETA * D_SHARED ** -0.5),
        "ln2_g": 1.0 + nrm(ks[21], (L, D), 0.02),
        "ln2_b": nrm(ks[22], (L, D), 0.02),
    }


def reference(x, c, w_ada, b_ada, w_in, sinks, conv_w, conv_b, conv_ln_g, conv_ln_b, w_o,
              ln1_g, ln1_b, w_router, router_bias, w_gate_e, w_up_e, w_down_e,
              w_gate_s, w_up_s, w_down_s, ln2_g, ln2_b):
    B, S, D = x.shape
    c_act = jax.nn.silu(c)
    for l in range(DEPTH):
        mod = c_act @ w_ada[l] + b_ada[l]
        sh1, sc1, g1, sh2, sc2, g2 = [m[:, None, :] for m in jnp.split(mod, 6, axis=-1)]

        h = x * (1.0 + sc1) + sh1
        proj = h @ w_in[l]
        q, k, v, u = jnp.split(proj, [ATTN_WIDTH, ATTN_WIDTH + KV_WIDTH,
                                      ATTN_WIDTH + 2 * KV_WIDTH], axis=-1)
        q = q.reshape(B, S, N_Q_HEADS, HEAD_DIM)
        k = k.reshape(B, S, N_KV_HEADS, HEAD_DIM)
        v = v.reshape(B, S, N_KV_HEADS, HEAD_DIM)
        attn_out = sliding_window_attention(q, k, v, sinks[l])
        conv_out = conformer_conv(u, conv_w[l], conv_b[l], conv_ln_g[l], conv_ln_b[l])
        mix = jnp.concatenate([attn_out, conv_out], axis=-1) @ w_o[l]
        x = layer_norm(DEEPNORM_ALPHA * x + (1.0 + g1) * mix, ln1_g[l], ln1_b[l])

        h = (x * (1.0 + sc2) + sh2).reshape(B * S, D)
        shared = (jax.nn.silu(h @ w_gate_s[l]) * (h @ w_up_s[l])) @ w_down_s[l]
        eidx, ew = route(h, w_router[l], router_bias[l])
        routed = routed_experts(h, eidx, ew, w_gate_e[l], w_up_e[l], w_down_e[l])
        ffn = (shared + routed).reshape(B, S, D)
        x = layer_norm(DEEPNORM_ALPHA * x + (1.0 + g2) * ffn, ln2_g[l], ln2_b[l])
    return x
```

```cpp
#include <hip/hip_runtime.h>
#include <cstdio>
#include <cstdint>

#define LAS __attribute__((address_space(3)))
typedef unsigned short bf16;
typedef short bf16x8 __attribute__((ext_vector_type(8)));
typedef short bf16x4v __attribute__((ext_vector_type(4)));
typedef float f32x4 __attribute__((ext_vector_type(4)));
typedef unsigned u32x4 __attribute__((ext_vector_type(4)));
typedef unsigned u32x2 __attribute__((ext_vector_type(2)));

#ifndef N_LAUNCH_MODE
#define N_LAUNCH_MODE 0
#endif

constexpr int NB = 8, SEQ = 4096, DM = 1024, T = NB * SEQ;
constexpr int HD = 64, NQH = 8, NKVH = 2;
constexpr int INC = 1792, QW = 1280;
constexpr int NE = 256, TOPK = 8, FE = 256;
constexpr int CK = 31, CW = 512;
constexpr int BM = 256, BN = 128;
constexpr int MAXROWS = T * TOPK + NE * BM;
constexpr int MAXTILES = MAXROWS / BM;
constexpr float LN_EPS = 1e-5f;
constexpr float ALPHA = 1.18920711500272106672f;
constexpr int NTHREADS = 512, NWAVES = 8;
constexpr int LDS_BYTES = 147456;

constexpr size_t MiB = 1u << 20;
constexpr size_t WS_CTL = 0, CTL_ZERO_BYTES = 64 * 1024;
constexpr size_t WS_MOD = 1 * MiB;
constexpr size_t WS_CNT = 1 * MiB + 256 * 1024;
constexpr size_t WS_HIST = 2 * MiB;
constexpr size_t WS_OFF = 3 * MiB;
constexpr size_t WS_EIDX = 4 * MiB;
constexpr size_t WS_EW = 5 * MiB;
constexpr size_t WS_RTOK = 6 * MiB;
constexpr size_t WS_RDST = 8 * MiB;
constexpr size_t WS_RW = 10 * MiB;
constexpr size_t WS_WINT = 12 * MiB;
constexpr size_t WS_WOT = 16 * MiB;
constexpr size_t WS_WCAT = 18 * MiB;
constexpr size_t WS_WDST = 20 * MiB;
constexpr size_t WS_WDT = 24 * MiB;
constexpr size_t WS_H = 152 * MiB;
constexpr size_t WS_HS = 312 * MiB;
constexpr size_t WS_SD = 328 * MiB;
constexpr size_t WS_Y = 392 * MiB;
constexpr size_t WS_WGT = 392 * MiB;
constexpr size_t WS_WUT = 520 * MiB;
constexpr size_t WS_H2 = 648 * MiB;
constexpr size_t WS_QKVG = 712 * MiB;
constexpr size_t WS_AC = 792 * MiB;
constexpr size_t WS_LOG = 856 * MiB;
constexpr size_t WS_END = 904 * MiB;

__device__ __forceinline__ unsigned f2bf(float f) { unsigned u = __float_as_uint(f); return (u + 0x7fffu + ((u >> 16) & 1u)) >> 16; }
__device__ __forceinline__ unsigned pk2(float lo, float hi) { return f2bf(lo) | (f2bf(hi) << 16); }
__device__ __forceinline__ float bf2f(unsigned h) { return __uint_as_float(h << 16); }
__device__ __forceinline__ float bflo(unsigned w) { return __uint_as_float(w << 16); }
__device__ __forceinline__ float bfhi(unsigned w) { return __uint_as_float(w & 0xffff0000u); }
__device__ __forceinline__ float sigmoidf_(float v) { return 1.0f / (1.0f + __expf(-v)); }
__device__ __forceinline__ float siluf_(float v) { return v / (1.0f + __expf(-v)); }
__device__ __forceinline__ float wave_sum(float v) {
#pragma unroll
    for (int o = 1; o < 64; o <<= 1) v += __shfl_xor(v, o);
    return v;
}
__device__ __forceinline__ int perm32(int rho) { const int n = rho >> 4, i = rho & 15; return 8 * (i >> 2) + 4 * n + (i & 3); }

#define XB_TMO      128
#define XB_XCNT(j)  (256  + 64 * (j))
#define XB_XSUB(j)  (1280 + 64 * (j))
#define XB_XGEN(j)  (2304 + 64 * (j))
#define XB_TOP      3328
#define XB_TOPGEN   3392
#define XCD_BAR_WORDS 3456
#define XB_SPIN_CAP (1u << 22)
__device__ __forceinline__ unsigned xb_ld(unsigned* p)              { return __hip_atomic_load(p, __ATOMIC_RELAXED, __HIP_MEMORY_SCOPE_AGENT); }
__device__ __forceinline__ unsigned xb_add(unsigned* p, unsigned v) { return __hip_atomic_fetch_add(p, v, __ATOMIC_RELAXED, __HIP_MEMORY_SCOPE_AGENT); }
__device__ __forceinline__ unsigned xb_xcc_id() { return (unsigned)__builtin_amdgcn_s_getreg((3 << 11) | 20) & 0xFu; }
#define XB_SPIN(cond, bar) do { unsigned _sp = 0; while (cond) { __builtin_amdgcn_s_sleep(1); \
    if ((++_sp & 255u) == 0u) { if (xb_ld(&(bar)[XB_TMO])) break; if (_sp > XB_SPIN_CAP) { atomicAdd(&(bar)[XB_TMO], 1u); break; } } } } while (0)
struct XcdBarrier { unsigned* bar; unsigned x; volatile LAS unsigned* st; };
__device__ __forceinline__ XcdBarrier xcd_barrier_post(unsigned* bar, volatile LAS unsigned* st) {
    XcdBarrier b; b.bar = bar; b.x = xb_xcc_id(); b.st = st;
    if (threadIdx.x == 0) (void)xb_add(&bar[XB_XCNT(b.x)], 1u);
    return b;
}
__device__ __forceinline__ void xcd_barrier_complete(unsigned* bar, unsigned x, unsigned& nloc, unsigned& nx) {
    const unsigned G = gridDim.x * gridDim.y * gridDim.z;
    unsigned sum, cnt, mine, sp = 0u;
    for (;;) {
        sum = 0u; cnt = 0u; mine = 0u;
#pragma unroll
        for (unsigned j = 0; j < 16; ++j) { const unsigned c = xb_ld(&bar[XB_XCNT(j)]); sum += c; cnt += (c > 0u) ? 1u : 0u; mine = (j == x) ? c : mine; }
        if (sum == G) break;
        __builtin_amdgcn_s_sleep(1);
        if ((++sp & 255u) == 0u) { if (xb_ld(&bar[XB_TMO])) break; if (sp > XB_SPIN_CAP) { atomicAdd(&bar[XB_TMO], 1u); break; } }
    }
    nloc = mine > 0u ? mine : 1u; nx = cnt > 0u ? cnt : 1u;
}
__device__ __forceinline__ void xcd_barrier(const XcdBarrier& b) {
    asm volatile("s_waitcnt vmcnt(0)" ::: "memory");
    __syncthreads();
    if (threadIdx.x == 0) {
        unsigned* bar = b.bar;
        __builtin_amdgcn_s_waitcnt(0);
        unsigned nloc = b.st[0], nx = b.st[1];
        if (nloc == 0u) { xcd_barrier_complete(bar, b.x, nloc, nx); b.st[0] = nloc; b.st[1] = nx; }
        const unsigned old = xb_add(&bar[XB_XSUB(b.x)], 1u);
        const unsigned gen = old / nloc;
        if (old + 1u == (gen + 1u) * nloc) {
            __builtin_amdgcn_fence(__ATOMIC_RELEASE, "agent");
            asm volatile("s_waitcnt vmcnt(0)" ::: "memory");
            const unsigned og = xb_add(&bar[XB_TOP], 1u);
            const unsigned tg = og / nx;
            if (og + 1u == (tg + 1u) * nx) xb_add(&bar[XB_TOPGEN], 1u);
            else XB_SPIN(xb_ld(&bar[XB_TOPGEN]) == tg, bar);
            __builtin_amdgcn_fence(__ATOMIC_ACQUIRE, "agent");
            xb_add(&bar[XB_XGEN(b.x)], 1u);
            asm volatile("s_waitcnt vmcnt(0)" ::: "memory");
        } else {
            XB_SPIN(xb_ld(&bar[XB_XGEN(b.x)]) == gen, bar);
            __builtin_amdgcn_fence(__ATOMIC_ACQUIRE, "agent");
            asm volatile("s_waitcnt vmcnt(0)" ::: "memory");
        }
    }
    __syncthreads();
}

struct Args {
    const float* in[23];
    float* out;
    unsigned char* ws;
    int ph_lo, ph_hi;
};

constexpr int STAGE_BYTES = 49152;
#define GLDS16(gp, lp) __builtin_amdgcn_global_load_lds((const unsigned*)(gp), (unsigned*)(lp), 16, 0, 0)

template <class ARow, class BRow>
__device__ __forceinline__ void gemm_tile(unsigned char* lds, const bf16* A, int lda, const bf16* Bt, int ldb, int K, const ARow& arow, const BRow& brow, f32x4 (&acc)[4][4]) {
    const int tid = threadIdx.x, lane = tid & 63, wid = __builtin_amdgcn_readfirstlane(tid >> 6), wm = wid >> 1, wn = wid & 1;
    const int lr = lane >> 3, lc = lane & 7, fr = lane & 15, fq = lane >> 4;
    const int swz = (lc ^ lr) * 16;
    const char* ap[4]; const char* bp[2];
#pragma unroll
    for (int i = 0; i < 4; ++i) { const int r = (wid * 4 + i) * 8 + lr; ap[i] = (const char*)(A + (size_t)arow(r) * lda) + swz; }
#pragma unroll
    for (int i = 0; i < 2; ++i) { const int r = (wid * 2 + i) * 8 + lr; bp[i] = (const char*)(Bt + (size_t)brow(r) * ldb) + swz; }
#pragma unroll
    for (int a = 0; a < 4; ++a)
#pragma unroll
        for (int b = 0; b < 4; ++b) acc[a][b] = (f32x4){0.f, 0.f, 0.f, 0.f};
    const int p0 = (fq ^ (lane & 7)) * 16;
    const int aoff = (wm * 64 + fr) * 128 + p0;
    const int boff = 32768 + (wn * 64 + fr) * 128 + p0;
    const int nk = K / 64;
#define GEMM_ISSUE(s, kb) do { unsigned char* _st = lds + (s) * STAGE_BYTES; \
        _Pragma("unroll") for (int _i = 0; _i < 4; ++_i) GLDS16(ap[_i] + (kb), _st + (wid * 4 + _i) * 1024); \
        _Pragma("unroll") for (int _i = 0; _i < 2; ++_i) GLDS16(bp[_i] + (kb), _st + 32768 + (wid * 2 + _i) * 1024); } while (0)
    __syncthreads();
    GEMM_ISSUE(0, 0);
    for (int t = 0; t < nk; ++t) {
        asm volatile("s_waitcnt vmcnt(0)" ::: "memory");
        __syncthreads();
        if (t + 1 < nk) GEMM_ISSUE((t + 1) & 1, (t + 1) * 128);
        const unsigned char* st = lds + (t & 1) * STAGE_BYTES;
#pragma unroll
        for (int kk = 0; kk < 2; ++kk) {
            bf16x8 af[4], bfr[4];
#pragma unroll
            for (int mt = 0; mt < 4; ++mt) af[mt] = *(const bf16x8*)(st + ((aoff ^ (kk * 64)) + mt * 2048));
#pragma unroll
            for (int nt = 0; nt < 4; ++nt) bfr[nt] = *(const bf16x8*)(st + ((boff ^ (kk * 64)) + nt * 2048));
#pragma unroll
            for (int mt = 0; mt < 4; ++mt)
#pragma unroll
                for (int nt = 0; nt < 4; ++nt) acc[mt][nt] = __builtin_amdgcn_mfma_f32_16x16x32_bf16(bfr[nt], af[mt], acc[mt][nt], 0, 0, 0);
        }
    }
#undef GEMM_ISSUE
}

struct RowIdent { int base; __device__ __forceinline__ int operator()(int r) const { return base + r; } };
struct RowGather { const int* idx; __device__ __forceinline__ int operator()(int r) const { return idx[r]; } };
struct BRowPlain { int n0; __device__ __forceinline__ int operator()(int rho) const { return n0 + (rho & ~31) + perm32(rho & 31); } };
struct BRowPair { int g0, u0; __device__ __forceinline__ int operator()(int rho) const { const int c = 32 * (rho >> 6) + perm32(rho & 31); return g0 + ((rho >> 5) & 1) * (u0 - g0) + c; } };

__device__ __forceinline__ void store8_bf16(bf16* p, const f32x4& a, const f32x4& b) {
    u32x4 w; w.x = pk2(a[0], a[1]); w.y = pk2(a[2], a[3]); w.z = pk2(b[0], b[1]); w.w = pk2(b[2], b[3]); *(u32x4*)p = w;
}

__device__ __forceinline__ void transpose_item(const float* src, int K, int N, bf16* dst, int item, float* scr, int lane) {
    const int nblk = N / 64, kb = item / nblk, nb = item % nblk, k0 = kb * 64, n0 = nb * 64;
#pragma unroll 8
    for (int i = 0; i < 64; ++i) scr[i * 65 + lane] = src[(size_t)(k0 + i) * N + n0 + lane];
    asm volatile("s_waitcnt lgkmcnt(0)" ::: "memory");
    const int c = lane & 7;
#pragma unroll
    for (int j = 0; j < 8; ++j) {
        const int n = (lane >> 3) + 8 * j; const float* s = scr + (8 * c) * 65 + n;
        u32x4 o; o.x = pk2(s[0], s[65]); o.y = pk2(s[2 * 65], s[3 * 65]); o.z = pk2(s[4 * 65], s[5 * 65]); o.w = pk2(s[6 * 65], s[7 * 65]);
        *(u32x4*)(dst + (size_t)(n0 + n) * K + k0 + 8 * c) = o;
    }
    asm volatile("s_waitcnt lgkmcnt(0)" ::: "memory");
}

__device__ __forceinline__ void phase_prep(const Args& a, unsigned char* lds, int G) {
    const int tid = threadIdx.x, lane = tid & 63, wid = tid >> 6, bx = blockIdx.x;
    unsigned char* ws = a.ws;
    {
        float* sc = (float*)lds;
        float* red = (float*)(lds + 32768);
        const float* c = a.in[1]; const float* w_ada = a.in[2]; const float* b_ada = a.in[3];
        float* mod = (float*)(ws + WS_MOD);
        for (int cb = bx; cb < 6144 / 32; cb += G) {
            __syncthreads();
            for (int i = tid; i < 8 * 1024; i += NTHREADS) sc[i] = siluf_(c[i]);
            __syncthreads();
            const int kg = tid >> 5, cl = tid & 31, col = cb * 32 + cl;
            float acc[8];
#pragma unroll
            for (int b = 0; b < 8; ++b) acc[b] = 0.f;
            for (int k = kg; k < 1024; k += 16) {
                const float wv = w_ada[(size_t)k * 6144 + col];
#pragma unroll
                for (int b = 0; b < 8; ++b) acc[b] += sc[b * 1024 + k] * wv;
            }
#pragma unroll
            for (int b = 0; b < 8; ++b) red[(kg * 8 + b) * 32 + cl] = acc[b];
            __syncthreads();
            if (tid < 256) {
                const int b = tid >> 5; float s = 0.f;
#pragma unroll
                for (int g = 0; g < 16; ++g) s += red[(g * 8 + b) * 32 + cl];
                mod[b * 6144 + col] = s + b_ada[col];
            }
        }
        __syncthreads();
    }
    {
        float* scr = (float*)(lds + wid * 16640);
        const int gw = bx * NWAVES + wid, NGW = G * NWAVES;
        constexpr int I_IN = 16 * 28, I_O = 16 * 16, I_S = 16 * 4, I_DS = 4 * 16, I_E = 16 * 4 * NE;
        constexpr int NITEMS = I_IN + I_O + 3 * I_S + I_DS + 3 * I_E;
        for (int it = gw; it < NITEMS; it += NGW) {
            int r = it;
            if (r < I_IN) { transpose_item(a.in[4], 1024, INC, (bf16*)(ws + WS_WINT), r, scr, lane); continue; } r -= I_IN;
            if (r < I_O) { transpose_item(a.in[10], 1024, 1024, (bf16*)(ws + WS_WOT), r, scr, lane); continue; } r -= I_O;
            if (r < I_S) { transpose_item(a.in[13], 1024, 256, (bf16*)(ws + WS_WCAT), r, scr, lane); continue; } r -= I_S;
            if (r < I_S) { transpose_item(a.in[18], 1024, 256, (bf16*)(ws + WS_WCAT) + 256 * 1024, r, scr, lane); continue; } r -= I_S;
            if (r < I_S) { transpose_item(a.in[19], 1024, 256, (bf16*)(ws + WS_WCAT) + 512 * 1024, r, scr, lane); continue; } r -= I_S;
            if (r < I_DS) { transpose_item(a.in[20], 256, 1024, (bf16*)(ws + WS_WDST), r, scr, lane); continue; } r -= I_DS;
            if (r < I_E) { const int e = r >> 6; transpose_item(a.in[15] + (size_t)e * 262144, 1024, 256, (bf16*)(ws + WS_WGT) + (size_t)e * 262144, r & 63, scr, lane); continue; } r -= I_E;
            if (r < I_E) { const int e = r >> 6; transpose_item(a.in[16] + (size_t)e * 262144, 1024, 256, (bf16*)(ws + WS_WUT) + (size_t)e * 262144, r & 63, scr, lane); continue; } r -= I_E;
            { const int e = r >> 6; transpose_item(a.in[17] + (size_t)e * 262144, 256, 1024, (bf16*)(ws + WS_WDT) + (size_t)e * 262144, r & 63, scr, lane); }
        }
    }
}

__device__ __forceinline__ void phase_hmod(const Args& a, int G) {
    const float* x = a.in[0]; const float* mod = (const float*)(a.ws + WS_MOD); bf16* h = (bf16*)(a.ws + WS_H2);
    const size_t nchunk = (size_t)T * DM / 8;
    for (size_t i = (size_t)blockIdx.x * NTHREADS + threadIdx.x; i < nchunk; i += (size_t)G * NTHREADS) {
        const size_t e0 = i * 8; const int row = (int)(e0 >> 10), col = (int)(e0 & 1023), b = row >> 12;
        const f32x4 v0 = *(const f32x4*)(x + e0), v1 = *(const f32x4*)(x + e0 + 4);
        const float* sh = mod + b * 6144 + col; const float* sc = sh + 1024;
        const f32x4 s0 = *(const f32x4*)sc, s1 = *(const f32x4*)(sc + 4), h0 = *(const f32x4*)sh, h1 = *(const f32x4*)(sh + 4);
        const f32x4 r0 = v0 * (s0 + 1.0f) + h0, r1 = v1 * (s1 + 1.0f) + h1;
        store8_bf16(h + e0, r0, r1);
    }
}

__device__ __forceinline__ void phase_proj(const Args& a, unsigned char* lds, int G) {
    const bf16* A = (const bf16*)(a.ws + WS_H2); const bf16* Bt = (const bf16*)(a.ws + WS_WINT); bf16* O = (bf16*)(a.ws + WS_QKVG);
    const int lane = threadIdx.x & 63, wid = threadIdx.x >> 6, wm = wid >> 1, wn = wid & 1, fr = lane & 15, fq = lane >> 4;
    constexpr int NT = 14, NU = (T / BM) * NT;
    for (int u = blockIdx.x; u < NU; u += G) {
        const int pm = u / NT, pn = u % NT;
        f32x4 acc[4][4];
        if (pn < 6) {
            gemm_tile(lds, A, DM, Bt, DM, DM, RowIdent{pm * BM}, BRowPlain{pn * BN}, acc);
#pragma unroll
            for (int mt = 0; mt < 4; ++mt) { bf16* rowp = O + (size_t)(pm * BM + wm * 64 + mt * 16 + fr) * QW + pn * BN + wn * 64 + 8 * fq;
#pragma unroll
                for (int p = 0; p < 2; ++p) store8_bf16(rowp + 32 * p, acc[mt][2 * p], acc[mt][2 * p + 1]); }
        } else {
            const int j = pn - 6;
            gemm_tile(lds, A, DM, Bt, DM, DM, RowIdent{pm * BM}, BRowPair{768 + 64 * j, 1280 + 64 * j}, acc);
#pragma unroll
            for (int mt = 0; mt < 4; ++mt) { bf16* rowp = O + (size_t)(pm * BM + wm * 64 + mt * 16 + fr) * QW + 768 + 64 * j + 32 * wn + 8 * fq;
                f32x4 r0, r1;
#pragma unroll
                for (int q = 0; q < 4; ++q) { r0[q] = acc[mt][0][q] * sigmoidf_(acc[mt][2][q]); r1[q] = acc[mt][1][q] * sigmoidf_(acc[mt][3][q]); }
                store8_bf16(rowp, r0, r1); }
        }
    }
}

constexpr int VT_STRIDE = 280;
__device__ __forceinline__ void attn_unit(const Args& a, unsigned char* lds, int unit) {
    const bf16* QK = (const bf16*)(a.ws + WS_QKVG); bf16* AC = (bf16*)(a.ws + WS_AC);
    const int tid = threadIdx.x, lane = tid & 63, w = __builtin_amdgcn_readfirstlane(tid >> 6), fr = lane & 15, fq = lane >> 4;
    const int kh = unit & 1, nblk = (unit >> 1) & 31, b = unit >> 6;
    const int tok0 = b * SEQ + nblk * 128;
    unsigned char* Kl = lds;
    bf16* Vt = (bf16*)(lds + 272 * 128);
    __syncthreads();
#pragma unroll 1
    for (int idx = tid; idx < 272 * 8; idx += NTHREADS) {
        const int key = idx >> 3, c = idx & 7;
        u32x4 kv = (u32x4){0u, 0u, 0u, 0u}, vv = (u32x4){0u, 0u, 0u, 0u};
        if (key < 256 && (nblk > 0 || key >= 128)) {
            const bf16* rowp = QK + (size_t)(tok0 - 128 + key) * QW + 512 + 64 * kh + 8 * c;
            kv = *(const u32x4*)rowp; vv = *(const u32x4*)(rowp + 128);
        }
        *(u32x4*)(Kl + key * 128 + ((c ^ (key & 7)) * 16)) = kv;
        bf16* vp = Vt + (8 * c) * VT_STRIDE + key;
        vp[0] = (bf16)(vv.x & 0xffffu); vp[VT_STRIDE] = (bf16)(vv.x >> 16);
        vp[2 * VT_STRIDE] = (bf16)(vv.y & 0xffffu); vp[3 * VT_STRIDE] = (bf16)(vv.y >> 16);
        vp[4 * VT_STRIDE] = (bf16)(vv.z & 0xffffu); vp[5 * VT_STRIDE] = (bf16)(vv.z >> 16);
        vp[6 * VT_STRIDE] = (bf16)(vv.w & 0xffffu); vp[7 * VT_STRIDE] = (bf16)(vv.w >> 16);
    }
    __syncthreads();
    const float* sinks = a.in[5];
#pragma unroll 1
    for (int g = 0; g < 4; ++g) {
        const int h = kh * 4 + g;
        int lofs = 0; asm volatile("" : "+v"(lofs));
        const float slope = exp2f(-(float)(h + 1)), sink = sinks[h];
        const bf16* qp = QK + (size_t)(tok0 + 16 * w + fr) * QW + 64 * h + 8 * fq;
        const bf16x8 q0 = *(const bf16x8*)qp, q1 = *(const bf16x8*)(qp + 32);
        f32x4 st[10];
#pragma unroll
        for (int i = 0; i < 10; ++i) {
            const int key = 16 * (w + i) + fr;
            const unsigned char* kp = Kl + key * 128 + lofs;
            const bf16x8 k0 = *(const bf16x8*)(kp + ((fq ^ (fr & 7)) * 16)), k1 = *(const bf16x8*)(kp + (((fq + 4) ^ (fr & 7)) * 16));
            f32x4 s = (f32x4){0.f, 0.f, 0.f, 0.f};
            s = __builtin_amdgcn_mfma_f32_16x16x32_bf16(k0, q0, s, 0, 0, 0);
            s = __builtin_amdgcn_mfma_f32_16x16x32_bf16(k1, q1, s, 0, 0, 0);
            st[i] = s;
        }
        float mx = -INFINITY;
#pragma unroll
        for (int i = 0; i < 10; ++i)
#pragma unroll
            for (int r = 0; r < 4; ++r) {
                const int dist = 128 + fr - 16 * i - 4 * fq - r;
                const int kj = 16 * (w + i) + 4 * fq + r;
                const bool valid = (dist >= 0) && (dist < 128) && (nblk > 0 || kj >= 128);
                const float s = valid ? (st[i][r] * 0.125f - slope * (float)dist) : -INFINITY;
                st[i][r] = s; mx = fmaxf(mx, s);
            }
        mx = fmaxf(mx, __shfl_xor(mx, 16)); mx = fmaxf(mx, __shfl_xor(mx, 32));
        mx = fmaxf(mx, sink);
        float sum = 0.f;
#pragma unroll
        for (int i = 0; i < 10; ++i)
#pragma unroll
            for (int r = 0; r < 4; ++r) { const float p = __expf(st[i][r] - mx); st[i][r] = p; sum += p; }
        sum += __shfl_xor(sum, 16); sum += __shfl_xor(sum, 32);
        const float inv = 1.0f / (sum + __expf(sink - mx));
        f32x4 o[4];
#pragma unroll
        for (int nt = 0; nt < 4; ++nt) o[nt] = (f32x4){0.f, 0.f, 0.f, 0.f};
#pragma unroll
        for (int s5 = 0; s5 < 5; ++s5) {
            u32x4 pw; pw.x = pk2(st[2 * s5][0], st[2 * s5][1]); pw.y = pk2(st[2 * s5][2], st[2 * s5][3]); pw.z = pk2(st[2 * s5 + 1][0], st[2 * s5 + 1][1]); pw.w = pk2(st[2 * s5 + 1][2], st[2 * s5 + 1][3]);
            const bf16x8 pf = __builtin_bit_cast(bf16x8, pw);
#pragma unroll
            for (int nt = 0; nt < 4; ++nt) {
                const bf16* vp = Vt + (16 * nt + fr) * VT_STRIDE + 16 * (w + 2 * s5) + 4 * fq + lofs;
                const u32x2 va = *(const u32x2*)vp, vb = *(const u32x2*)(vp + 16);
                u32x4 vw; vw.x = va.x; vw.y = va.y; vw.z = vb.x; vw.w = vb.y;
                o[nt] = __builtin_amdgcn_mfma_f32_16x16x32_bf16(__builtin_bit_cast(bf16x8, vw), pf, o[nt], 0, 0, 0);
            }
        }
        bf16* op = AC + (size_t)(tok0 + 16 * w + fr) * DM + 64 * h + 4 * fq;
#pragma unroll
        for (int nt = 0; nt < 4; ++nt) { u32x2 ow; ow.x = pk2(o[nt][0] * inv, o[nt][1] * inv); ow.y = pk2(o[nt][2] * inv, o[nt][3] * inv); *(u32x2*)(op + 16 * nt) = ow; }
    }
}

__device__ __forceinline__ void conv_unit(const Args& a, unsigned char* lds, int unit) {
    const bf16* QK = (const bf16*)(a.ws + WS_QKVG); bf16* AC = (bf16*)(a.ws + WS_AC);
    const int tid = threadIdx.x, lane = tid & 63, wid = tid >> 6;
    const int t0 = unit * 32, b = t0 >> 12, s0 = t0 & 4095, c = tid;
    bf16* inp = (bf16*)lds;
    float* yb = (float*)(lds + 62 * CW * 2);
    __syncthreads();
    for (int idx = tid; idx < 62 * 64; idx += NTHREADS) {
        const int i = idx >> 6, ch = idx & 63, s = s0 - 30 + i;
        u32x4 v = (u32x4){0u, 0u, 0u, 0u};
        if (s >= 0) v = *(const u32x4*)(QK + (size_t)(b * SEQ + s) * QW + 768 + 8 * ch);
        *(u32x4*)(inp + i * CW + 8 * ch) = v;
    }
    const float* cw = a.in[6];
    float wgt[CK];
#pragma unroll
    for (int j = 0; j < CK; ++j) wgt[j] = cw[j * CW + c];
    float acc[32];
    const float bias = a.in[7][c];
#pragma unroll
    for (int t = 0; t < 32; ++t) acc[t] = bias;
    __syncthreads();
#pragma unroll
    for (int i = 0; i < 62; ++i) {
        const float v = bf2f(inp[i * CW + c]);
#pragma unroll
        for (int t = 0; t < 32; ++t) { const int j = i - t; if (j >= 0 && j < CK) acc[t] += v * wgt[j]; }
    }
#pragma unroll
    for (int t = 0; t < 32; ++t) yb[t * CW + c] = acc[t];
    __syncthreads();
    const float* lg = a.in[8]; const float* lb = a.in[9];
    const f32x4 g0 = *(const f32x4*)(lg + 8 * lane), g1 = *(const f32x4*)(lg + 8 * lane + 4), b0 = *(const f32x4*)(lb + 8 * lane), b1 = *(const f32x4*)(lb + 8 * lane + 4);
#pragma unroll
    for (int q = 0; q < 4; ++q) {
        const int t = wid * 4 + q;
        f32x4 v0 = *(const f32x4*)(yb + t * CW + 8 * lane), v1 = *(const f32x4*)(yb + t * CW + 8 * lane + 4);
        const float mean = wave_sum((v0[0] + v0[1]) + (v0[2] + v0[3]) + (v1[0] + v1[1]) + (v1[2] + v1[3])) * (1.0f / CW);
        v0 = v0 - mean; v1 = v1 - mean;
        const float var = wave_sum((v0[0] * v0[0] + v0[1] * v0[1]) + (v0[2] * v0[2] + v0[3] * v0[3]) + (v1[0] * v1[0] + v1[1] * v1[1]) + (v1[2] * v1[2] + v1[3] * v1[3])) * (1.0f / CW);
        const float rstd = rsqrtf(var + LN_EPS);
        f32x4 r0 = v0 * rstd * g0 + b0, r1 = v1 * rstd * g1 + b1;
#pragma unroll
        for (int e = 0; e < 4; ++e) { r0[e] = siluf_(r0[e]); r1[e] = siluf_(r1[e]); }
        store8_bf16(AC + (size_t)(t0 + t) * DM + 512 + 8 * lane, r0, r1);
    }
}

__device__ __forceinline__ void phase_mixer(const Args& a, unsigned char* lds, int G) {
    for (int u = blockIdx.x; u < NB * 32 * NKVH; u += G) attn_unit(a, lds, u);
    for (int u = blockIdx.x; u < T / 32; u += G) conv_unit(a, lds, u);
}

__device__ __forceinline__ void phase_wo(const Args& a, unsigned char* lds, int G) {
    const bf16* A = (const bf16*)(a.ws + WS_AC); const bf16* Bt = (const bf16*)(a.ws + WS_WOT);
    const float* x = a.in[0]; const float* mod = (const float*)(a.ws + WS_MOD); float* out = a.out;
    const int lane = threadIdx.x & 63, wid = threadIdx.x >> 6, wm = wid >> 1, wn = wid & 1, fr = lane & 15, fq = lane >> 4;
    constexpr int NT = 8, NU = (T / BM) * NT;
    for (int u = blockIdx.x; u < NU; u += G) {
        const int pm = u / NT, pn = u % NT;
        f32x4 acc[4][4];
        gemm_tile(lds, A, DM, Bt, DM, DM, RowIdent{pm * BM}, BRowPlain{pn * BN}, acc);
#pragma unroll
        for (int mt = 0; mt < 4; ++mt) {
            const int m = pm * BM + wm * 64 + mt * 16 + fr, bb = m >> 12;
#pragma unroll
            for (int p = 0; p < 2; ++p) {
                const int n = pn * BN + wn * 64 + 32 * p + 8 * fq;
                const float* g1 = mod + bb * 6144 + 2048 + n;
                const size_t off = (size_t)m * DM + n;
                const f32x4 x0 = *(const f32x4*)(x + off), x1 = *(const f32x4*)(x + off + 4), ga = *(const f32x4*)g1, gb = *(const f32x4*)(g1 + 4);
                *(f32x4*)(out + off) = x0 * ALPHA + (ga + 1.0f) * acc[mt][2 * p];
                *(f32x4*)(out + off + 4) = x1 * ALPHA + (gb + 1.0f) * acc[mt][2 * p + 1];
            }
        }
    }
}

__device__ __forceinline__ void phase_ln1(const Args& a, int G) {
    const float* mod = (const float*)(a.ws + WS_MOD); float* out = a.out; bf16* h2 = (bf16*)(a.ws + WS_H2);
    const float* lg = a.in[11]; const float* lb = a.in[12];
    const int lane = threadIdx.x & 63, wid = threadIdx.x >> 6;
    for (int m = blockIdx.x * NWAVES + wid; m < T; m += G * NWAVES) {
        const int bb = m >> 12; float* rowp = out + (size_t)m * DM;
        f32x4 v[4]; float s = 0.f;
#pragma unroll
        for (int q = 0; q < 4; ++q) { v[q] = *(const f32x4*)(rowp + 4 * lane + 256 * q); s += (v[q][0] + v[q][1]) + (v[q][2] + v[q][3]); }
        const float mean = wave_sum(s) * (1.0f / DM); float s2 = 0.f;
#pragma unroll
        for (int q = 0; q < 4; ++q) { v[q] = v[q] - mean; s2 += (v[q][0] * v[q][0] + v[q][1] * v[q][1]) + (v[q][2] * v[q][2] + v[q][3] * v[q][3]); }
        const float rstd = rsqrtf(wave_sum(s2) * (1.0f / DM) + LN_EPS);
#pragma unroll
        for (int q = 0; q < 4; ++q) {
            const int n = 4 * lane + 256 * q;
            const f32x4 x1 = v[q] * rstd * *(const f32x4*)(lg + n) + *(const f32x4*)(lb + n);
            *(f32x4*)(rowp + n) = x1;
            const f32x4 hh = x1 * (*(const f32x4*)(mod + bb * 6144 + 4096 + n) + 1.0f) + *(const f32x4*)(mod + bb * 6144 + 3072 + n);
            u32x2 w; w.x = pk2(hh[0], hh[1]); w.y = pk2(hh[2], hh[3]); *(u32x2*)(h2 + (size_t)m * DM + n) = w;
        }
    }
}

__device__ __forceinline__ void phase_rs(const Args& a, unsigned char* lds, int G) {
    const bf16* A = (const bf16*)(a.ws + WS_H2); const bf16* Bt = (const bf16*)(a.ws + WS_WCAT);
    float* logits = (float*)(a.ws + WS_LOG); bf16* hs = (bf16*)(a.ws + WS_HS);
    const int lane = threadIdx.x & 63, wid = threadIdx.x >> 6, wm = wid >> 1, wn = wid & 1, fr = lane & 15, fq = lane >> 4;
    constexpr int NT = 6, NU = (T / BM) * NT;
    for (int u = blockIdx.x; u < NU; u += G) {
        const int pm = u / NT, pn = u % NT;
        f32x4 acc[4][4];
        if (pn < 2) {
            gemm_tile(lds, A, DM, Bt, DM, DM, RowIdent{pm * BM}, BRowPlain{pn * BN}, acc);
#pragma unroll
            for (int mt = 0; mt < 4; ++mt) { float* rowp = logits + (size_t)(pm * BM + wm * 64 + mt * 16 + fr) * NE + pn * BN + wn * 64 + 8 * fq;
#pragma unroll
                for (int p = 0; p < 2; ++p) { *(f32x4*)(rowp + 32 * p) = acc[mt][2 * p]; *(f32x4*)(rowp + 32 * p + 4) = acc[mt][2 * p + 1]; } }
        } else {
            const int j = pn - 2;
            gemm_tile(lds, A, DM, Bt, DM, DM, RowIdent{pm * BM}, BRowPair{256 + 64 * j, 512 + 64 * j}, acc);
#pragma unroll
            for (int mt = 0; mt < 4; ++mt) { bf16* rowp = hs + (size_t)(pm * BM + wm * 64 + mt * 16 + fr) * FE + 64 * j + 32 * wn + 8 * fq;
                f32x4 r0, r1;
#pragma unroll
                for (int q = 0; q < 4; ++q) { r0[q] = siluf_(acc[mt][0][q]) * acc[mt][2][q]; r1[q] = siluf_(acc[mt][1][q]) * acc[mt][3][q]; }
                store8_bf16(rowp, r0, r1); }
        }
    }
}

__device__ __forceinline__ void phase_route(const Args& a, unsigned char* lds, int G) {
    const float* logits = (const float*)(a.ws + WS_LOG); const float* rbias = a.in[14];
    int* eidx = (int*)(a.ws + WS_EIDX); float* ew = (float*)(a.ws + WS_EW); int* histg = (int*)(a.ws + WS_HIST);
    const int tid = threadIdx.x, lane = tid & 63, wid = tid >> 6;
    int* hist = (int*)lds;
    __syncthreads();
    if (tid < NE) hist[tid] = 0;
    __syncthreads();
    const int chunk = (T + G - 1) / G, tbeg = blockIdx.x * chunk, tend = min(T, tbeg + chunk);
    const f32x4 bv = *(const f32x4*)(rbias + 4 * lane);
    for (int t = tbeg + wid; t < tend; t += NWAVES) {
        const f32x4 lg = *(const f32x4*)(logits + (size_t)t * NE + 4 * lane);
        float sc[4], sel[4];
#pragma unroll
        for (int i = 0; i < 4; ++i) { sc[i] = sigmoidf_(lg[i]); sel[i] = sc[i] + bv[i]; }
        float a1 = fmaxf(sel[0], sel[1]), a2 = fminf(sel[0], sel[1]);
        { const float c1 = fmaxf(sel[2], sel[3]), c2 = fminf(sel[2], sel[3]); const float n1 = fmaxf(a1, c1), n2 = fmaxf(fminf(a1, c1), fmaxf(a2, c2)); a1 = n1; a2 = n2; }
#pragma unroll
        for (int o = 1; o < 8; o <<= 1) { const float c1 = __shfl_xor(a1, o), c2 = __shfl_xor(a2, o); const float n1 = fmaxf(a1, c1), n2 = fmaxf(fminf(a1, c1), fmaxf(a2, c2)); a1 = n1; a2 = n2; }
        const float gs = a1 + a2; const int mg = lane >> 3; int rank = 0;
#pragma unroll
        for (int g = 0; g < 8; ++g) { const float o = __shfl(gs, 8 * g); rank += (o > gs || (o == gs && g < mg)) ? 1 : 0; }
        const bool gsel = rank < 4;
        float v[4];
#pragma unroll
        for (int i = 0; i < 4; ++i) v[i] = gsel ? sel[i] : -INFINITY;
        int my_e = 0; float my_w = 0.f, wsum = 0.f;
#pragma unroll
        for (int r = 0; r < TOPK; ++r) {
            float bvv = v[0]; int bi = 0;
#pragma unroll
            for (int i = 1; i < 4; ++i) if (v[i] > bvv) { bvv = v[i]; bi = i; }
            int bidx = 4 * lane + bi;
#pragma unroll
            for (int o = 1; o < 64; o <<= 1) { const float ov = __shfl_xor(bvv, o); const int oi = __shfl_xor(bidx, o); if (ov > bvv || (ov == bvv && oi < bidx)) { bvv = ov; bidx = oi; } }
            const int owner = bidx >> 2, oi = bidx & 3;
            const float mys = (oi == 0) ? sc[0] : (oi == 1) ? sc[1] : (oi == 2) ? sc[2] : sc[3];
            const float wv = __shfl(mys, owner);
            if (lane == owner) {
#pragma unroll
                for (int i = 0; i < 4; ++i) if (i == oi) v[i] = -INFINITY;
            }
            wsum += wv;
            if (lane == r) { my_e = bidx; my_w = wv; }
        }
        if (lane < TOPK) {
            eidx[(size_t)t * TOPK + lane] = my_e;
            ew[(size_t)t * TOPK + lane] = my_w / wsum * 2.5f;
            atomicAdd(&hist[my_e], 1);
        }
    }
    __syncthreads();
    if (tid < NE) histg[blockIdx.x * NE + tid] = hist[tid];
}

__device__ __forceinline__ void phase_scan(const Args& a, unsigned char* lds, int G) {
    const int* histg = (const int*)(a.ws + WS_HIST); int* off = (int*)(a.ws + WS_OFF); int* cnt = (int*)(a.ws + WS_CNT);
    const int tid = threadIdx.x; int* buf = (int*)lds;
    for (int e = blockIdx.x; e < NE; e += G) {
        __syncthreads();
        const int v = (tid < G) ? histg[tid * NE + e] : 0;
        buf[tid] = v;
        __syncthreads();
        int cur = 0;
#pragma unroll
        for (int o = 1; o < NTHREADS; o <<= 1) {
            const int x = buf[cur * 512 + tid] + ((tid >= o) ? buf[cur * 512 + tid - o] : 0);
            buf[(cur ^ 1) * 512 + tid] = x; cur ^= 1;
            __syncthreads();
        }
        const int incl = buf[cur * 512 + tid];
        if (tid < G) off[tid * NE + e] = incl - v;
        if (tid == NTHREADS - 1) cnt[e] = incl;
    }
}

__device__ __forceinline__ void phase_lists(const Args& a, unsigned char* lds, int G) {
    int* cnt = (int*)(a.ws + WS_CNT); const int* off = (const int*)(a.ws + WS_OFF);
    const int* eidx = (const int*)(a.ws + WS_EIDX); const float* ew = (const float*)(a.ws + WS_EW);
    int* rtok = (int*)(a.ws + WS_RTOK); int* rdst = (int*)(a.ws + WS_RDST); float* rw = (float*)(a.ws + WS_RW);
    const int tid = threadIdx.x;
    int* base = (int*)lds;
    int* cur = base + 512;
    int* sbuf = base + 1024;
    __syncthreads();
    int c = 0, pad = 0;
    if (tid < NE) { c = cnt[tid]; pad = (c + BM - 1) / BM * BM; sbuf[tid] = pad; }
    __syncthreads();
    int curb = 0;
    for (int o = 1; o < NE; o <<= 1) {
        if (tid < NE) { const int x = sbuf[curb * 256 + tid] + ((tid >= o) ? sbuf[curb * 256 + tid - o] : 0); sbuf[(curb ^ 1) * 256 + tid] = x; }
        curb ^= 1;
        __syncthreads();
    }
    if (tid < NE) { const int incl = sbuf[curb * 256 + tid]; base[tid] = incl - pad; if (tid == NE - 1) base[NE] = incl; cur[tid] = incl - pad + off[blockIdx.x * NE + tid]; }
    __syncthreads();
    for (int e = blockIdx.x; e < NE; e += G) {
        const int b0 = base[e], cc = cnt[e], pe = base[e + 1];
        for (int r = b0 + cc + tid; r < pe; r += NTHREADS) { rtok[r] = 0; rdst[r] = -1; rw[r] = 0.f; }
        for (int tl = b0 / BM + tid; tl < pe / BM; tl += NTHREADS) cnt[512 + tl] = e;
    }
    if (blockIdx.x == 0 && tid == 0) cnt[256] = base[NE] / BM;
    const int chunk = (T + G - 1) / G, tbeg = blockIdx.x * chunk, tend = min(T, tbeg + chunk);
    for (int i = tbeg * TOPK + tid; i < tend * TOPK; i += NTHREADS) {
        const int e = eidx[i];
        const int r = atomicAdd(&cur[e], 1);
        rtok[r] = i >> 3; rdst[r] = i; rw[r] = ew[i];
    }
}

__device__ __forceinline__ void phase_moe1(const Args& a, unsigned char* lds, int G) {
    const bf16* A = (const bf16*)(a.ws + WS_H2); const bf16* Bt = (const bf16*)(a.ws + WS_WGT); bf16* H = (bf16*)(a.ws + WS_H);
    const int* cnt = (const int*)(a.ws + WS_CNT); const int* rtok = (const int*)(a.ws + WS_RTOK);
    const int lane = threadIdx.x & 63, wid = threadIdx.x >> 6, wm = wid >> 1, wn = wid & 1, fr = lane & 15, fq = lane >> 4;
    const int ntiles = cnt[256], NU = ntiles * 4;
    for (int u = blockIdx.x; u < NU; u += G) {
        const int tile = u >> 2, j = u & 3, e = cnt[512 + tile];
        f32x4 acc[4][4];
        gemm_tile(lds, A, DM, Bt, DM, DM, RowGather{rtok + tile * BM}, BRowPair{e * 256 + 64 * j, 65536 + e * 256 + 64 * j}, acc);
#pragma unroll
        for (int mt = 0; mt < 4; ++mt) { bf16* rowp = H + (size_t)(tile * BM + wm * 64 + mt * 16 + fr) * FE + 64 * j + 32 * wn + 8 * fq;
            f32x4 r0, r1;
#pragma unroll
            for (int q = 0; q < 4; ++q) { r0[q] = siluf_(acc[mt][0][q]) * acc[mt][2][q]; r1[q] = siluf_(acc[mt][1][q]) * acc[mt][3][q]; }
            store8_bf16(rowp, r0, r1); }
    }
}

__device__ __forceinline__ void phase_moe2(const Args& a, unsigned char* lds, int G) {
    const bf16* H = (const bf16*)(a.ws + WS_H); const bf16* Wd = (const bf16*)(a.ws + WS_WDT); bf16* Y = (bf16*)(a.ws + WS_Y);
    const bf16* hs = (const bf16*)(a.ws + WS_HS); const bf16* Wds = (const bf16*)(a.ws + WS_WDST); bf16* SD = (bf16*)(a.ws + WS_SD);
    const int* cnt = (const int*)(a.ws + WS_CNT); const int* rdst = (const int*)(a.ws + WS_RDST); const float* rw = (const float*)(a.ws + WS_RW);
    const int lane = threadIdx.x & 63, wid = threadIdx.x >> 6, wm = wid >> 1, wn = wid & 1, fr = lane & 15, fq = lane >> 4;
    const int ntiles = cnt[256], NU = ntiles * 8, NS = (T / BM) * 8;
    for (int u = blockIdx.x; u < NU + NS; u += G) {
        f32x4 acc[4][4];
        if (u < NU) {
            const int tile = u >> 3, j = u & 7, e = cnt[512 + tile];
            gemm_tile(lds, H, FE, Wd, FE, FE, RowIdent{tile * BM}, BRowPlain{e * 1024 + j * BN}, acc);
#pragma unroll
            for (int mt = 0; mt < 4; ++mt) {
                const int r = tile * BM + wm * 64 + mt * 16 + fr; const int dst = rdst[r];
                if (dst >= 0) { const float wv = rw[r]; bf16* rowp = Y + (size_t)dst * DM + j * BN + wn * 64 + 8 * fq;
#pragma unroll
                    for (int p = 0; p < 2; ++p) store8_bf16(rowp + 32 * p, acc[mt][2 * p] * wv, acc[mt][2 * p + 1] * wv); }
            }
        } else {
            const int v = u - NU, pm = v >> 3, pn = v & 7;
            gemm_tile(lds, hs, FE, Wds, FE, FE, RowIdent{pm * BM}, BRowPlain{pn * BN}, acc);
#pragma unroll
            for (int mt = 0; mt < 4; ++mt) { bf16* rowp = SD + (size_t)(pm * BM + wm * 64 + mt * 16 + fr) * DM + pn * BN + wn * 64 + 8 * fq;
#pragma unroll
                for (int p = 0; p < 2; ++p) store8_bf16(rowp + 32 * p, acc[mt][2 * p], acc[mt][2 * p + 1]); }
        }
    }
}

__device__ __forceinline__ void phase_final(const Args& a, int G) {
    const float* mod = (const float*)(a.ws + WS_MOD); float* out = a.out;
    const bf16* SD = (const bf16*)(a.ws + WS_SD); const bf16* Y = (const bf16*)(a.ws + WS_Y);
    const float* lg = a.in[21]; const float* lb = a.in[22];
    const int lane = threadIdx.x & 63, wid = threadIdx.x >> 6;
    for (int m = blockIdx.x * NWAVES + wid; m < T; m += G * NWAVES) {
        const int bb = m >> 12; float* rowp = out + (size_t)m * DM;
        f32x4 v[4]; float s = 0.f;
#pragma unroll
        for (int q = 0; q < 4; ++q) {
            const int n = 4 * lane + 256 * q;
            u32x2 w = *(const u32x2*)(SD + (size_t)m * DM + n);
            f32x4 f = (f32x4){bflo(w.x), bfhi(w.x), bflo(w.y), bfhi(w.y)};
#pragma unroll
            for (int k = 0; k < TOPK; ++k) { const u32x2 y = *(const u32x2*)(Y + ((size_t)m * TOPK + k) * DM + n); f[0] += bflo(y.x); f[1] += bfhi(y.x); f[2] += bflo(y.y); f[3] += bfhi(y.y); }
            const f32x4 x1 = *(const f32x4*)(rowp + n);
            v[q] = x1 * ALPHA + (*(const f32x4*)(mod + bb * 6144 + 5120 + n) + 1.0f) * f;
            s += (v[q][0] + v[q][1]) + (v[q][2] + v[q][3]);
        }
        const float mean = wave_sum(s) * (1.0f / DM); float s2 = 0.f;
#pragma unroll
        for (int q = 0; q < 4; ++q) { v[q] = v[q] - mean; s2 += (v[q][0] * v[q][0] + v[q][1] * v[q][1]) + (v[q][2] * v[q][2] + v[q][3] * v[q][3]); }
        const float rstd = rsqrtf(wave_sum(s2) * (1.0f / DM) + LN_EPS);
#pragma unroll
        for (int q = 0; q < 4; ++q) { const int n = 4 * lane + 256 * q; *(f32x4*)(rowp + n) = v[q] * rstd * *(const f32x4*)(lg + n) + *(const f32x4*)(lb + n); }
    }
}

constexpr int NPHASES = 13;
__global__ void __launch_bounds__(NTHREADS, 2) fwd_kernel(Args a) {
    extern __shared__ __attribute__((aligned(16))) unsigned char lds[];
    const int G = gridDim.x;
    volatile LAS unsigned* misc = (volatile LAS unsigned*)(LAS unsigned char*)(lds + LDS_BYTES - 64);
    if (threadIdx.x < 16) misc[threadIdx.x] = 0u;
    __syncthreads();
    XcdBarrier bar; bar.bar = (unsigned*)(a.ws + WS_CTL); bar.x = 0; bar.st = nullptr;
    const bool multi = (a.ph_hi - a.ph_lo) > 1;
    if (multi) bar = xcd_barrier_post((unsigned*)(a.ws + WS_CTL), misc);
#define IN(k) (a.ph_lo <= (k) && (k) < a.ph_hi)
#define SEAM(k) do { if (IN(k) && IN((k) + 1)) xcd_barrier(bar); } while (0)
    if (IN(0)) phase_prep(a, lds, G);
    SEAM(0);
    if (IN(1)) phase_hmod(a, G);
    SEAM(1);
    if (IN(2)) phase_proj(a, lds, G);
    SEAM(2);
    if (IN(3)) phase_mixer(a, lds, G);
    SEAM(3);
    if (IN(4)) phase_wo(a, lds, G);
    SEAM(4);
    if (IN(5)) phase_ln1(a, G);
    SEAM(5);
    if (IN(6)) phase_rs(a, lds, G);
    SEAM(6);
    if (IN(7)) phase_route(a, lds, G);
    SEAM(7);
    if (IN(8)) phase_scan(a, lds, G);
    SEAM(8);
    if (IN(9)) phase_lists(a, lds, G);
    SEAM(9);
    if (IN(10)) phase_moe1(a, lds, G);
    SEAM(10);
    if (IN(11)) phase_moe2(a, lds, G);
    SEAM(11);
    if (IN(12)) phase_final(a, G);
#undef IN
#undef SEAM
}

extern "C" void kernel_launch(void* const* d_in, const int* in_sizes, int n_in, void* d_out, int out_size, void* d_ws, size_t ws_size, hipStream_t stream) {
    static int grid = 0;
    if (grid == 0) {
        if (n_in != 23 || out_size != T * DM || ws_size < WS_END) { fprintf(stderr, "kernel_launch: unexpected shapes (n_in %d out %d ws %zu)\n", n_in, out_size, ws_size); grid = -1; return; }
        int dev = 0, cus = 0;
        if (hipGetDevice(&dev) != hipSuccess || hipDeviceGetAttribute(&cus, hipDeviceAttributeMultiprocessorCount, dev) != hipSuccess) { grid = -1; return; }
        if (hipFuncSetAttribute((const void*)fwd_kernel, hipFuncAttributeMaxDynamicSharedMemorySize, LDS_BYTES) != hipSuccess) { fprintf(stderr, "kernel_launch: hipFuncSetAttribute failed\n"); grid = -1; return; }
        int per_cu = 0;
        (void)hipOccupancyMaxActiveBlocksPerMultiprocessor(&per_cu, (const void*)fwd_kernel, NTHREADS, LDS_BYTES);
        (void)hipGetLastError();
        grid = cus > 512 ? 512 : cus;
        if (per_cu < 1) fprintf(stderr, "kernel_launch: occupancy query reports %d blocks per CU\n", per_cu);
    }
    if (grid < 0) return;
    (void)hipMemsetAsync((char*)d_ws + WS_CTL, 0, CTL_ZERO_BYTES, stream);
    Args a{};
    for (int i = 0; i < 23; ++i) a.in[i] = (const float*)d_in[i];
    a.out = (float*)d_out; a.ws = (unsigned char*)d_ws;
#if N_LAUNCH_MODE == 1
    a.ph_lo = 0; a.ph_hi = NPHASES;
    hipLaunchKernelGGL(fwd_kernel, dim3(grid), dim3(NTHREADS), LDS_BYTES, stream, a);
#else
    for (int p = 0; p < NPHASES; ++p) { a.ph_lo = p; a.ph_hi = p + 1; hipLaunchKernelGGL(fwd_kernel, dim3(grid), dim3(NTHREADS), LDS_BYTES, stream, a); }
#endif
}
```

```cpp
#include <hip/hip_runtime.h>
#include <cstdio>
#include <cstdint>

#define LAS __attribute__((address_space(3)))
typedef unsigned short bf16;
typedef short bf16x8 __attribute__((ext_vector_type(8)));
typedef short bf16x4v __attribute__((ext_vector_type(4)));
typedef float f32x4 __attribute__((ext_vector_type(4)));
typedef unsigned u32x4 __attribute__((ext_vector_type(4)));
typedef unsigned u32x2 __attribute__((ext_vector_type(2)));

#ifndef N_LAUNCH_MODE
#define N_LAUNCH_MODE 1
#endif

constexpr int NB = 8, SEQ = 4096, DM = 1024, T = NB * SEQ;
constexpr int HD = 64, NQH = 8, NKVH = 2;
constexpr int INC = 1792, QW = 1280;
constexpr int NE = 256, TOPK = 8, FE = 256;
constexpr int CK = 31, CW = 512;
constexpr int BM = 256, BN = 128;
constexpr int MAXROWS = T * TOPK + NE * BM;
constexpr int MAXTILES = MAXROWS / BM;
constexpr float LN_EPS = 1e-5f;
constexpr float ALPHA = 1.18920711500272106672f;
constexpr int NTHREADS = 512, NWAVES = 8;
constexpr int LDS_BYTES = 147456;

constexpr size_t MiB = 1u << 20;
constexpr size_t WS_CTL = 0, CTL_ZERO_BYTES = 64 * 1024;
constexpr size_t WS_MOD = 1 * MiB;
constexpr size_t WS_CNT = 1 * MiB + 256 * 1024;
constexpr size_t WS_HIST = 2 * MiB;
constexpr size_t WS_OFF = 3 * MiB;
constexpr size_t WS_EIDX = 4 * MiB;
constexpr size_t WS_EW = 5 * MiB;
constexpr size_t WS_RTOK = 6 * MiB;
constexpr size_t WS_RDST = 8 * MiB;
constexpr size_t WS_RW = 10 * MiB;
constexpr size_t WS_WINT = 12 * MiB;
constexpr size_t WS_WOT = 16 * MiB;
constexpr size_t WS_WCAT = 18 * MiB;
constexpr size_t WS_WDST = 20 * MiB;
constexpr size_t WS_WDT = 24 * MiB;
constexpr size_t WS_H = 152 * MiB;
constexpr size_t WS_HS = 312 * MiB;
constexpr size_t WS_SD = 328 * MiB;
constexpr size_t WS_Y = 392 * MiB;
constexpr size_t WS_WGT = 392 * MiB;
constexpr size_t WS_WUT = 520 * MiB;
constexpr size_t WS_H2 = 648 * MiB;
constexpr size_t WS_QKVG = 712 * MiB;
constexpr size_t WS_AC = 792 * MiB;
constexpr size_t WS_LOG = 856 * MiB;
constexpr size_t WS_END = 904 * MiB;

__device__ __forceinline__ unsigned f2bf(float f) { unsigned u = __float_as_uint(f); return (u + 0x7fffu + ((u >> 16) & 1u)) >> 16; }
__device__ __forceinline__ unsigned pk2(float lo, float hi) { return f2bf(lo) | (f2bf(hi) << 16); }
__device__ __forceinline__ float bf2f(unsigned h) { return __uint_as_float(h << 16); }
__device__ __forceinline__ float bflo(unsigned w) { return __uint_as_float(w << 16); }
__device__ __forceinline__ float bfhi(unsigned w) { return __uint_as_float(w & 0xffff0000u); }
__device__ __forceinline__ float sigmoidf_(float v) { return 1.0f / (1.0f + __expf(-v)); }
__device__ __forceinline__ float siluf_(float v) { return v / (1.0f + __expf(-v)); }
__device__ __forceinline__ float wave_sum(float v) {
#pragma unroll
    for (int o = 1; o < 64; o <<= 1) v += __shfl_xor(v, o);
    return v;
}
__device__ __forceinline__ int perm32(int rho) { const int n = rho >> 4, i = rho & 15; return 8 * (i >> 2) + 4 * n + (i & 3); }

#define XB_TMO      128
#define XB_XCNT(j)  (256  + 64 * (j))
#define XB_XSUB(j)  (1280 + 64 * (j))
#define XB_XGEN(j)  (2304 + 64 * (j))
#define XB_TOP      3328
#define XB_TOPGEN   3392
#define XCD_BAR_WORDS 3456
#define XB_SPIN_CAP (1u << 22)
__device__ __forceinline__ unsigned xb_ld(unsigned* p)              { return __hip_atomic_load(p, __ATOMIC_RELAXED, __HIP_MEMORY_SCOPE_AGENT); }
__device__ __forceinline__ unsigned xb_add(unsigned* p, unsigned v) { return __hip_atomic_fetch_add(p, v, __ATOMIC_RELAXED, __HIP_MEMORY_SCOPE_AGENT); }
__device__ __forceinline__ unsigned xb_xcc_id() { return (unsigned)__builtin_amdgcn_s_getreg((3 << 11) | 20) & 0xFu; }
#define XB_SPIN(cond, bar) do { unsigned _sp = 0; while (cond) { __builtin_amdgcn_s_sleep(1); \
    if ((++_sp & 255u) == 0u) { if (xb_ld(&(bar)[XB_TMO])) break; if (_sp > XB_SPIN_CAP) { atomicAdd(&(bar)[XB_TMO], 1u); break; } } } } while (0)
struct XcdBarrier { unsigned* bar; unsigned x; volatile LAS unsigned* st; };
__device__ __forceinline__ XcdBarrier xcd_barrier_post(unsigned* bar, volatile LAS unsigned* st) {
    XcdBarrier b; b.bar = bar; b.x = xb_xcc_id(); b.st = st;
    if (threadIdx.x == 0) (void)xb_add(&bar[XB_XCNT(b.x)], 1u);
    return b;
}
__device__ __forceinline__ void xcd_barrier_complete(unsigned* bar, unsigned x, unsigned& nloc, unsigned& nx) {
    const unsigned G = gridDim.x * gridDim.y * gridDim.z;
    unsigned sum, cnt, mine, sp = 0u;
    for (;;) {
        sum = 0u; cnt = 0u; mine = 0u;
#pragma unroll
        for (unsigned j = 0; j < 16; ++j) { const unsigned c = xb_ld(&bar[XB_XCNT(j)]); sum += c; cnt += (c > 0u) ? 1u : 0u; mine = (j == x) ? c : mine; }
        if (sum == G) break;
        __builtin_amdgcn_s_sleep(1);
        if ((++sp & 255u) == 0u) { if (xb_ld(&bar[XB_TMO])) break; if (sp > XB_SPIN_CAP) { atomicAdd(&bar[XB_TMO], 1u); break; } }
    }
    nloc = mine > 0u ? mine : 1u; nx = cnt > 0u ? cnt : 1u;
}
__device__ __forceinline__ void xcd_barrier(const XcdBarrier& b) {
    asm volatile("s_waitcnt vmcnt(0)" ::: "memory");
    __syncthreads();
    if (threadIdx.x == 0) {
        unsigned* bar = b.bar;
        __builtin_amdgcn_s_waitcnt(0);
        unsigned nloc = b.st[0], nx = b.st[1];
        if (nloc == 0u) { xcd_barrier_complete(bar, b.x, nloc, nx); b.st[0] = nloc; b.st[1] = nx; }
        const unsigned old = xb_add(&bar[XB_XSUB(b.x)], 1u);
        const unsigned gen = old / nloc;
        if (old + 1u == (gen + 1u) * nloc) {
            __builtin_amdgcn_fence(__ATOMIC_RELEASE, "agent");
            asm volatile("s_waitcnt vmcnt(0)" ::: "memory");
            const unsigned og = xb_add(&bar[XB_TOP], 1u);
            const unsigned tg = og / nx;
            if (og + 1u == (tg + 1u) * nx) xb_add(&bar[XB_TOPGEN], 1u);
            else XB_SPIN(xb_ld(&bar[XB_TOPGEN]) == tg, bar);
            __builtin_amdgcn_fence(__ATOMIC_ACQUIRE, "agent");
            xb_add(&bar[XB_XGEN(b.x)], 1u);
            asm volatile("s_waitcnt vmcnt(0)" ::: "memory");
        } else {
            XB_SPIN(xb_ld(&bar[XB_XGEN(b.x)]) == gen, bar);
            __builtin_amdgcn_fence(__ATOMIC_ACQUIRE, "agent");
            asm volatile("s_waitcnt vmcnt(0)" ::: "memory");
        }
    }
    __syncthreads();
}

struct Args {
    const float* in[23];
    float* out;
    unsigned char* ws;
    int ph_lo, ph_hi;
};

constexpr int STAGE_BYTES = 49152;
#define GLDS16(gp, lp) __builtin_amdgcn_global_load_lds((const unsigned*)(gp), (unsigned*)(lp), 16, 0, 0)

template <class ARow, class BRow>
__device__ __forceinline__ void gemm_tile(unsigned char* lds, const bf16* A, int lda, const bf16* Bt, int ldb, int K, const ARow& arow, const BRow& brow, f32x4 (&acc)[4][4]) {
    const int tid = threadIdx.x, lane = tid & 63, wid = __builtin_amdgcn_readfirstlane(tid >> 6), wm = wid >> 1, wn = wid & 1;
    const int lr = lane >> 3, lc = lane & 7, fr = lane & 15, fq = lane >> 4;
    const int swz = (lc ^ lr) * 16;
    const char* ap[4]; const char* bp[2];
#pragma unroll
    for (int i = 0; i < 4; ++i) { const int r = (wid * 4 + i) * 8 + lr; ap[i] = (const char*)(A + (size_t)arow(r) * lda) + swz; }
#pragma unroll
    for (int i = 0; i < 2; ++i) { const int r = (wid * 2 + i) * 8 + lr; bp[i] = (const char*)(Bt + (size_t)brow(r) * ldb) + swz; }
#pragma unroll
    for (int a = 0; a < 4; ++a)
#pragma unroll
        for (int b = 0; b < 4; ++b) acc[a][b] = (f32x4){0.f, 0.f, 0.f, 0.f};
    const int p0 = (fq ^ (lane & 7)) * 16;
    const int aoff = (wm * 64 + fr) * 128 + p0;
    const int boff = 32768 + (wn * 64 + fr) * 128 + p0;
    const int nk = K / 64;
#define GEMM_ISSUE(s, kb) do { unsigned char* _st = lds + (s) * STAGE_BYTES; \
        _Pragma("unroll") for (int _i = 0; _i < 4; ++_i) GLDS16(ap[_i] + (kb), _st + (wid * 4 + _i) * 1024); \
        _Pragma("unroll") for (int _i = 0; _i < 2; ++_i) GLDS16(bp[_i] + (kb), _st + 32768 + (wid * 2 + _i) * 1024); } while (0)
    __syncthreads();
    GEMM_ISSUE(0, 0);
    for (int t = 0; t < nk; ++t) {
        asm volatile("s_waitcnt vmcnt(0)" ::: "memory");
        __syncthreads();
        if (t + 1 < nk) GEMM_ISSUE((t + 1) & 1, (t + 1) * 128);
        const unsigned char* st = lds + (t & 1) * STAGE_BYTES;
#pragma unroll
        for (int kk = 0; kk < 2; ++kk) {
            bf16x8 af[4], bfr[4];
#pragma unroll
            for (int mt = 0; mt < 4; ++mt) af[mt] = *(const bf16x8*)(st + ((aoff ^ (kk * 64)) + mt * 2048));
#pragma unroll
            for (int nt = 0; nt < 4; ++nt) bfr[nt] = *(const bf16x8*)(st + ((boff ^ (kk * 64)) + nt * 2048));
#pragma unroll
            for (int mt = 0; mt < 4; ++mt)
#pragma unroll
                for (int nt = 0; nt < 4; ++nt) acc[mt][nt] = __builtin_amdgcn_mfma_f32_16x16x32_bf16(bfr[nt], af[mt], acc[mt][nt], 0, 0, 0);
        }
    }
#undef GEMM_ISSUE
}

struct RowIdent { int base; __device__ __forceinline__ int operator()(int r) const { return base + r; } };
struct RowGather { const int* idx; __device__ __forceinline__ int operator()(int r) const { return idx[r]; } };
struct BRowPlain { int n0; __device__ __forceinline__ int operator()(int rho) const { return n0 + (rho & ~31) + perm32(rho & 31); } };
struct BRowPair { int g0, u0; __device__ __forceinline__ int operator()(int rho) const { const int c = 32 * (rho >> 6) + perm32(rho & 31); return g0 + ((rho >> 5) & 1) * (u0 - g0) + c; } };

__device__ __forceinline__ void store8_bf16(bf16* p, const f32x4& a, const f32x4& b) {
    u32x4 w; w.x = pk2(a[0], a[1]); w.y = pk2(a[2], a[3]); w.z = pk2(b[0], b[1]); w.w = pk2(b[2], b[3]); *(u32x4*)p = w;
}

__device__ __forceinline__ void transpose_item(const float* src, int K, int N, bf16* dst, int item, float* scr, int lane) {
    const int nblk = N / 64, kb = item / nblk, nb = item % nblk, k0 = kb * 64, n0 = nb * 64;
#pragma unroll 8
    for (int i = 0; i < 64; ++i) scr[i * 65 + lane] = src[(size_t)(k0 + i) * N + n0 + lane];
    asm volatile("s_waitcnt lgkmcnt(0)" ::: "memory");
    const int c = lane & 7;
#pragma unroll
    for (int j = 0; j < 8; ++j) {
        const int n = (lane >> 3) + 8 * j; const float* s = scr + (8 * c) * 65 + n;
        u32x4 o; o.x = pk2(s[0], s[65]); o.y = pk2(s[2 * 65], s[3 * 65]); o.z = pk2(s[4 * 65], s[5 * 65]); o.w = pk2(s[6 * 65], s[7 * 65]);
        *(u32x4*)(dst + (size_t)(n0 + n) * K + k0 + 8 * c) = o;
    }
    asm volatile("s_waitcnt lgkmcnt(0)" ::: "memory");
}

__device__ __forceinline__ void phase_prep(const Args& a, unsigned char* lds, int G) {
    const int tid = threadIdx.x, lane = tid & 63, wid = tid >> 6, bx = blockIdx.x;
    unsigned char* ws = a.ws;
    {
        float* sc = (float*)lds;
        float* red = (float*)(lds + 32768);
        const float* c = a.in[1]; const float* w_ada = a.in[2]; const float* b_ada = a.in[3];
        float* mod = (float*)(ws + WS_MOD);
        for (int cb = bx; cb < 6144 / 32; cb += G) {
            __syncthreads();
            for (int i = tid; i < 8 * 1024; i += NTHREADS) sc[i] = siluf_(c[i]);
            __syncthreads();
            const int kg = tid >> 5, cl = tid & 31, col = cb * 32 + cl;
            float acc[8];
#pragma unroll
            for (int b = 0; b < 8; ++b) acc[b] = 0.f;
            for (int k = kg; k < 1024; k += 16) {
                const float wv = w_ada[(size_t)k * 6144 + col];
#pragma unroll
                for (int b = 0; b < 8; ++b) acc[b] += sc[b * 1024 + k] * wv;
            }
#pragma unroll
            for (int b = 0; b < 8; ++b) red[(kg * 8 + b) * 32 + cl] = acc[b];
            __syncthreads();
            if (tid < 256) {
                const int b = tid >> 5; float s = 0.f;
#pragma unroll
                for (int g = 0; g < 16; ++g) s += red[(g * 8 + b) * 32 + cl];
                mod[b * 6144 + col] = s + b_ada[col];
            }
        }
        __syncthreads();
    }
    {
        float* scr = (float*)(lds + wid * 16640);
        const int gw = bx * NWAVES + wid, NGW = G * NWAVES;
        constexpr int I_IN = 16 * 28, I_O = 16 * 16, I_S = 16 * 4, I_DS = 4 * 16, I_E = 16 * 4 * NE;
        constexpr int NITEMS = I_IN + I_O + 3 * I_S + I_DS + 3 * I_E;
        for (int it = gw; it < NITEMS; it += NGW) {
            int r = it;
            if (r < I_IN) { transpose_item(a.in[4], 1024, INC, (bf16*)(ws + WS_WINT), r, scr, lane); continue; } r -= I_IN;
            if (r < I_O) { transpose_item(a.in[10], 1024, 1024, (bf16*)(ws + WS_WOT), r, scr, lane); continue; } r -= I_O;
            if (r < I_S) { transpose_item(a.in[13], 1024, 256, (bf16*)(ws + WS_WCAT), r, scr, lane); continue; } r -= I_S;
            if (r < I_S) { transpose_item(a.in[18], 1024, 256, (bf16*)(ws + WS_WCAT) + 256 * 1024, r, scr, lane); continue; } r -= I_S;
            if (r < I_S) { transpose_item(a.in[19], 1024, 256, (bf16*)(ws + WS_WCAT) + 512 * 1024, r, scr, lane); continue; } r -= I_S;
            if (r < I_DS) { transpose_item(a.in[20], 256, 1024, (bf16*)(ws + WS_WDST), r, scr, lane); continue; } r -= I_DS;
            if (r < I_E) { const int e = r >> 6; transpose_item(a.in[15] + (size_t)e * 262144, 1024, 256, (bf16*)(ws + WS_WGT) + (size_t)e * 262144, r & 63, scr, lane); continue; } r -= I_E;
            if (r < I_E) { const int e = r >> 6; transpose_item(a.in[16] + (size_t)e * 262144, 1024, 256, (bf16*)(ws + WS_WUT) + (size_t)e * 262144, r & 63, scr, lane); continue; } r -= I_E;
            { const int e = r >> 6; transpose_item(a.in[17] + (size_t)e * 262144, 256, 1024, (bf16*)(ws + WS_WDT) + (size_t)e * 262144, r & 63, scr, lane); }
        }
    }
}

__device__ __forceinline__ void phase_hmod(const Args& a, int G) {
    const float* x = a.in[0]; const float* mod = (const float*)(a.ws + WS_MOD); bf16* h = (bf16*)(a.ws + WS_H2);
    const size_t nchunk = (size_t)T * DM / 8;
    for (size_t i = (size_t)blockIdx.x * NTHREADS + threadIdx.x; i < nchunk; i += (size_t)G * NTHREADS) {
        const size_t e0 = i * 8; const int row = (int)(e0 >> 10), col = (int)(e0 & 1023), b = row >> 12;
        const f32x4 v0 = *(const f32x4*)(x + e0), v1 = *(const f32x4*)(x + e0 + 4);
        const float* sh = mod + b * 6144 + col; const float* sc = sh + 1024;
        const f32x4 s0 = *(const f32x4*)sc, s1 = *(const f32x4*)(sc + 4), h0 = *(const f32x4*)sh, h1 = *(const f32x4*)(sh + 4);
        const f32x4 r0 = v0 * (s0 + 1.0f) + h0, r1 = v1 * (s1 + 1.0f) + h1;
        store8_bf16(h + e0, r0, r1);
    }
}

__device__ __forceinline__ void phase_proj(const Args& a, unsigned char* lds, int G) {
    const bf16* A = (const bf16*)(a.ws + WS_H2); const bf16* Bt = (const bf16*)(a.ws + WS_WINT); bf16* O = (bf16*)(a.ws + WS_QKVG);
    const int lane = threadIdx.x & 63, wid = threadIdx.x >> 6, wm = wid >> 1, wn = wid & 1, fr = lane & 15, fq = lane >> 4;
    constexpr int NT = 14, NU = (T / BM) * NT;
    for (int u = blockIdx.x; u < NU; u += G) {
        const int pm = u / NT, pn = u % NT;
        f32x4 acc[4][4];
        if (pn < 6) {
            gemm_tile(lds, A, DM, Bt, DM, DM, RowIdent{pm * BM}, BRowPlain{pn * BN}, acc);
#pragma unroll
            for (int mt = 0; mt < 4; ++mt) { bf16* rowp = O + (size_t)(pm * BM + wm * 64 + mt * 16 + fr) * QW + pn * BN + wn * 64 + 8 * fq;
#pragma unroll
                for (int p = 0; p < 2; ++p) store8_bf16(rowp + 32 * p, acc[mt][2 * p], acc[mt][2 * p + 1]); }
        } else {
            const int j = pn - 6;
            gemm_tile(lds, A, DM, Bt, DM, DM, RowIdent{pm * BM}, BRowPair{768 + 64 * j, 1280 + 64 * j}, acc);
#pragma unroll
            for (int mt = 0; mt < 4; ++mt) { bf16* rowp = O + (size_t)(pm * BM + wm * 64 + mt * 16 + fr) * QW + 768 + 64 * j + 32 * wn + 8 * fq;
                f32x4 r0, r1;
#pragma unroll
                for (int q = 0; q < 4; ++q) { r0[q] = acc[mt][0][q] * sigmoidf_(acc[mt][2][q]); r1[q] = acc[mt][1][q] * sigmoidf_(acc[mt][3][q]); }
                store8_bf16(rowp, r0, r1); }
        }
    }
}

constexpr int VT_STRIDE = 280;
__device__ __forceinline__ void attn_unit(const Args& a, unsigned char* lds, int unit) {
    const bf16* QK = (const bf16*)(a.ws + WS_QKVG); bf16* AC = (bf16*)(a.ws + WS_AC);
    const int tid = threadIdx.x, lane = tid & 63, w = __builtin_amdgcn_readfirstlane(tid >> 6), fr = lane & 15, fq = lane >> 4;
    const int kh = unit & 1, nblk = (unit >> 1) & 31, b = unit >> 6;
    const int tok0 = b * SEQ + nblk * 128;
    unsigned char* Kl = lds;
    bf16* Vt = (bf16*)(lds + 272 * 128);
    __syncthreads();
#pragma unroll 1
    for (int idx = tid; idx < 272 * 8; idx += NTHREADS) {
        const int key = idx >> 3, c = idx & 7;
        u32x4 kv = (u32x4){0u, 0u, 0u, 0u}, vv = (u32x4){0u, 0u, 0u, 0u};
        if (key < 256 && (nblk > 0 || key >= 128)) {
            const bf16* rowp = QK + (size_t)(tok0 - 128 + key) * QW + 512 + 64 * kh + 8 * c;
            kv = *(const u32x4*)rowp; vv = *(const u32x4*)(rowp + 128);
        }
        *(u32x4*)(Kl + key * 128 + ((c ^ (key & 7)) * 16)) = kv;
        bf16* vp = Vt + (8 * c) * VT_STRIDE + key;
        vp[0] = (bf16)(vv.x & 0xffffu); vp[VT_STRIDE] = (bf16)(vv.x >> 16);
        vp[2 * VT_STRIDE] = (bf16)(vv.y & 0xffffu); vp[3 * VT_STRIDE] = (bf16)(vv.y >> 16);
        vp[4 * VT_STRIDE] = (bf16)(vv.z & 0xffffu); vp[5 * VT_STRIDE] = (bf16)(vv.z >> 16);
        vp[6 * VT_STRIDE] = (bf16)(vv.w & 0xffffu); vp[7 * VT_STRIDE] = (bf16)(vv.w >> 16);
    }
    __syncthreads();
    const float* sinks = a.in[5];
#pragma unroll 1
    for (int g = 0; g < 4; ++g) {
        const int h = kh * 4 + g;
        int lofs = 0; asm volatile("" : "+v"(lofs));
        const float slope = exp2f(-(float)(h + 1)), sink = sinks[h];
        const bf16* qp = QK + (size_t)(tok0 + 16 * w + fr) * QW + 64 * h + 8 * fq;
        const bf16x8 q0 = *(const bf16x8*)qp, q1 = *(const bf16x8*)(qp + 32);
        f32x4 st[10];
#pragma unroll
        for (int i = 0; i < 10; ++i) {
            const int key = 16 * (w + i) + fr;
            const unsigned char* kp = Kl + key * 128 + lofs;
            const bf16x8 k0 = *(const bf16x8*)(kp + ((fq ^ (fr & 7)) * 16)), k1 = *(const bf16x8*)(kp + (((fq + 4) ^ (fr & 7)) * 16));
            f32x4 s = (f32x4){0.f, 0.f, 0.f, 0.f};
            s = __builtin_amdgcn_mfma_f32_16x16x32_bf16(k0, q0, s, 0, 0, 0);
            s = __builtin_amdgcn_mfma_f32_16x16x32_bf16(k1, q1, s, 0, 0, 0);
            st[i] = s;
        }
        float mx = -INFINITY;
#pragma unroll
        for (int i = 0; i < 10; ++i)
#pragma unroll
            for (int r = 0; r < 4; ++r) {
                const int dist = 128 + fr - 16 * i - 4 * fq - r;
                const int kj = 16 * (w + i) + 4 * fq + r;
                const bool valid = (dist >= 0) && (dist < 128) && (nblk > 0 || kj >= 128);
                const float s = valid ? (st[i][r] * 0.125f - slope * (float)dist) : -INFINITY;
                st[i][r] = s; mx = fmaxf(mx, s);
            }
        mx = fmaxf(mx, __shfl_xor(mx, 16)); mx = fmaxf(mx, __shfl_xor(mx, 32));
        mx = fmaxf(mx, sink);
        float sum = 0.f;
#pragma unroll
        for (int i = 0; i < 10; ++i)
#pragma unroll
            for (int r = 0; r < 4; ++r) { const float p = __expf(st[i][r] - mx); st[i][r] = p; sum += p; }
        sum += __shfl_xor(sum, 16); sum += __shfl_xor(sum, 32);
        const float inv = 1.0f / (sum + __expf(sink - mx));
        f32x4 o[4];
#pragma unroll
        for (int nt = 0; nt < 4; ++nt) o[nt] = (f32x4){0.f, 0.f, 0.f, 0.f};
#pragma unroll
        for (int s5 = 0; s5 < 5; ++s5) {
            u32x4 pw; pw.x = pk2(st[2 * s5][0], st[2 * s5][1]); pw.y = pk2(st[2 * s5][2], st[2 * s5][3]); pw.z = pk2(st[2 * s5 + 1][0], st[2 * s5 + 1][1]); pw.w = pk2(st[2 * s5 + 1][2], st[2 * s5 + 1][3]);
            const bf16x8 pf = __builtin_bit_cast(bf16x8, pw);
#pragma unroll
            for (int nt = 0; nt < 4; ++nt) {
                const bf16* vp = Vt + (16 * nt + fr) * VT_STRIDE + 16 * (w + 2 * s5) + 4 * fq + lofs;
                const u32x2 va = *(const u32x2*)vp, vb = *(const u32x2*)(vp + 16);
                u32x4 vw; vw.x = va.x; vw.y = va.y; vw.z = vb.x; vw.w = vb.y;
                o[nt] = __builtin_amdgcn_mfma_f32_16x16x32_bf16(__builtin_bit_cast(bf16x8, vw), pf, o[nt], 0, 0, 0);
            }
        }
        bf16* op = AC + (size_t)(tok0 + 16 * w + fr) * DM + 64 * h + 4 * fq;
#pragma unroll
        for (int nt = 0; nt < 4; ++nt) { u32x2 ow; ow.x = pk2(o[nt][0] * inv, o[nt][1] * inv); ow.y = pk2(o[nt][2] * inv, o[nt][3] * inv); *(u32x2*)(op + 16 * nt) = ow; }
    }
}

__device__ __forceinline__ void conv_unit(const Args& a, unsigned char* lds, int unit) {
    const bf16* QK = (const bf16*)(a.ws + WS_QKVG); bf16* AC = (bf16*)(a.ws + WS_AC);
    const int tid = threadIdx.x, lane = tid & 63, wid = tid >> 6;
    const int t0 = unit * 32, b = t0 >> 12, s0 = t0 & 4095, c = tid;
    bf16* inp = (bf16*)lds;
    float* yb = (float*)(lds + 62 * CW * 2);
    __syncthreads();
    for (int idx = tid; idx < 62 * 64; idx += NTHREADS) {
        const int i = idx >> 6, ch = idx & 63, s = s0 - 30 + i;
        u32x4 v = (u32x4){0u, 0u, 0u, 0u};
        if (s >= 0) v = *(const u32x4*)(QK + (size_t)(b * SEQ + s) * QW + 768 + 8 * ch);
        *(u32x4*)(inp + i * CW + 8 * ch) = v;
    }
    const float* cw = a.in[6];
    float wgt[CK];
#pragma unroll
    for (int j = 0; j < CK; ++j) wgt[j] = cw[j * CW + c];
    float acc[32];
    const float bias = a.in[7][c];
#pragma unroll
    for (int t = 0; t < 32; ++t) acc[t] = bias;
    __syncthreads();
#pragma unroll
    for (int i = 0; i < 62; ++i) {
        const float v = bf2f(inp[i * CW + c]);
#pragma unroll
        for (int t = 0; t < 32; ++t) { const int j = i - t; if (j >= 0 && j < CK) acc[t] += v * wgt[j]; }
    }
#pragma unroll
    for (int t = 0; t < 32; ++t) yb[t * CW + c] = acc[t];
    __syncthreads();
    const float* lg = a.in[8]; const float* lb = a.in[9];
    const f32x4 g0 = *(const f32x4*)(lg + 8 * lane), g1 = *(const f32x4*)(lg + 8 * lane + 4), b0 = *(const f32x4*)(lb + 8 * lane), b1 = *(const f32x4*)(lb + 8 * lane + 4);
#pragma unroll
    for (int q = 0; q < 4; ++q) {
        const int t = wid * 4 + q;
        f32x4 v0 = *(const f32x4*)(yb + t * CW + 8 * lane), v1 = *(const f32x4*)(yb + t * CW + 8 * lane + 4);
        const float mean = wave_sum((v0[0] + v0[1]) + (v0[2] + v0[3]) + (v1[0] + v1[1]) + (v1[2] + v1[3])) * (1.0f / CW);
        v0 = v0 - mean; v1 = v1 - mean;
        const float var = wave_sum((v0[0] * v0[0] + v0[1] * v0[1]) + (v0[2] * v0[2] + v0[3] * v0[3]) + (v1[0] * v1[0] + v1[1] * v1[1]) + (v1[2] * v1[2] + v1[3] * v1[3])) * (1.0f / CW);
        const float rstd = rsqrtf(var + LN_EPS);
        f32x4 r0 = v0 * rstd * g0 + b0, r1 = v1 * rstd * g1 + b1;
#pragma unroll
        for (int e = 0; e < 4; ++e) { r0[e] = siluf_(r0[e]); r1[e] = siluf_(r1[e]); }
        store8_bf16(AC + (size_t)(t0 + t) * DM + 512 + 8 * lane, r0, r1);
    }
}

__device__ __forceinline__ void phase_mixer(const Args& a, unsigned char* lds, int G) {
    for (int u = blockIdx.x; u < NB * 32 * NKVH; u += G) attn_unit(a, lds, u);
    for (int u = blockIdx.x; u < T / 32; u += G) conv_unit(a, lds, u);
}

__device__ __forceinline__ void phase_wo(const Args& a, unsigned char* lds, int G) {
    const bf16* A = (const bf16*)(a.ws + WS_AC); const bf16* Bt = (const bf16*)(a.ws + WS_WOT);
    const float* x = a.in[0]; const float* mod = (const float*)(a.ws + WS_MOD); float* out = a.out;
    const int lane = threadIdx.x & 63, wid = threadIdx.x >> 6, wm = wid >> 1, wn = wid & 1, fr = lane & 15, fq = lane >> 4;
    constexpr int NT = 8, NU = (T / BM) * NT;
    for (int u = blockIdx.x; u < NU; u += G) {
        const int pm = u / NT, pn = u % NT;
        f32x4 acc[4][4];
        gemm_tile(lds, A, DM, Bt, DM, DM, RowIdent{pm * BM}, BRowPlain{pn * BN}, acc);
#pragma unroll
        for (int mt = 0; mt < 4; ++mt) {
            const int m = pm * BM + wm * 64 + mt * 16 + fr, bb = m >> 12;
#pragma unroll
            for (int p = 0; p < 2; ++p) {
                const int n = pn * BN + wn * 64 + 32 * p + 8 * fq;
                const float* g1 = mod + bb * 6144 + 2048 + n;
                const size_t off = (size_t)m * DM + n;
                const f32x4 x0 = *(const f32x4*)(x + off), x1 = *(const f32x4*)(x + off + 4), ga = *(const f32x4*)g1, gb = *(const f32x4*)(g1 + 4);
                *(f32x4*)(out + off) = x0 * ALPHA + (ga + 1.0f) * acc[mt][2 * p];
                *(f32x4*)(out + off + 4) = x1 * ALPHA + (gb + 1.0f) * acc[mt][2 * p + 1];
            }
        }
    }
}

__device__ __forceinline__ void phase_ln1(const Args& a, int G) {
    const float* mod = (const float*)(a.ws + WS_MOD); float* out = a.out; bf16* h2 = (bf16*)(a.ws + WS_H2);
    const float* lg = a.in[11]; const float* lb = a.in[12];
    const int lane = threadIdx.x & 63, wid = threadIdx.x >> 6;
    for (int m = blockIdx.x * NWAVES + wid; m < T; m += G * NWAVES) {
        const int bb = m >> 12; float* rowp = out + (size_t)m * DM;
        f32x4 v[4]; float s = 0.f;
#pragma unroll
        for (int q = 0; q < 4; ++q) { v[q] = *(const f32x4*)(rowp + 4 * lane + 256 * q); s += (v[q][0] + v[q][1]) + (v[q][2] + v[q][3]); }
        const float mean = wave_sum(s) * (1.0f / DM); float s2 = 0.f;
#pragma unroll
        for (int q = 0; q < 4; ++q) { v[q] = v[q] - mean; s2 += (v[q][0] * v[q][0] + v[q][1] * v[q][1]) + (v[q][2] * v[q][2] + v[q][3] * v[q][3]); }
        const float rstd = rsqrtf(wave_sum(s2) * (1.0f / DM) + LN_EPS);
#pragma unroll
        for (int q = 0; q < 4; ++q) {
            const int n = 4 * lane + 256 * q;
            const f32x4 x1 = v[q] * rstd * *(const f32x4*)(lg + n) + *(const f32x4*)(lb + n);
            *(f32x4*)(rowp + n) = x1;
            const f32x4 hh = x1 * (*(const f32x4*)(mod + bb * 6144 + 4096 + n) + 1.0f) + *(const f32x4*)(mod + bb * 6144 + 3072 + n);
            u32x2 w; w.x = pk2(hh[0], hh[1]); w.y = pk2(hh[2], hh[3]); *(u32x2*)(h2 + (size_t)m * DM + n) = w;
        }
    }
}

__device__ __forceinline__ void phase_rs(const Args& a, unsigned char* lds, int G) {
    const bf16* A = (const bf16*)(a.ws + WS_H2); const bf16* Bt = (const bf16*)(a.ws + WS_WCAT);
    float* logits = (float*)(a.ws + WS_LOG); bf16* hs = (bf16*)(a.ws + WS_HS);
    const int lane = threadIdx.x & 63, wid = threadIdx.x >> 6, wm = wid >> 1, wn = wid & 1, fr = lane & 15, fq = lane >> 4;
    constexpr int NT = 6, NU = (T / BM) * NT;
    for (int u = blockIdx.x; u < NU; u += G) {
        const int pm = u / NT, pn = u % NT;
        f32x4 acc[4][4];
        if (pn < 2) {
            gemm_tile(lds, A, DM, Bt, DM, DM, RowIdent{pm * BM}, BRowPlain{pn * BN}, acc);
#pragma unroll
            for (int mt = 0; mt < 4; ++mt) { float* rowp = logits + (size_t)(pm * BM + wm * 64 + mt * 16 + fr) * NE + pn * BN + wn * 64 + 8 * fq;
#pragma unroll
                for (int p = 0; p < 2; ++p) { *(f32x4*)(rowp + 32 * p) = acc[mt][2 * p]; *(f32x4*)(rowp + 32 * p + 4) = acc[mt][2 * p + 1]; } }
        } else {
            const int j = pn - 2;
            gemm_tile(lds, A, DM, Bt, DM, DM, RowIdent{pm * BM}, BRowPair{256 + 64 * j, 512 + 64 * j}, acc);
#pragma unroll
            for (int mt = 0; mt < 4; ++mt) { bf16* rowp = hs + (size_t)(pm * BM + wm * 64 + mt * 16 + fr) * FE + 64 * j + 32 * wn + 8 * fq;
                f32x4 r0, r1;
#pragma unroll
                for (int q = 0; q < 4; ++q) { r0[q] = siluf_(acc[mt][0][q]) * acc[mt][2][q]; r1[q] = siluf_(acc[mt][1][q]) * acc[mt][3][q]; }
                store8_bf16(rowp, r0, r1); }
        }
    }
}

__device__ __forceinline__ void phase_route(const Args& a, unsigned char* lds, int G) {
    const float* logits = (const float*)(a.ws + WS_LOG); const float* rbias = a.in[14];
    int* eidx = (int*)(a.ws + WS_EIDX); float* ew = (float*)(a.ws + WS_EW); int* histg = (int*)(a.ws + WS_HIST);
    const int tid = threadIdx.x, lane = tid & 63, wid = tid >> 6;
    int* hist = (int*)lds;
    __syncthreads();
    if (tid < NE) hist[tid] = 0;
    __syncthreads();
    const int chunk = (T + G - 1) / G, tbeg = blockIdx.x * chunk, tend = min(T, tbeg + chunk);
    const f32x4 bv = *(const f32x4*)(rbias + 4 * lane);
    for (int t = tbeg + wid; t < tend; t += NWAVES) {
        const f32x4 lg = *(const f32x4*)(logits + (size_t)t * NE + 4 * lane);
        float sc[4], sel[4];
#pragma unroll
        for (int i = 0; i < 4; ++i) { sc[i] = sigmoidf_(lg[i]); sel[i] = sc[i] + bv[i]; }
        float a1 = fmaxf(sel[0], sel[1]), a2 = fminf(sel[0], sel[1]);
        { const float c1 = fmaxf(sel[2], sel[3]), c2 = fminf(sel[2], sel[3]); const float n1 = fmaxf(a1, c1), n2 = fmaxf(fminf(a1, c1), fmaxf(a2, c2)); a1 = n1; a2 = n2; }
#pragma unroll
        for (int o = 1; o < 8; o <<= 1) { const float c1 = __shfl_xor(a1, o), c2 = __shfl_xor(a2, o); const float n1 = fmaxf(a1, c1), n2 = fmaxf(fminf(a1, c1), fmaxf(a2, c2)); a1 = n1; a2 = n2; }
        const float gs = a1 + a2; const int mg = lane >> 3; int rank = 0;
#pragma unroll
        for (int g = 0; g < 8; ++g) { const float o = __shfl(gs, 8 * g); rank += (o > gs || (o == gs && g < mg)) ? 1 : 0; }
        const bool gsel = rank < 4;
        float v[4];
#pragma unroll
        for (int i = 0; i < 4; ++i) v[i] = gsel ? sel[i] : -INFINITY;
        int my_e = 0; float my_w = 0.f, wsum = 0.f;
#pragma unroll
        for (int r = 0; r < TOPK; ++r) {
            float bvv = v[0]; int bi = 0;
#pragma unroll
            for (int i = 1; i < 4; ++i) if (v[i] > bvv) { bvv = v[i]; bi = i; }
            int bidx = 4 * lane + bi;
#pragma unroll
            for (int o = 1; o < 64; o <<= 1) { const float ov = __shfl_xor(bvv, o); const int oi = __shfl_xor(bidx, o); if (ov > bvv || (ov == bvv && oi < bidx)) { bvv = ov; bidx = oi; } }
            const int owner = bidx >> 2, oi = bidx & 3;
            const float mys = (oi == 0) ? sc[0] : (oi == 1) ? sc[1] : (oi == 2) ? sc[2] : sc[3];
            const float wv = __shfl(mys, owner);
            if (lane == owner) {
#pragma unroll
                for (int i = 0; i < 4; ++i) if (i == oi) v[i] = -INFINITY;
            }
            wsum += wv;
            if (lane == r) { my_e = bidx; my_w = wv; }
        }
        if (lane < TOPK) {
            eidx[(size_t)t * TOPK + lane] = my_e;
            ew[(size_t)t * TOPK + lane] = my_w / wsum * 2.5f;
            atomicAdd(&hist[my_e], 1);
        }
    }
    __syncthreads();
    if (tid < NE) histg[blockIdx.x * NE + tid] = hist[tid];
}

__device__ __forceinline__ void phase_scan(const Args& a, unsigned char* lds, int G) {
    const int* histg = (const int*)(a.ws + WS_HIST); int* off = (int*)(a.ws + WS_OFF); int* cnt = (int*)(a.ws + WS_CNT);
    const int tid = threadIdx.x; int* buf = (int*)lds;
    for (int e = blockIdx.x; e < NE; e += G) {
        __syncthreads();
        const int v = (tid < G) ? histg[tid * NE + e] : 0;
        buf[tid] = v;
        __syncthreads();
        int cur = 0;
#pragma unroll
        for (int o = 1; o < NTHREADS; o <<= 1) {
            const int x = buf[cur * 512 + tid] + ((tid >= o) ? buf[cur * 512 + tid - o] : 0);
            buf[(cur ^ 1) * 512 + tid] = x; cur ^= 1;
            __syncthreads();
        }
        const int incl = buf[cur * 512 + tid];
        if (tid < G) off[tid * NE + e] = incl - v;
        if (tid == NTHREADS - 1) cnt[e] = incl;
    }
}

__device__ __forceinline__ void phase_lists(const Args& a, unsigned char* lds, int G) {
    int* cnt = (int*)(a.ws + WS_CNT); const int* off = (const int*)(a.ws + WS_OFF);
    const int* eidx = (const int*)(a.ws + WS_EIDX); const float* ew = (const float*)(a.ws + WS_EW);
    int* rtok = (int*)(a.ws + WS_RTOK); int* rdst = (int*)(a.ws + WS_RDST); float* rw = (float*)(a.ws + WS_RW);
    const int tid = threadIdx.x;
    int* base = (int*)lds;
    int* cur = base + 512;
    int* sbuf = base + 1024;
    __syncthreads();
    int c = 0, pad = 0;
    if (tid < NE) { c = cnt[tid]; pad = (c + BM - 1) / BM * BM; sbuf[tid] = pad; }
    __syncthreads();
    int curb = 0;
    for (int o = 1; o < NE; o <<= 1) {
        if (tid < NE) { const int x = sbuf[curb * 256 + tid] + ((tid >= o) ? sbuf[curb * 256 + tid - o] : 0); sbuf[(curb ^ 1) * 256 + tid] = x; }
        curb ^= 1;
        __syncthreads();
    }
    if (tid < NE) { const int incl = sbuf[curb * 256 + tid]; base[tid] = incl - pad; if (tid == NE - 1) base[NE] = incl; cur[tid] = incl - pad + off[blockIdx.x * NE + tid]; }
    __syncthreads();
    for (int e = blockIdx.x; e < NE; e += G) {
        const int b0 = base[e], cc = cnt[e], pe = base[e + 1];
        for (int r = b0 + cc + tid; r < pe; r += NTHREADS) { rtok[r] = 0; rdst[r] = -1; rw[r] = 0.f; }
        for (int tl = b0 / BM + tid; tl < pe / BM; tl += NTHREADS) cnt[512 + tl] = e;
    }
    if (blockIdx.x == 0 && tid == 0) cnt[256] = base[NE] / BM;
    const int chunk = (T + G - 1) / G, tbeg = blockIdx.x * chunk, tend = min(T, tbeg + chunk);
    for (int i = tbeg * TOPK + tid; i < tend * TOPK; i += NTHREADS) {
        const int e = eidx[i];
        const int r = atomicAdd(&cur[e], 1);
        rtok[r] = i >> 3; rdst[r] = i; rw[r] = ew[i];
    }
}

__device__ __forceinline__ void phase_moe1(const Args& a, unsigned char* lds, int G) {
    const bf16* A = (const bf16*)(a.ws + WS_H2); const bf16* Bt = (const bf16*)(a.ws + WS_WGT); bf16* H = (bf16*)(a.ws + WS_H);
    const int* cnt = (const int*)(a.ws + WS_CNT); const int* rtok = (const int*)(a.ws + WS_RTOK);
    const int lane = threadIdx.x & 63, wid = threadIdx.x >> 6, wm = wid >> 1, wn = wid & 1, fr = lane & 15, fq = lane >> 4;
    const int ntiles = cnt[256], NU = ntiles * 4;
    for (int u = blockIdx.x; u < NU; u += G) {
        const int tile = u >> 2, j = u & 3, e = cnt[512 + tile];
        f32x4 acc[4][4];
        gemm_tile(lds, A, DM, Bt, DM, DM, RowGather{rtok + tile * BM}, BRowPair{e * 256 + 64 * j, 65536 + e * 256 + 64 * j}, acc);
#pragma unroll
        for (int mt = 0; mt < 4; ++mt) { bf16* rowp = H + (size_t)(tile * BM + wm * 64 + mt * 16 + fr) * FE + 64 * j + 32 * wn + 8 * fq;
            f32x4 r0, r1;
#pragma unroll
            for (int q = 0; q < 4; ++q) { r0[q] = siluf_(acc[mt][0][q]) * acc[mt][2][q]; r1[q] = siluf_(acc[mt][1][q]) * acc[mt][3][q]; }
            store8_bf16(rowp, r0, r1); }
    }
}

__device__ __forceinline__ void phase_moe2(const Args& a, unsigned char* lds, int G) {
    const bf16* H = (const bf16*)(a.ws + WS_H); const bf16* Wd = (const bf16*)(a.ws + WS_WDT); bf16* Y = (bf16*)(a.ws + WS_Y);
    const bf16* hs = (const bf16*)(a.ws + WS_HS); const bf16* Wds = (const bf16*)(a.ws + WS_WDST); bf16* SD = (bf16*)(a.ws + WS_SD);
    const int* cnt = (const int*)(a.ws + WS_CNT); const int* rdst = (const int*)(a.ws + WS_RDST); const float* rw = (const float*)(a.ws + WS_RW);
    const int lane = threadIdx.x & 63, wid = threadIdx.x >> 6, wm = wid >> 1, wn = wid & 1, fr = lane & 15, fq = lane >> 4;
    const int ntiles = cnt[256], NU = ntiles * 8, NS = (T / BM) * 8;
    for (int u = blockIdx.x; u < NU + NS; u += G) {
        f32x4 acc[4][4];
        if (u < NU) {
            const int tile = u >> 3, j = u & 7, e = cnt[512 + tile];
            gemm_tile(lds, H, FE, Wd, FE, FE, RowIdent{tile * BM}, BRowPlain{e * 1024 + j * BN}, acc);
#pragma unroll
            for (int mt = 0; mt < 4; ++mt) {
                const int r = tile * BM + wm * 64 + mt * 16 + fr; const int dst = rdst[r];
                if (dst >= 0) { const float wv = rw[r]; bf16* rowp = Y + (size_t)dst * DM + j * BN + wn * 64 + 8 * fq;
#pragma unroll
                    for (int p = 0; p < 2; ++p) store8_bf16(rowp + 32 * p, acc[mt][2 * p] * wv, acc[mt][2 * p + 1] * wv); }
            }
        } else {
            const int v = u - NU, pm = v >> 3, pn = v & 7;
            gemm_tile(lds, hs, FE, Wds, FE, FE, RowIdent{pm * BM}, BRowPlain{pn * BN}, acc);
#pragma unroll
            for (int mt = 0; mt < 4; ++mt) { bf16* rowp = SD + (size_t)(pm * BM + wm * 64 + mt * 16 + fr) * DM + pn * BN + wn * 64 + 8 * fq;
#pragma unroll
                for (int p = 0; p < 2; ++p) store8_bf16(rowp + 32 * p, acc[mt][2 * p], acc[mt][2 * p + 1]); }
        }
    }
}

__device__ __forceinline__ void phase_final(const Args& a, int G) {
    const float* mod = (const float*)(a.ws + WS_MOD); float* out = a.out;
    const bf16* SD = (const bf16*)(a.ws + WS_SD); const bf16* Y = (const bf16*)(a.ws + WS_Y);
    const float* lg = a.in[21]; const float* lb = a.in[22];
    const int lane = threadIdx.x & 63, wid = threadIdx.x >> 6;
    for (int m = blockIdx.x * NWAVES + wid; m < T; m += G * NWAVES) {
        const int bb = m >> 12; float* rowp = out + (size_t)m * DM;
        f32x4 v[4]; float s = 0.f;
#pragma unroll
        for (int q = 0; q < 4; ++q) {
            const int n = 4 * lane + 256 * q;
            u32x2 w = *(const u32x2*)(SD + (size_t)m * DM + n);
            f32x4 f = (f32x4){bflo(w.x), bfhi(w.x), bflo(w.y), bfhi(w.y)};
#pragma unroll
            for (int k = 0; k < TOPK; ++k) { const u32x2 y = *(const u32x2*)(Y + ((size_t)m * TOPK + k) * DM + n); f[0] += bflo(y.x); f[1] += bfhi(y.x); f[2] += bflo(y.y); f[3] += bfhi(y.y); }
            const f32x4 x1 = *(const f32x4*)(rowp + n);
            v[q] = x1 * ALPHA + (*(const f32x4*)(mod + bb * 6144 + 5120 + n) + 1.0f) * f;
            s += (v[q][0] + v[q][1]) + (v[q][2] + v[q][3]);
        }
        const float mean = wave_sum(s) * (1.0f / DM); float s2 = 0.f;
#pragma unroll
        for (int q = 0; q < 4; ++q) { v[q] = v[q] - mean; s2 += (v[q][0] * v[q][0] + v[q][1] * v[q][1]) + (v[q][2] * v[q][2] + v[q][3] * v[q][3]); }
        const float rstd = rsqrtf(wave_sum(s2) * (1.0f / DM) + LN_EPS);
#pragma unroll
        for (int q = 0; q < 4; ++q) { const int n = 4 * lane + 256 * q; *(f32x4*)(rowp + n) = v[q] * rstd * *(const f32x4*)(lg + n) + *(const f32x4*)(lb + n); }
    }
}

constexpr int NPHASES = 13;
__global__ void __launch_bounds__(NTHREADS, 2) fwd_kernel(Args a) {
    extern __shared__ __attribute__((aligned(16))) unsigned char lds[];
    const int G = gridDim.x;
    volatile LAS unsigned* misc = (volatile LAS unsigned*)(LAS unsigned char*)(lds + LDS_BYTES - 64);
    if (threadIdx.x < 16) misc[threadIdx.x] = 0u;
    __syncthreads();
    XcdBarrier bar; bar.bar = (unsigned*)(a.ws + WS_CTL); bar.x = 0; bar.st = nullptr;
    const bool multi = (a.ph_hi - a.ph_lo) > 1;
    if (multi) bar = xcd_barrier_post((unsigned*)(a.ws + WS_CTL), misc);
#define IN(k) (a.ph_lo <= (k) && (k) < a.ph_hi)
#define SEAM(k) do { if (IN(k) && IN((k) + 1)) xcd_barrier(bar); } while (0)
    if (IN(0)) phase_prep(a, lds, G);
    SEAM(0);
    if (IN(1)) phase_hmod(a, G);
    SEAM(1);
    if (IN(2)) phase_proj(a, lds, G);
    SEAM(2);
    if (IN(3)) phase_mixer(a, lds, G);
    SEAM(3);
    if (IN(4)) phase_wo(a, lds, G);
    SEAM(4);
    if (IN(5)) phase_ln1(a, G);
    SEAM(5);
    if (IN(6)) phase_rs(a, lds, G);
    SEAM(6);
    if (IN(7)) phase_route(a, lds, G);
    SEAM(7);
    if (IN(8)) phase_scan(a, lds, G);
    SEAM(8);
    if (IN(9)) phase_lists(a, lds, G);
    SEAM(9);
    if (IN(10)) phase_moe1(a, lds, G);
    SEAM(10);
    if (IN(11)) phase_moe2(a, lds, G);
    SEAM(11);
    if (IN(12)) phase_final(a, G);
#undef IN
#undef SEAM
}

extern "C" void kernel_launch(void* const* d_in, const int* in_sizes, int n_in, void* d_out, int out_size, void* d_ws, size_t ws_size, hipStream_t stream) {
    static int grid = 0;
    if (grid == 0) {
        if (n_in != 23 || out_size != T * DM || ws_size < WS_END) { fprintf(stderr, "kernel_launch: unexpected shapes (n_in %d out %d ws %zu)\n", n_in, out_size, ws_size); grid = -1; return; }
        int dev = 0, cus = 0;
        if (hipGetDevice(&dev) != hipSuccess || hipDeviceGetAttribute(&cus, hipDeviceAttributeMultiprocessorCount, dev) != hipSuccess) { grid = -1; return; }
        if (hipFuncSetAttribute((const void*)fwd_kernel, hipFuncAttributeMaxDynamicSharedMemorySize, LDS_BYTES) != hipSuccess) { fprintf(stderr, "kernel_launch: hipFuncSetAttribute failed\n"); grid = -1; return; }
        int per_cu = 0;
        (void)hipOccupancyMaxActiveBlocksPerMultiprocessor(&per_cu, (const void*)fwd_kernel, NTHREADS, LDS_BYTES);
        (void)hipGetLastError();
        grid = cus > 512 ? 512 : cus;
        if (per_cu < 1) fprintf(stderr, "kernel_launch: occupancy query reports %d blocks per CU\n", per_cu);
    }
    if (grid < 0) return;
    (void)hipMemsetAsync((char*)d_ws + WS_CTL, 0, CTL_ZERO_BYTES, stream);
    Args a{};
    for (int i = 0; i < 23; ++i) a.in[i] = (const float*)d_in[i];
    a.out = (float*)d_out; a.ws = (unsigned char*)d_ws;
#if N_LAUNCH_MODE == 1
    a.ph_lo = 0; a.ph_hi = NPHASES;
    hipLaunchKernelGGL(fwd_kernel, dim3(grid), dim3(NTHREADS), LDS_BYTES, stream, a);
#else
    for (int p = 0; p < NPHASES; ++p) { a.ph_lo = p; a.ph_hi = p + 1; hipLaunchKernelGGL(fwd_kernel, dim3(grid), dim3(NTHREADS), LDS_BYTES, stream, a); }
#endif
}
```

```cpp
#include <hip/hip_runtime.h>
#include <cstdio>
#include <cstdint>

#define LAS __attribute__((address_space(3)))
typedef unsigned short bf16;
typedef short bf16x8 __attribute__((ext_vector_type(8)));
typedef short bf16x4v __attribute__((ext_vector_type(4)));
typedef float f32x4 __attribute__((ext_vector_type(4)));
typedef unsigned u32x4 __attribute__((ext_vector_type(4)));
typedef unsigned u32x2 __attribute__((ext_vector_type(2)));

#ifndef N_LAUNCH_MODE
#define N_LAUNCH_MODE 1
#endif

constexpr int NB = 8, SEQ = 4096, DM = 1024, T = NB * SEQ;
constexpr int HD = 64, NQH = 8, NKVH = 2;
constexpr int INC = 1792, QW = 1280;
constexpr int NE = 256, TOPK = 8, FE = 256;
constexpr int CK = 31, CW = 512;
constexpr int BM = 256, BN = 128;
constexpr int MAXROWS = T * TOPK + NE * BM;
constexpr int MAXTILES = MAXROWS / BM;
constexpr float LN_EPS = 1e-5f;
constexpr float ALPHA = 1.18920711500272106672f;
constexpr int NTHREADS = 512, NWAVES = 8;
constexpr int LDS_BYTES = 147456;

constexpr size_t MiB = 1u << 20;
constexpr size_t WS_CTL = 0, CTL_ZERO_BYTES = 64 * 1024;
constexpr size_t WS_MOD = 1 * MiB;
constexpr size_t WS_CNT = 1 * MiB + 256 * 1024;
constexpr size_t WS_HIST = 2 * MiB;
constexpr size_t WS_OFF = 3 * MiB;
constexpr size_t WS_EIDX = 4 * MiB;
constexpr size_t WS_EW = 5 * MiB;
constexpr size_t WS_RTOK = 6 * MiB;
constexpr size_t WS_RDST = 8 * MiB;
constexpr size_t WS_RW = 10 * MiB;
constexpr size_t WS_WINT = 12 * MiB;
constexpr size_t WS_WOT = 16 * MiB;
constexpr size_t WS_WCAT = 18 * MiB;
constexpr size_t WS_WDST = 20 * MiB;
constexpr size_t WS_WDT = 24 * MiB;
constexpr size_t WS_H = 152 * MiB;
constexpr size_t WS_HS = 312 * MiB;
constexpr size_t WS_SD = 328 * MiB;
constexpr size_t WS_Y = 392 * MiB;
constexpr size_t WS_WGT = 392 * MiB;
constexpr size_t WS_WUT = 520 * MiB;
constexpr size_t WS_H2 = 648 * MiB;
constexpr size_t WS_QKVG = 712 * MiB;
constexpr size_t WS_AC = 792 * MiB;
constexpr size_t WS_LOG = 856 * MiB;
constexpr size_t WS_END = 904 * MiB;

__device__ __forceinline__ unsigned f2bf(float f) { unsigned u = __float_as_uint(f); return (u + 0x7fffu + ((u >> 16) & 1u)) >> 16; }
__device__ __forceinline__ unsigned pk2(float lo, float hi) { return f2bf(lo) | (f2bf(hi) << 16); }
__device__ __forceinline__ float bf2f(unsigned h) { return __uint_as_float(h << 16); }
__device__ __forceinline__ float bflo(unsigned w) { return __uint_as_float(w << 16); }
__device__ __forceinline__ float bfhi(unsigned w) { return __uint_as_float(w & 0xffff0000u); }
__device__ __forceinline__ float sigmoidf_(float v) { return 1.0f / (1.0f + __expf(-v)); }
__device__ __forceinline__ float siluf_(float v) { return v / (1.0f + __expf(-v)); }
__device__ __forceinline__ float wave_sum(float v) {
#pragma unroll
    for (int o = 1; o < 64; o <<= 1) v += __shfl_xor(v, o);
    return v;
}
__device__ __forceinline__ int perm32(int rho) { const int n = rho >> 4, i = rho & 15; return 8 * (i >> 2) + 4 * n + (i & 3); }

#define XB_TMO      128
#define XB_XCNT(j)  (256  + 64 * (j))
#define XB_XSUB(j)  (1280 + 64 * (j))
#define XB_XGEN(j)  (2304 + 64 * (j))
#define XB_TOP      3328
#define XB_TOPGEN   3392
#define XCD_BAR_WORDS 3456
#define XB_SPIN_CAP (1u << 22)
__device__ __forceinline__ unsigned xb_ld(unsigned* p)              { return __hip_atomic_load(p, __ATOMIC_RELAXED, __HIP_MEMORY_SCOPE_AGENT); }
__device__ __forceinline__ unsigned xb_add(unsigned* p, unsigned v) { return __hip_atomic_fetch_add(p, v, __ATOMIC_RELAXED, __HIP_MEMORY_SCOPE_AGENT); }
__device__ __forceinline__ unsigned xb_xcc_id() { return (unsigned)__builtin_amdgcn_s_getreg((3 << 11) | 20) & 0xFu; }
#define XB_SPIN(cond, bar) do { unsigned _sp = 0; while (cond) { __builtin_amdgcn_s_sleep(1); \
    if ((++_sp & 255u) == 0u) { if (xb_ld(&(bar)[XB_TMO])) break; if (_sp > XB_SPIN_CAP) { atomicAdd(&(bar)[XB_TMO], 1u); break; } } } } while (0)
struct XcdBarrier { unsigned* bar; unsigned x; volatile LAS unsigned* st; };
__device__ __forceinline__ XcdBarrier xcd_barrier_post(unsigned* bar, volatile LAS unsigned* st) {
    XcdBarrier b; b.bar = bar; b.x = xb_xcc_id(); b.st = st;
    if (threadIdx.x == 0) (void)xb_add(&bar[XB_XCNT(b.x)], 1u);
    return b;
}
__device__ __forceinline__ void xcd_barrier_complete(unsigned* bar, unsigned x, unsigned& nloc, unsigned& nx) {
    const unsigned G = gridDim.x * gridDim.y * gridDim.z;
    unsigned sum, cnt, mine, sp = 0u;
    for (;;) {
        sum = 0u; cnt = 0u; mine = 0u;
#pragma unroll
        for (unsigned j = 0; j < 16; ++j) { const unsigned c = xb_ld(&bar[XB_XCNT(j)]); sum += c; cnt += (c > 0u) ? 1u : 0u; mine = (j == x) ? c : mine; }
        if (sum == G) break;
        __builtin_amdgcn_s_sleep(1);
        if ((++sp & 255u) == 0u) { if (xb_ld(&bar[XB_TMO])) break; if (sp > XB_SPIN_CAP) { atomicAdd(&bar[XB_TMO], 1u); break; } }
    }
    nloc = mine > 0u ? mine : 1u; nx = cnt > 0u ? cnt : 1u;
}
__device__ __forceinline__ void xcd_barrier(const XcdBarrier& b) {
    asm volatile("s_waitcnt vmcnt(0)" ::: "memory");
    __syncthreads();
    if (threadIdx.x == 0) {
        unsigned* bar = b.bar;
        __builtin_amdgcn_s_waitcnt(0);
        unsigned nloc = b.st[0], nx = b.st[1];
        if (nloc == 0u) { xcd_barrier_complete(bar, b.x, nloc, nx); b.st[0] = nloc; b.st[1] = nx; }
        const unsigned old = xb_add(&bar[XB_XSUB(b.x)], 1u);
        const unsigned gen = old / nloc;
        if (old + 1u == (gen + 1u) * nloc) {
            __builtin_amdgcn_fence(__ATOMIC_RELEASE, "agent");
            asm volatile("s_waitcnt vmcnt(0)" ::: "memory");
            const unsigned og = xb_add(&bar[XB_TOP], 1u);
            const unsigned tg = og / nx;
            if (og + 1u == (tg + 1u) * nx) xb_add(&bar[XB_TOPGEN], 1u);
            else XB_SPIN(xb_ld(&bar[XB_TOPGEN]) == tg, bar);
            __builtin_amdgcn_fence(__ATOMIC_ACQUIRE, "agent");
            xb_add(&bar[XB_XGEN(b.x)], 1u);
            asm volatile("s_waitcnt vmcnt(0)" ::: "memory");
        } else {
            XB_SPIN(xb_ld(&bar[XB_XGEN(b.x)]) == gen, bar);
            __builtin_amdgcn_fence(__ATOMIC_ACQUIRE, "agent");
            asm volatile("s_waitcnt vmcnt(0)" ::: "memory");
        }
    }
    __syncthreads();
}

struct Args {
    const float* in[23];
    float* out;
    unsigned char* ws;
    int ph_lo, ph_hi;
};

namespace pg {
constexpr int HALF = 128, HTB = HALF * 64 * 2, PG_STAGE_BYTES = 8 * HTB;
__device__ __forceinline__ int lds_byte(int r, int c) { const int st = (r >> 4) * 2 + (c >> 5), rr = r & 15, cc = c & 31, ob = rr * 64 + cc * 2; return st * 1024 + (ob ^ (((ob >> 9) & 1) << 5)); }
__device__ __forceinline__ void stage_rc(int b, int& R, int& C) { const int st = b / 1024, sb = b % 1024, swz = sb ^ (((sb >> 9) & 1) << 5); R = (st >> 1) * 16 + swz / 64; C = (st & 1) * 32 + (swz % 64) / 2; }
struct Unit { unsigned a, b0, b1; int r0, c, aux; };
typedef __amdgpu_buffer_rsrc_t rsrc_t;

template <class Epi, class Sched, bool GATHER>
__device__ __forceinline__ void gemm_phase(LAS unsigned char* lds, unsigned char* wsbase, const int K, const Sched& S, const Epi& E) {
    const rsrc_t rs = __builtin_amdgcn_make_buffer_rsrc((void*)wsbase, 0, 0x7fffffff, 0x00020000);
    const int tid = threadIdx.x, wid = __builtin_amdgcn_readfirstlane(tid >> 6), lane = tid & 63, wr = wid >> 2, wc = wid & 3, fr = lane & 15, fq = lane >> 4;
    const int nt = K / 64;
    int Rr[2], Cc[2]; unsigned voffB[2], vA[2][2], nvA[2][2];
#pragma unroll
    for (int i = 0; i < 2; ++i) { stage_rc(tid * 16 + i * 8192, Rr[i], Cc[i]); const int Rb = (Rr[i] & ~31) + perm32(Rr[i] & 31); voffB[i] = (unsigned)(Rb * K + Cc[i]) * 2u; }
    const unsigned kstep = 128;
    const unsigned ldsw = (unsigned)wid * 1024u;
    const int aoff = lds_byte(wr * 64 + fr, fq * 8), boff = lds_byte(wc * 32 + fr, fq * 8);
#define PG_SA(b, h) (((b) * 2 + (h)) * pg::HTB)
#define PG_SB(b, h) ((4 + (b) * 2 + (h)) * pg::HTB)
#define PG_STG(bufoff, gbase, v0, v1) do { \
        __builtin_amdgcn_raw_ptr_buffer_load_lds(rs, (LAS unsigned*)(lds + (bufoff) + ldsw), 16, (int)(v0), (int)(gbase), 0, 0); \
        __builtin_amdgcn_raw_ptr_buffer_load_lds(rs, (LAS unsigned*)(lds + (bufoff) + ldsw + 8192), 16, (int)(v1), (int)(gbase), 0, 0); } while (0)
#define PG_STGB(bufoff, gbase) PG_STG(bufoff, gbase, voffB[0], voffB[1])
#define PG_LDA(dst, b, h) do { _Pragma("unroll") for (int m = 0; m < 4; ++m) _Pragma("unroll") for (int k = 0; k < 2; ++k) dst[m][k] = *(const LAS bf16x8*)(lds + PG_SA(b, h) + aoff + m * 2048 + k * 1024); } while (0)
#define PG_LDB(dst, b, h) do { _Pragma("unroll") for (int n = 0; n < 2; ++n) _Pragma("unroll") for (int k = 0; k < 2; ++k) dst[n][k] = *(const LAS bf16x8*)(lds + PG_SB(b, h) + boff + n * 2048 + k * 1024); } while (0)
#define PG_MMA(ai, bj, At, Bt) do { __builtin_amdgcn_s_setprio(1); _Pragma("unroll") for (int m = 0; m < 4; ++m) _Pragma("unroll") for (int n = 0; n < 2; ++n) _Pragma("unroll") for (int k = 0; k < 2; ++k) \
        acc[ai][bj][m][n] = __builtin_amdgcn_mfma_f32_16x16x32_bf16(Bt[n][k], At[m][k], acc[ai][bj][m][n], 0, 0, 0); __builtin_amdgcn_s_setprio(0); } while (0)
#define PG_WAIT_V(n) asm volatile("s_waitcnt vmcnt(" #n ")" ::: "memory")
#define PG_WAIT_L(n) asm volatile("s_waitcnt lgkmcnt(" #n ")" ::: "memory")
#define PG_BAR __builtin_amdgcn_s_barrier()
#define PG_SCHED __builtin_amdgcn_sched_barrier(0)
#define PG_VA(dst, u) do { _Pragma("unroll") for (int h = 0; h < 2; ++h) _Pragma("unroll") for (int i = 0; i < 2; ++i) \
        dst[h][i] = GATHER ? (unsigned)(S.row(u, h * pg::HALF + Rr[i]) * K + Cc[i]) * 2u : (unsigned)((h * pg::HALF + Rr[i]) * K + Cc[i]) * 2u; } while (0)
    Unit cur, nxt; int ui = 0;
    if (!S.next(0, cur)) return;
    f32x4 acc[2][2][4][2];
#pragma unroll
    for (int a = 0; a < 2; ++a)
#pragma unroll
        for (int b = 0; b < 2; ++b)
#pragma unroll
            for (int m = 0; m < 4; ++m)
#pragma unroll
                for (int n = 0; n < 2; ++n) acc[a][b][m][n] = (f32x4){0.f, 0.f, 0.f, 0.f};
    bf16x8 At[4][2], B0[2][2], B1[2][2];
    PG_VA(vA, cur);
#pragma unroll
    for (int h = 0; h < 2; ++h)
#pragma unroll
        for (int i = 0; i < 2; ++i) nvA[h][i] = vA[h][i];
    unsigned cA = cur.a, cB0 = cur.b0, cB1 = cur.b1;
    PG_STGB(PG_SB(0, 0), cB0); PG_STGB(PG_SB(0, 1), cB1); PG_STG(PG_SA(0, 0), cA, vA[0][0], vA[0][1]); PG_STG(PG_SA(0, 1), cA, vA[1][0], vA[1][1]);
    if (wr == 1) PG_BAR;
    PG_WAIT_V(2); PG_BAR;
    PG_STGB(PG_SB(1, 0), cB0 + kstep); PG_STG(PG_SA(1, 0), cA + kstep, vA[0][0], vA[0][1]); PG_STGB(PG_SB(1, 1), cB1 + kstep);
    PG_WAIT_V(6); PG_BAR;
    for (;;) {
        const bool has_next = S.next(ui + 1, nxt);
        const unsigned nA = has_next ? nxt.a : cA, nB0 = has_next ? nxt.b0 : cB0, nB1 = has_next ? nxt.b1 : cB1;
        for (int t = 0; t < nt; t += 2) {
            const bool last = (t == nt - 2);
            const unsigned a1 = cA + (unsigned)(t + 1) * kstep;
            const unsigned a2 = last ? nA : cA + (unsigned)(t + 2) * kstep;
            const unsigned b20 = last ? nB0 : cB0 + (unsigned)(t + 2) * kstep, b21 = last ? nB1 : cB1 + (unsigned)(t + 2) * kstep;
            const unsigned a3 = a2 + kstep, b30 = b20 + kstep, b31 = b21 + kstep;
            unsigned wA[2][2];
            if (GATHER) {
                if (last && has_next) PG_VA(nvA, nxt);
#pragma unroll
                for (int h = 0; h < 2; ++h)
#pragma unroll
                    for (int i = 0; i < 2; ++i) wA[h][i] = (last && has_next) ? nvA[h][i] : vA[h][i];
            } else {
#pragma unroll
                for (int h = 0; h < 2; ++h)
#pragma unroll
                    for (int i = 0; i < 2; ++i) wA[h][i] = vA[h][i];
            }
            PG_LDB(B0, 0, 0); PG_LDB(B1, 0, 1); PG_SCHED; PG_LDA(At, 0, 0); PG_STG(PG_SA(1, 1), a1, vA[1][0], vA[1][1]);
            PG_WAIT_V(8); PG_WAIT_L(0); PG_BAR; PG_MMA(0, 0, At, B0); PG_MMA(0, 1, At, B1); PG_BAR; PG_SCHED;
            PG_LDA(At, 0, 1); PG_STGB(PG_SB(0, 0), b20); PG_STGB(PG_SB(0, 1), b21); PG_STG(PG_SA(0, 0), a2, wA[0][0], wA[0][1]);
            PG_WAIT_V(8); PG_WAIT_L(0); PG_BAR; PG_MMA(1, 0, At, B0); PG_MMA(1, 1, At, B1); PG_BAR; PG_SCHED;
            PG_LDB(B0, 1, 0); PG_LDB(B1, 1, 1); PG_SCHED; PG_LDA(At, 1, 0); PG_STG(PG_SA(0, 1), a2, wA[1][0], wA[1][1]);
            PG_WAIT_V(8); PG_WAIT_L(0); PG_BAR; PG_MMA(0, 0, At, B0); PG_MMA(0, 1, At, B1); PG_BAR; PG_SCHED;
            PG_LDA(At, 1, 1); PG_STGB(PG_SB(1, 0), b30); PG_STGB(PG_SB(1, 1), b31); PG_STG(PG_SA(1, 0), a3, wA[0][0], wA[0][1]);
            PG_WAIT_V(8); PG_WAIT_L(0); PG_BAR; PG_MMA(1, 0, At, B0); PG_MMA(1, 1, At, B1); PG_BAR; PG_SCHED;
        }
        if (wr == 0) PG_BAR;
        E(acc, cur, wr, wc, fr, fq);
        if (!has_next) break;
#pragma unroll
        for (int a = 0; a < 2; ++a)
#pragma unroll
            for (int b = 0; b < 2; ++b)
#pragma unroll
                for (int m = 0; m < 4; ++m)
#pragma unroll
                    for (int n = 0; n < 2; ++n) acc[a][b][m][n] = (f32x4){0.f, 0.f, 0.f, 0.f};
        cur = nxt; cA = nA; cB0 = nB0; cB1 = nB1; ++ui;
        if (GATHER) {
#pragma unroll
            for (int h = 0; h < 2; ++h)
#pragma unroll
                for (int i = 0; i < 2; ++i) vA[h][i] = nvA[h][i];
        }
        if (wr == 1) PG_BAR;
    }
    PG_WAIT_V(0);
    PG_BAR;
#undef PG_SA
#undef PG_SB
#undef PG_STG
#undef PG_STGB
#undef PG_LDA
#undef PG_LDB
#undef PG_MMA
#undef PG_WAIT_V
#undef PG_WAIT_L
#undef PG_BAR
#undef PG_SCHED
#undef PG_VA
}
}

struct XcdSplit {
    int NU, G, bx;
    __device__ __forceinline__ bool unit(int i, int& u) const {
        if (G & 7) { u = bx + i * G; return u < NU; }
        const int x = bx & 7, li = bx >> 3, per = G >> 3, q = NU >> 3, r = NU & 7;
        const int start = x * q + (x < r ? x : r), len = q + (x < r ? 1 : 0), k = li + i * per;
        if (k >= len) return false;
        u = start + k; return true;
    }
};
__device__ __forceinline__ void dense_pmpn(int idx, int nN, int& pm, int& pn) { const int nig = 8 * nN, gid = idx / nig, rem = idx % nig; pm = gid * 8 + (rem & 7); pn = rem >> 3; }

__device__ __forceinline__ void store8_bf16(bf16* p, const f32x4& a, const f32x4& b) {
    u32x4 w; w.x = pk2(a[0], a[1]); w.y = pk2(a[2], a[3]); w.z = pk2(b[0], b[1]); w.w = pk2(b[2], b[3]); *(u32x4*)p = w;
}
typedef f32x4 acc_t[2][2][4][2];

__device__ __forceinline__ void transpose_item(const float* src, int K, int N, bf16* dst, int item, float* scr, int lane) {
    const int nblk = N / 64, kb = item / nblk, nb = item % nblk, k0 = kb * 64, n0 = nb * 64;
#pragma unroll 8
    for (int i = 0; i < 64; ++i) scr[i * 65 + lane] = src[(size_t)(k0 + i) * N + n0 + lane];
    asm volatile("s_waitcnt lgkmcnt(0)" ::: "memory");
    const int c = lane & 7;
#pragma unroll
    for (int j = 0; j < 8; ++j) {
        const int n = (lane >> 3) + 8 * j; const float* s = scr + (8 * c) * 65 + n;
        u32x4 o; o.x = pk2(s[0], s[65]); o.y = pk2(s[2 * 65], s[3 * 65]); o.z = pk2(s[4 * 65], s[5 * 65]); o.w = pk2(s[6 * 65], s[7 * 65]);
        *(u32x4*)(dst + (size_t)(n0 + n) * K + k0 + 8 * c) = o;
    }
    asm volatile("s_waitcnt lgkmcnt(0)" ::: "memory");
}

__device__ __forceinline__ void phase_prep(const Args& a, unsigned char* lds, int G) {
    const int tid = threadIdx.x, lane = tid & 63, wid = tid >> 6, bx = blockIdx.x;
    unsigned char* ws = a.ws;
    {
        float* sc = (float*)lds;
        float* red = (float*)(lds + 32768);
        const float* c = a.in[1]; const float* w_ada = a.in[2]; const float* b_ada = a.in[3];
        float* mod = (float*)(ws + WS_MOD);
        for (int cb = bx; cb < 6144 / 32; cb += G) {
            __syncthreads();
            for (int i = tid; i < 8 * 1024; i += NTHREADS) sc[i] = siluf_(c[i]);
            __syncthreads();
            const int kg = tid >> 5, cl = tid & 31, col = cb * 32 + cl;
            float acc[8];
#pragma unroll
            for (int b = 0; b < 8; ++b) acc[b] = 0.f;
            for (int k = kg; k < 1024; k += 16) {
                const float wv = w_ada[(size_t)k * 6144 + col];
#pragma unroll
                for (int b = 0; b < 8; ++b) acc[b] += sc[b * 1024 + k] * wv;
            }
#pragma unroll
            for (int b = 0; b < 8; ++b) red[(kg * 8 + b) * 32 + cl] = acc[b];
            __syncthreads();
            if (tid < 256) {
                const int b = tid >> 5; float s = 0.f;
#pragma unroll
                for (int g = 0; g < 16; ++g) s += red[(g * 8 + b) * 32 + cl];
                mod[b * 6144 + col] = s + b_ada[col];
            }
        }
        __syncthreads();
    }
    {
        float* scr = (float*)(lds + wid * 16640);
        const int gw = bx * NWAVES + wid, NGW = G * NWAVES;
        constexpr int I_IN = 16 * 28, I_O = 16 * 16, I_S = 16 * 4, I_DS = 4 * 16, I_E = 16 * 4 * NE;
        constexpr int NITEMS = I_IN + I_O + 3 * I_S + I_DS + 3 * I_E;
        for (int it = gw; it < NITEMS; it += NGW) {
            int r = it;
            if (r < I_IN) { transpose_item(a.in[4], 1024, INC, (bf16*)(ws + WS_WINT), r, scr, lane); continue; } r -= I_IN;
            if (r < I_O) { transpose_item(a.in[10], 1024, 1024, (bf16*)(ws + WS_WOT), r, scr, lane); continue; } r -= I_O;
            if (r < I_S) { transpose_item(a.in[13], 1024, 256, (bf16*)(ws + WS_WCAT), r, scr, lane); continue; } r -= I_S;
            if (r < I_S) { transpose_item(a.in[18], 1024, 256, (bf16*)(ws + WS_WCAT) + 256 * 1024, r, scr, lane); continue; } r -= I_S;
            if (r < I_S) { transpose_item(a.in[19], 1024, 256, (bf16*)(ws + WS_WCAT) + 512 * 1024, r, scr, lane); continue; } r -= I_S;
            if (r < I_DS) { transpose_item(a.in[20], 256, 1024, (bf16*)(ws + WS_WDST), r, scr, lane); continue; } r -= I_DS;
            if (r < I_E) { const int e = r >> 6; transpose_item(a.in[15] + (size_t)e * 262144, 1024, 256, (bf16*)(ws + WS_WGT) + (size_t)e * 262144, r & 63, scr, lane); continue; } r -= I_E;
            if (r < I_E) { const int e = r >> 6; transpose_item(a.in[16] + (size_t)e * 262144, 1024, 256, (bf16*)(ws + WS_WUT) + (size_t)e * 262144, r & 63, scr, lane); continue; } r -= I_E;
            { const int e = r >> 6; transpose_item(a.in[17] + (size_t)e * 262144, 256, 1024, (bf16*)(ws + WS_WDT) + (size_t)e * 262144, r & 63, scr, lane); }
        }
    }
}

__device__ __forceinline__ void phase_hmod(const Args& a, int G) {
    const float* x = a.in[0]; const float* mod = (const float*)(a.ws + WS_MOD); bf16* h = (bf16*)(a.ws + WS_H2);
    const size_t nchunk = (size_t)T * DM / 8;
    for (size_t i = (size_t)blockIdx.x * NTHREADS + threadIdx.x; i < nchunk; i += (size_t)G * NTHREADS) {
        const size_t e0 = i * 8; const int row = (int)(e0 >> 10), col = (int)(e0 & 1023), b = row >> 12;
        const f32x4 v0 = *(const f32x4*)(x + e0), v1 = *(const f32x4*)(x + e0 + 4);
        const float* sh = mod + b * 6144 + col; const float* sc = sh + 1024;
        const f32x4 s0 = *(const f32x4*)sc, s1 = *(const f32x4*)(sc + 4), h0 = *(const f32x4*)sh, h1 = *(const f32x4*)(sh + 4);
        const f32x4 r0 = v0 * (s0 + 1.0f) + h0, r1 = v1 * (s1 + 1.0f) + h1;
        store8_bf16(h + e0, r0, r1);
    }
}

struct SchedProj {
    XcdSplit xs; unsigned A, Bt;
    __device__ __forceinline__ bool next(int i, pg::Unit& u) const {
        int idx; if (!xs.unit(i, idx)) return false; int pm, pn; dense_pmpn(idx, 7, pm, pn);
        u.a = A + (unsigned)pm * 256 * 2048; u.r0 = pm * 256; u.c = pn; u.aux = 0;
        if (pn < 3) { u.b0 = Bt + (unsigned)(256 * pn) * 2048; u.b1 = u.b0 + 128 * 2048; }
        else { const int j = pn - 3; u.b0 = Bt + (unsigned)(768 + 128 * j) * 2048; u.b1 = Bt + (unsigned)(1280 + 128 * j) * 2048; }
        return true; }
    __device__ __forceinline__ int row(const pg::Unit&, int) const { return 0; }
};
struct EpiProj {
    bf16* O;
    __device__ __forceinline__ void operator()(const acc_t& acc, const pg::Unit& u, int wr, int wc, int fr, int fq) const {
        const int row0 = u.r0 + wr * 64 + fr;
        if (u.c < 3) {
#pragma unroll
            for (int ai = 0; ai < 2; ++ai)
#pragma unroll
                for (int m = 0; m < 4; ++m) { bf16* rowp = O + (size_t)(row0 + ai * 128 + m * 16) * QW + 256 * u.c + wc * 32 + 8 * fq;
#pragma unroll
                    for (int bj = 0; bj < 2; ++bj) store8_bf16(rowp + bj * 128, acc[ai][bj][m][0], acc[ai][bj][m][1]); }
        } else {
            const int j = u.c - 3;
#pragma unroll
            for (int ai = 0; ai < 2; ++ai)
#pragma unroll
                for (int m = 0; m < 4; ++m) { bf16* rowp = O + (size_t)(row0 + ai * 128 + m * 16) * QW + 768 + 128 * j + wc * 32 + 8 * fq;
                    f32x4 r0, r1;
#pragma unroll
                    for (int q = 0; q < 4; ++q) { r0[q] = acc[ai][0][m][0][q] * sigmoidf_(acc[ai][1][m][0][q]); r1[q] = acc[ai][0][m][1][q] * sigmoidf_(acc[ai][1][m][1][q]); }
                    store8_bf16(rowp, r0, r1); }
        }
    }
};
__device__ __forceinline__ void phase_proj(const Args& a, unsigned char* lds, int G) {
    SchedProj S{XcdSplit{(T / 256) * 7, G, (int)blockIdx.x}, (unsigned)WS_H2, (unsigned)WS_WINT};
    EpiProj E{(bf16*)(a.ws + WS_QKVG)};
    pg::gemm_phase<EpiProj, SchedProj, false>((LAS unsigned char*)lds, a.ws, DM, S, E);
}

constexpr int VT_STRIDE = 280;
__device__ __forceinline__ void attn_unit(const Args& a, unsigned char* lds, int unit) {
    const bf16* QK = (const bf16*)(a.ws + WS_QKVG); bf16* AC = (bf16*)(a.ws + WS_AC);
    const int tid = threadIdx.x, lane = tid & 63, w = __builtin_amdgcn_readfirstlane(tid >> 6), fr = lane & 15, fq = lane >> 4;
    const int kh = unit & 1, nblk = (unit >> 1) & 31, b = unit >> 6;
    const int tok0 = b * SEQ + nblk * 128;
    unsigned char* Kl = lds;
    bf16* Vt = (bf16*)(lds + 272 * 128);
    __syncthreads();
#pragma unroll 1
    for (int idx = tid; idx < 272 * 8; idx += NTHREADS) {
        const int key = idx >> 3, c = idx & 7;
        u32x4 kv = (u32x4){0u, 0u, 0u, 0u}, vv = (u32x4){0u, 0u, 0u, 0u};
        if (key < 256 && (nblk > 0 || key >= 128)) {
            const bf16* rowp = QK + (size_t)(tok0 - 128 + key) * QW + 512 + 64 * kh + 8 * c;
            kv = *(const u32x4*)rowp; vv = *(const u32x4*)(rowp + 128);
        }
        *(u32x4*)(Kl + key * 128 + ((c ^ (key & 7)) * 16)) = kv;
        bf16* vp = Vt + (8 * c) * VT_STRIDE + key;
        vp[0] = (bf16)(vv.x & 0xffffu); vp[VT_STRIDE] = (bf16)(vv.x >> 16);
        vp[2 * VT_STRIDE] = (bf16)(vv.y & 0xffffu); vp[3 * VT_STRIDE] = (bf16)(vv.y >> 16);
        vp[4 * VT_STRIDE] = (bf16)(vv.z & 0xffffu); vp[5 * VT_STRIDE] = (bf16)(vv.z >> 16);
        vp[6 * VT_STRIDE] = (bf16)(vv.w & 0xffffu); vp[7 * VT_STRIDE] = (bf16)(vv.w >> 16);
    }
    __syncthreads();
    const float* sinks = a.in[5];
#pragma unroll 1
    for (int g = 0; g < 4; ++g) {
        const int h = kh * 4 + g;
        int lofs = 0; asm volatile("" : "+v"(lofs));
        const float slope = exp2f(-(float)(h + 1)), sink = sinks[h];
        const bf16* qp = QK + (size_t)(tok0 + 16 * w + fr) * QW + 64 * h + 8 * fq;
        const bf16x8 q0 = *(const bf16x8*)qp, q1 = *(const bf16x8*)(qp + 32);
        f32x4 st[10];
#pragma unroll
        for (int i = 0; i < 10; ++i) {
            const int key = 16 * (w + i) + fr;
            const unsigned char* kp = Kl + key * 128 + lofs;
            const bf16x8 k0 = *(const bf16x8*)(kp + ((fq ^ (fr & 7)) * 16)), k1 = *(const bf16x8*)(kp + (((fq + 4) ^ (fr & 7)) * 16));
            f32x4 s = (f32x4){0.f, 0.f, 0.f, 0.f};
            s = __builtin_amdgcn_mfma_f32_16x16x32_bf16(k0, q0, s, 0, 0, 0);
            s = __builtin_amdgcn_mfma_f32_16x16x32_bf16(k1, q1, s, 0, 0, 0);
            st[i] = s;
        }
        float mx = -INFINITY;
#pragma unroll
        for (int i = 0; i < 10; ++i)
#pragma unroll
            for (int r = 0; r < 4; ++r) {
                const int dist = 128 + fr - 16 * i - 4 * fq - r;
                const int kj = 16 * (w + i) + 4 * fq + r;
                const bool valid = (dist >= 0) && (dist < 128) && (nblk > 0 || kj >= 128);
                const float s = valid ? (st[i][r] * 0.125f - slope * (float)dist) : -INFINITY;
                st[i][r] = s; mx = fmaxf(mx, s);
            }
        mx = fmaxf(mx, __shfl_xor(mx, 16)); mx = fmaxf(mx, __shfl_xor(mx, 32));
        mx = fmaxf(mx, sink);
        float sum = 0.f;
#pragma unroll
        for (int i = 0; i < 10; ++i)
#pragma unroll
            for (int r = 0; r < 4; ++r) { const float p = __expf(st[i][r] - mx); st[i][r] = p; sum += p; }
        sum += __shfl_xor(sum, 16); sum += __shfl_xor(sum, 32);
        const float inv = 1.0f / (sum + __expf(sink - mx));
        f32x4 o[4];
#pragma unroll
        for (int nt = 0; nt < 4; ++nt) o[nt] = (f32x4){0.f, 0.f, 0.f, 0.f};
#pragma unroll
        for (int s5 = 0; s5 < 5; ++s5) {
            u32x4 pw; pw.x = pk2(st[2 * s5][0], st[2 * s5][1]); pw.y = pk2(st[2 * s5][2], st[2 * s5][3]); pw.z = pk2(st[2 * s5 + 1][0], st[2 * s5 + 1][1]); pw.w = pk2(st[2 * s5 + 1][2], st[2 * s5 + 1][3]);
            const bf16x8 pf = __builtin_bit_cast(bf16x8, pw);
#pragma unroll
            for (int nt = 0; nt < 4; ++nt) {
                const bf16* vp = Vt + (16 * nt + fr) * VT_STRIDE + 16 * (w + 2 * s5) + 4 * fq + lofs;
                const u32x2 va = *(const u32x2*)vp, vb = *(const u32x2*)(vp + 16);
                u32x4 vw; vw.x = va.x; vw.y = va.y; vw.z = vb.x; vw.w = vb.y;
                o[nt] = __builtin_amdgcn_mfma_f32_16x16x32_bf16(__builtin_bit_cast(bf16x8, vw), pf, o[nt], 0, 0, 0);
            }
        }
        bf16* op = AC + (size_t)(tok0 + 16 * w + fr) * DM + 64 * h + 4 * fq;
#pragma unroll
        for (int nt = 0; nt < 4; ++nt) { u32x2 ow; ow.x = pk2(o[nt][0] * inv, o[nt][1] * inv); ow.y = pk2(o[nt][2] * inv, o[nt][3] * inv); *(u32x2*)(op + 16 * nt) = ow; }
    }
}

__device__ __forceinline__ void conv_unit(const Args& a, unsigned char* lds, int unit) {
    const bf16* QK = (const bf16*)(a.ws + WS_QKVG); bf16* AC = (bf16*)(a.ws + WS_AC);
    const int tid = threadIdx.x, lane = tid & 63, wid = tid >> 6;
    const int t0 = unit * 32, b = t0 >> 12, s0 = t0 & 4095, c = tid;
    bf16* inp = (bf16*)lds;
    float* yb = (float*)(lds + 62 * CW * 2);
    __syncthreads();
    for (int idx = tid; idx < 62 * 64; idx += NTHREADS) {
        const int i = idx >> 6, ch = idx & 63, s = s0 - 30 + i;
        u32x4 v = (u32x4){0u, 0u, 0u, 0u};
        if (s >= 0) v = *(const u32x4*)(QK + (size_t)(b * SEQ + s) * QW + 768 + 8 * ch);
        *(u32x4*)(inp + i * CW + 8 * ch) = v;
    }
    const float* cw = a.in[6];
    float wgt[CK];
#pragma unroll
    for (int j = 0; j < CK; ++j) wgt[j] = cw[j * CW + c];
    float acc[32];
    const float bias = a.in[7][c];
#pragma unroll
    for (int t = 0; t < 32; ++t) acc[t] = bias;
    __syncthreads();
#pragma unroll
    for (int i = 0; i < 62; ++i) {
        const float v = bf2f(inp[i * CW + c]);
#pragma unroll
        for (int t = 0; t < 32; ++t) { const int j = i - t; if (j >= 0 && j < CK) acc[t] += v * wgt[j]; }
    }
#pragma unroll
    for (int t = 0; t < 32; ++t) yb[t * CW + c] = acc[t];
    __syncthreads();
    const float* lg = a.in[8]; const float* lb = a.in[9];
    const f32x4 g0 = *(const f32x4*)(lg + 8 * lane), g1 = *(const f32x4*)(lg + 8 * lane + 4), b0 = *(const f32x4*)(lb + 8 * lane), b1 = *(const f32x4*)(lb + 8 * lane + 4);
#pragma unroll
    for (int q = 0; q < 4; ++q) {
        const int t = wid * 4 + q;
        f32x4 v0 = *(const f32x4*)(yb + t * CW + 8 * lane), v1 = *(const f32x4*)(yb + t * CW + 8 * lane + 4);
        const float mean = wave_sum((v0[0] + v0[1]) + (v0[2] + v0[3]) + (v1[0] + v1[1]) + (v1[2] + v1[3])) * (1.0f / CW);
        v0 = v0 - mean; v1 = v1 - mean;
        const float var = wave_sum((v0[0] * v0[0] + v0[1] * v0[1]) + (v0[2] * v0[2] + v0[3] * v0[3]) + (v1[0] * v1[0] + v1[1] * v1[1]) + (v1[2] * v1[2] + v1[3] * v1[3])) * (1.0f / CW);
        const float rstd = rsqrtf(var + LN_EPS);
        f32x4 r0 = v0 * rstd * g0 + b0, r1 = v1 * rstd * g1 + b1;
#pragma unroll
        for (int e = 0; e < 4; ++e) { r0[e] = siluf_(r0[e]); r1[e] = siluf_(r1[e]); }
        store8_bf16(AC + (size_t)(t0 + t) * DM + 512 + 8 * lane, r0, r1);
    }
}

__device__ __forceinline__ void phase_mixer(const Args& a, unsigned char* lds, int G) {
    for (int u = blockIdx.x; u < NB * 32 * NKVH; u += G) attn_unit(a, lds, u);
    for (int u = blockIdx.x; u < T / 32; u += G) conv_unit(a, lds, u);
}

struct SchedWo {
    XcdSplit xs; unsigned A, Bt;
    __device__ __forceinline__ bool next(int i, pg::Unit& u) const {
        int idx; if (!xs.unit(i, idx)) return false; int pm, pn; dense_pmpn(idx, 4, pm, pn);
        u.a = A + (unsigned)pm * 256 * 2048; u.r0 = pm * 256; u.c = pn; u.aux = 0;
        u.b0 = Bt + (unsigned)(256 * pn) * 2048; u.b1 = u.b0 + 128 * 2048; return true; }
    __device__ __forceinline__ int row(const pg::Unit&, int) const { return 0; }
};
struct EpiWo {
    const float* x; const float* mod; float* out;
    __device__ __forceinline__ void operator()(const acc_t& acc, const pg::Unit& u, int wr, int wc, int fr, int fq) const {
        const int row0 = u.r0 + wr * 64 + fr, bb = u.r0 >> 12, col0 = 256 * u.c + wc * 32 + 8 * fq;
        f32x4 g[2][2];
#pragma unroll
        for (int bj = 0; bj < 2; ++bj)
#pragma unroll
            for (int n = 0; n < 2; ++n) g[bj][n] = *(const f32x4*)(mod + bb * 6144 + 2048 + col0 + 128 * bj + 4 * n) + 1.0f;
#pragma unroll
        for (int ai = 0; ai < 2; ++ai)
#pragma unroll
            for (int m = 0; m < 4; ++m) { const size_t off = (size_t)(row0 + ai * 128 + m * 16) * DM + col0;
#pragma unroll
                for (int bj = 0; bj < 2; ++bj)
#pragma unroll
                    for (int n = 0; n < 2; ++n) { const f32x4 xv = *(const f32x4*)(x + off + 128 * bj + 4 * n); *(f32x4*)(out + off + 128 * bj + 4 * n) = xv * ALPHA + g[bj][n] * acc[ai][bj][m][n]; } }
    }
};
__device__ __forceinline__ void phase_wo(const Args& a, unsigned char* lds, int G) {
    SchedWo S{XcdSplit{(T / 256) * 4, G, (int)blockIdx.x}, (unsigned)WS_AC, (unsigned)WS_WOT};
    EpiWo E{a.in[0], (const float*)(a.ws + WS_MOD), a.out};
    pg::gemm_phase<EpiWo, SchedWo, false>((LAS unsigned char*)lds, a.ws, DM, S, E);
}

__device__ __forceinline__ void phase_ln1(const Args& a, int G) {
    const float* mod = (const float*)(a.ws + WS_MOD); float* out = a.out; bf16* h2 = (bf16*)(a.ws + WS_H2);
    const float* lg = a.in[11]; const float* lb = a.in[12];
    const int lane = threadIdx.x & 63, wid = threadIdx.x >> 6;
    for (int m = blockIdx.x * NWAVES + wid; m < T; m += G * NWAVES) {
        const int bb = m >> 12; float* rowp = out + (size_t)m * DM;
        f32x4 v[4]; float s = 0.f;
#pragma unroll
        for (int q = 0; q < 4; ++q) { v[q] = *(const f32x4*)(rowp + 4 * lane + 256 * q); s += (v[q][0] + v[q][1]) + (v[q][2] + v[q][3]); }
        const float mean = wave_sum(s) * (1.0f / DM); float s2 = 0.f;
#pragma unroll
        for (int q = 0; q < 4; ++q) { v[q] = v[q] - mean; s2 += (v[q][0] * v[q][0] + v[q][1] * v[q][1]) + (v[q][2] * v[q][2] + v[q][3] * v[q][3]); }
        const float rstd = rsqrtf(wave_sum(s2) * (1.0f / DM) + LN_EPS);
#pragma unroll
        for (int q = 0; q < 4; ++q) {
            const int n = 4 * lane + 256 * q;
            const f32x4 x1 = v[q] * rstd * *(const f32x4*)(lg + n) + *(const f32x4*)(lb + n);
            *(f32x4*)(rowp + n) = x1;
            const f32x4 hh = x1 * (*(const f32x4*)(mod + bb * 6144 + 4096 + n) + 1.0f) + *(const f32x4*)(mod + bb * 6144 + 3072 + n);
            u32x2 w; w.x = pk2(hh[0], hh[1]); w.y = pk2(hh[2], hh[3]); *(u32x2*)(h2 + (size_t)m * DM + n) = w;
        }
    }
}

struct SchedRs {
    XcdSplit xs; unsigned A, Bt;
    __device__ __forceinline__ bool next(int i, pg::Unit& u) const {
        int idx; if (!xs.unit(i, idx)) return false; int pm, pn; dense_pmpn(idx, 3, pm, pn);
        u.a = A + (unsigned)pm * 256 * 2048; u.r0 = pm * 256; u.c = pn; u.aux = 0;
        if (pn == 0) { u.b0 = Bt; u.b1 = Bt + 128 * 2048; }
        else { const int j = pn - 1; u.b0 = Bt + (unsigned)(256 + 128 * j) * 2048; u.b1 = Bt + (unsigned)(512 + 128 * j) * 2048; }
        return true; }
    __device__ __forceinline__ int row(const pg::Unit&, int) const { return 0; }
};
struct EpiRs {
    float* logits; bf16* hs;
    __device__ __forceinline__ void operator()(const acc_t& acc, const pg::Unit& u, int wr, int wc, int fr, int fq) const {
        const int row0 = u.r0 + wr * 64 + fr;
        if (u.c == 0) {
#pragma unroll
            for (int ai = 0; ai < 2; ++ai)
#pragma unroll
                for (int m = 0; m < 4; ++m) { float* rowp = logits + (size_t)(row0 + ai * 128 + m * 16) * NE + wc * 32 + 8 * fq;
#pragma unroll
                    for (int bj = 0; bj < 2; ++bj) { *(f32x4*)(rowp + 128 * bj) = acc[ai][bj][m][0]; *(f32x4*)(rowp + 128 * bj + 4) = acc[ai][bj][m][1]; } }
        } else {
            const int j = u.c - 1;
#pragma unroll
            for (int ai = 0; ai < 2; ++ai)
#pragma unroll
                for (int m = 0; m < 4; ++m) { bf16* rowp = hs + (size_t)(row0 + ai * 128 + m * 16) * FE + 128 * j + wc * 32 + 8 * fq;
                    f32x4 r0, r1;
#pragma unroll
                    for (int q = 0; q < 4; ++q) { r0[q] = siluf_(acc[ai][0][m][0][q]) * acc[ai][1][m][0][q]; r1[q] = siluf_(acc[ai][0][m][1][q]) * acc[ai][1][m][1][q]; }
                    store8_bf16(rowp, r0, r1); }
        }
    }
};
__device__ __forceinline__ void phase_rs(const Args& a, unsigned char* lds, int G) {
    SchedRs S{XcdSplit{(T / 256) * 3, G, (int)blockIdx.x}, (unsigned)WS_H2, (unsigned)WS_WCAT};
    EpiRs E{(float*)(a.ws + WS_LOG), (bf16*)(a.ws + WS_HS)};
    pg::gemm_phase<EpiRs, SchedRs, false>((LAS unsigned char*)lds, a.ws, DM, S, E);
}

__device__ __forceinline__ void phase_route(const Args& a, unsigned char* lds, int G) {
    const float* logits = (const float*)(a.ws + WS_LOG); const float* rbias = a.in[14];
    int* eidx = (int*)(a.ws + WS_EIDX); float* ew = (float*)(a.ws + WS_EW); int* histg = (int*)(a.ws + WS_HIST);
    const int tid = threadIdx.x, lane = tid & 63, wid = tid >> 6;
    int* hist = (int*)lds;
    __syncthreads();
    if (tid < NE) hist[tid] = 0;
    __syncthreads();
    const int chunk = (T + G - 1) / G, tbeg = blockIdx.x * chunk, tend = min(T, tbeg + chunk);
    const f32x4 bv = *(const f32x4*)(rbias + 4 * lane);
    for (int t = tbeg + wid; t < tend; t += NWAVES) {
        const f32x4 lg = *(const f32x4*)(logits + (size_t)t * NE + 4 * lane);
        float sc[4], sel[4];
#pragma unroll
        for (int i = 0; i < 4; ++i) { sc[i] = sigmoidf_(lg[i]); sel[i] = sc[i] + bv[i]; }
        float a1 = fmaxf(sel[0], sel[1]), a2 = fminf(sel[0], sel[1]);
        { const float c1 = fmaxf(sel[2], sel[3]), c2 = fminf(sel[2], sel[3]); const float n1 = fmaxf(a1, c1), n2 = fmaxf(fminf(a1, c1), fmaxf(a2, c2)); a1 = n1; a2 = n2; }
#pragma unroll
        for (int o = 1; o < 8; o <<= 1) { const float c1 = __shfl_xor(a1, o), c2 = __shfl_xor(a2, o); const float n1 = fmaxf(a1, c1), n2 = fmaxf(fminf(a1, c1), fmaxf(a2, c2)); a1 = n1; a2 = n2; }
        const float gs = a1 + a2; const int mg = lane >> 3; int rank = 0;
#pragma unroll
        for (int g = 0; g < 8; ++g) { const float o = __shfl(gs, 8 * g); rank += (o > gs || (o == gs && g < mg)) ? 1 : 0; }
        const bool gsel = rank < 4;
        float v[4];
#pragma unroll
        for (int i = 0; i < 4; ++i) v[i] = gsel ? sel[i] : -INFINITY;
        int my_e = 0; float my_w = 0.f, wsum = 0.f;
#pragma unroll
        for (int r = 0; r < TOPK; ++r) {
            float bvv = v[0]; int bi = 0;
#pragma unroll
            for (int i = 1; i < 4; ++i) if (v[i] > bvv) { bvv = v[i]; bi = i; }
            int bidx = 4 * lane + bi;
#pragma unroll
            for (int o = 1; o < 64; o <<= 1) { const float ov = __shfl_xor(bvv, o); const int oi = __shfl_xor(bidx, o); if (ov > bvv || (ov == bvv && oi < bidx)) { bvv = ov; bidx = oi; } }
            const int owner = bidx >> 2, oi = bidx & 3;
            const float mys = (oi == 0) ? sc[0] : (oi == 1) ? sc[1] : (oi == 2) ? sc[2] : sc[3];
            const float wv = __shfl(mys, owner);
            if (lane == owner) {
#pragma unroll
                for (int i = 0; i < 4; ++i) if (i == oi) v[i] = -INFINITY;
            }
            wsum += wv;
            if (lane == r) { my_e = bidx; my_w = wv; }
        }
        if (lane < TOPK) {
            eidx[(size_t)t * TOPK + lane] = my_e;
            ew[(size_t)t * TOPK + lane] = my_w / wsum * 2.5f;
            atomicAdd(&hist[my_e], 1);
        }
    }
    __syncthreads();
    if (tid < NE) histg[blockIdx.x * NE + tid] = hist[tid];
}

__device__ __forceinline__ void phase_scan(const Args& a, unsigned char* lds, int G) {
    const int* histg = (const int*)(a.ws + WS_HIST); int* off = (int*)(a.ws + WS_OFF); int* cnt = (int*)(a.ws + WS_CNT);
    const int tid = threadIdx.x; int* buf = (int*)lds;
    for (int e = blockIdx.x; e < NE; e += G) {
        __syncthreads();
        const int v = (tid < G) ? histg[tid * NE + e] : 0;
        buf[tid] = v;
        __syncthreads();
        int cur = 0;
#pragma unroll
        for (int o = 1; o < NTHREADS; o <<= 1) {
            const int x = buf[cur * 512 + tid] + ((tid >= o) ? buf[cur * 512 + tid - o] : 0);
            buf[(cur ^ 1) * 512 + tid] = x; cur ^= 1;
            __syncthreads();
        }
        const int incl = buf[cur * 512 + tid];
        if (tid < G) off[tid * NE + e] = incl - v;
        if (tid == NTHREADS - 1) cnt[e] = incl;
    }
}

__device__ __forceinline__ void phase_lists(const Args& a, unsigned char* lds, int G) {
    int* cnt = (int*)(a.ws + WS_CNT); const int* off = (const int*)(a.ws + WS_OFF);
    const int* eidx = (const int*)(a.ws + WS_EIDX); const float* ew = (const float*)(a.ws + WS_EW);
    int* rtok = (int*)(a.ws + WS_RTOK); int* rdst = (int*)(a.ws + WS_RDST); float* rw = (float*)(a.ws + WS_RW);
    const int tid = threadIdx.x;
    int* base = (int*)lds;
    int* cur = base + 512;
    int* sbuf = base + 1024;
    __syncthreads();
    int c = 0, pad = 0;
    if (tid < NE) { c = cnt[tid]; pad = (c + BM - 1) / BM * BM; sbuf[tid] = pad; }
    __syncthreads();
    int curb = 0;
    for (int o = 1; o < NE; o <<= 1) {
        if (tid < NE) { const int x = sbuf[curb * 256 + tid] + ((tid >= o) ? sbuf[curb * 256 + tid - o] : 0); sbuf[(curb ^ 1) * 256 + tid] = x; }
        curb ^= 1;
        __syncthreads();
    }
    if (tid < NE) { const int incl = sbuf[curb * 256 + tid]; base[tid] = incl - pad; if (tid == NE - 1) base[NE] = incl; cur[tid] = incl - pad + off[blockIdx.x * NE + tid]; }
    __syncthreads();
    for (int e = blockIdx.x; e < NE; e += G) {
        const int b0 = base[e], cc = cnt[e], pe = base[e + 1];
        for (int r = b0 + cc + tid; r < pe; r += NTHREADS) { rtok[r] = 0; rdst[r] = -1; rw[r] = 0.f; }
        for (int tl = b0 / BM + tid; tl < pe / BM; tl += NTHREADS) cnt[512 + tl] = e;
    }
    if (blockIdx.x == 0 && tid == 0) cnt[256] = base[NE] / BM;
    const int chunk = (T + G - 1) / G, tbeg = blockIdx.x * chunk, tend = min(T, tbeg + chunk);
    for (int i = tbeg * TOPK + tid; i < tend * TOPK; i += NTHREADS) {
        const int e = eidx[i];
        const int r = atomicAdd(&cur[e], 1);
        rtok[r] = i >> 3; rdst[r] = i; rw[r] = ew[i];
    }
}

struct SchedMoe1 {
    XcdSplit xs; unsigned A, Wg, Wu; const int* texp; const LAS int* lists;
    __device__ __forceinline__ bool next(int i, pg::Unit& u) const {
        int idx; if (!xs.unit(i, idx)) return false; const int tile = idx >> 1, j = idx & 1, e = texp[tile];
        u.a = A; u.r0 = tile * 256; u.c = j; u.aux = i;
        u.b0 = Wg + (unsigned)(e * 256 + 128 * j) * 2048; u.b1 = Wu + (unsigned)(e * 256 + 128 * j) * 2048; return true; }
    __device__ __forceinline__ int row(const pg::Unit& u, int r) const { return lists[u.aux * 256 + r]; }
};
struct EpiMoe1 {
    bf16* H;
    __device__ __forceinline__ void operator()(const acc_t& acc, const pg::Unit& u, int wr, int wc, int fr, int fq) const {
        const int row0 = u.r0 + wr * 64 + fr;
#pragma unroll
        for (int ai = 0; ai < 2; ++ai)
#pragma unroll
            for (int m = 0; m < 4; ++m) { bf16* rowp = H + (size_t)(row0 + ai * 128 + m * 16) * FE + 128 * u.c + wc * 32 + 8 * fq;
                f32x4 r0, r1;
#pragma unroll
                for (int q = 0; q < 4; ++q) { r0[q] = siluf_(acc[ai][0][m][0][q]) * acc[ai][1][m][0][q]; r1[q] = siluf_(acc[ai][0][m][1][q]) * acc[ai][1][m][1][q]; }
                store8_bf16(rowp, r0, r1); }
    }
};
constexpr int LIST_OFF = pg::PG_STAGE_BYTES, MAX_LISTS = 12;
__device__ __forceinline__ void phase_moe1(const Args& a, unsigned char* lds, int G) {
    const int* cnt = (const int*)(a.ws + WS_CNT); const int* rtok = (const int*)(a.ws + WS_RTOK);
    const int ntiles = cnt[256];
    XcdSplit xs{ntiles * 2, G, (int)blockIdx.x};
    LAS int* lists = (LAS int*)((LAS unsigned char*)lds + LIST_OFF);
    __syncthreads();
    for (int i = 0; i < MAX_LISTS; ++i) { int idx; if (!xs.unit(i, idx)) break; if (threadIdx.x < 256) lists[i * 256 + threadIdx.x] = rtok[(idx >> 1) * 256 + threadIdx.x]; }
    __syncthreads();
    SchedMoe1 S{xs, (unsigned)WS_H2, (unsigned)WS_WGT, (unsigned)WS_WUT, cnt + 512, lists};
    EpiMoe1 E{(bf16*)(a.ws + WS_H)};
    pg::gemm_phase<EpiMoe1, SchedMoe1, true>((LAS unsigned char*)lds, a.ws, DM, S, E);
}

struct SchedMoe2 {
    XcdSplit xs; int NU2; unsigned Hb, Wd, hs, Wds; const int* texp;
    __device__ __forceinline__ bool next(int i, pg::Unit& u) const {
        int idx; if (!xs.unit(i, idx)) return false;
        if (idx < NU2) { const int tile = idx >> 2, jn = idx & 3, e = texp[tile];
            u.a = Hb + (unsigned)tile * 256 * 512; u.r0 = tile * 256; u.c = jn; u.aux = 0;
            u.b0 = Wd + (unsigned)(e * 1024 + 256 * jn) * 512; u.b1 = u.b0 + 128 * 512; }
        else { int pm, pn; dense_pmpn(idx - NU2, 4, pm, pn);
            u.a = hs + (unsigned)pm * 256 * 512; u.r0 = pm * 256; u.c = pn; u.aux = 1;
            u.b0 = Wds + (unsigned)(256 * pn) * 512; u.b1 = u.b0 + 128 * 512; }
        return true; }
    __device__ __forceinline__ int row(const pg::Unit&, int) const { return 0; }
};
struct EpiMoe2 {
    bf16* Y; bf16* SD; const int* rdst; const float* rw;
    __device__ __forceinline__ void operator()(const acc_t& acc, const pg::Unit& u, int wr, int wc, int fr, int fq) const {
        const int row0 = u.r0 + wr * 64 + fr, col0 = 256 * u.c + wc * 32 + 8 * fq;
        if (u.aux == 0) {
#pragma unroll
            for (int ai = 0; ai < 2; ++ai)
#pragma unroll
                for (int m = 0; m < 4; ++m) { const int r = row0 + ai * 128 + m * 16; const int dst = rdst[r];
                    if (dst >= 0) { const float wv = rw[r]; bf16* rowp = Y + (size_t)dst * DM + col0;
#pragma unroll
                        for (int bj = 0; bj < 2; ++bj) store8_bf16(rowp + 128 * bj, acc[ai][bj][m][0] * wv, acc[ai][bj][m][1] * wv); } }
        } else {
#pragma unroll
            for (int ai = 0; ai < 2; ++ai)
#pragma unroll
                for (int m = 0; m < 4; ++m) { bf16* rowp = SD + (size_t)(row0 + ai * 128 + m * 16) * DM + col0;
#pragma unroll
                    for (int bj = 0; bj < 2; ++bj) store8_bf16(rowp + 128 * bj, acc[ai][bj][m][0], acc[ai][bj][m][1]); }
        }
    }
};
__device__ __forceinline__ void phase_moe2(const Args& a, unsigned char* lds, int G) {
    const int* cnt = (const int*)(a.ws + WS_CNT);
    const int ntiles = cnt[256], NU2 = ntiles * 4;
    SchedMoe2 S{XcdSplit{NU2 + (T / 256) * 4, G, (int)blockIdx.x}, NU2, (unsigned)WS_H, (unsigned)WS_WDT, (unsigned)WS_HS, (unsigned)WS_WDST, cnt + 512};
    EpiMoe2 E{(bf16*)(a.ws + WS_Y), (bf16*)(a.ws + WS_SD), (const int*)(a.ws + WS_RDST), (const float*)(a.ws + WS_RW)};
    pg::gemm_phase<EpiMoe2, SchedMoe2, false>((LAS unsigned char*)lds, a.ws, FE, S, E);
}

__device__ __forceinline__ void phase_final(const Args& a, int G) {
    const float* mod = (const float*)(a.ws + WS_MOD); float* out = a.out;
    const bf16* SD = (const bf16*)(a.ws + WS_SD); const bf16* Y = (const bf16*)(a.ws + WS_Y);
    const float* lg = a.in[21]; const float* lb = a.in[22];
    const int lane = threadIdx.x & 63, wid = threadIdx.x >> 6;
    for (int m = blockIdx.x * NWAVES + wid; m < T; m += G * NWAVES) {
        const int bb = m >> 12; float* rowp = out + (size_t)m * DM;
        f32x4 v[4]; float s = 0.f;
#pragma unroll
        for (int q = 0; q < 4; ++q) {
            const int n = 4 * lane + 256 * q;
            u32x2 w = *(const u32x2*)(SD + (size_t)m * DM + n);
            f32x4 f = (f32x4){bflo(w.x), bfhi(w.x), bflo(w.y), bfhi(w.y)};
#pragma unroll
            for (int k = 0; k < TOPK; ++k) { const u32x2 y = *(const u32x2*)(Y + ((size_t)m * TOPK + k) * DM + n); f[0] += bflo(y.x); f[1] += bfhi(y.x); f[2] += bflo(y.y); f[3] += bfhi(y.y); }
            const f32x4 x1 = *(const f32x4*)(rowp + n);
            v[q] = x1 * ALPHA + (*(const f32x4*)(mod + bb * 6144 + 5120 + n) + 1.0f) * f;
            s += (v[q][0] + v[q][1]) + (v[q][2] + v[q][3]);
        }
        const float mean = wave_sum(s) * (1.0f / DM); float s2 = 0.f;
#pragma unroll
        for (int q = 0; q < 4; ++q) { v[q] = v[q] - mean; s2 += (v[q][0] * v[q][0] + v[q][1] * v[q][1]) + (v[q][2] * v[q][2] + v[q][3] * v[q][3]); }
        const float rstd = rsqrtf(wave_sum(s2) * (1.0f / DM) + LN_EPS);
#pragma unroll
        for (int q = 0; q < 4; ++q) { const int n = 4 * lane + 256 * q; *(f32x4*)(rowp + n) = v[q] * rstd * *(const f32x4*)(lg + n) + *(const f32x4*)(lb + n); }
    }
}

constexpr int NPHASES = 13;
__global__ void __launch_bounds__(NTHREADS, 2) fwd_kernel(Args a) {
    extern __shared__ __attribute__((aligned(16))) unsigned char lds[];
    const int G = gridDim.x;
    volatile LAS unsigned* misc = (volatile LAS unsigned*)(LAS unsigned char*)(lds + LDS_BYTES - 64);
    if (threadIdx.x < 16) misc[threadIdx.x] = 0u;
    __syncthreads();
    XcdBarrier bar; bar.bar = (unsigned*)(a.ws + WS_CTL); bar.x = 0; bar.st = nullptr;
    const bool multi = (a.ph_hi - a.ph_lo) > 1;
    if (multi) bar = xcd_barrier_post((unsigned*)(a.ws + WS_CTL), misc);
#define IN(k) (a.ph_lo <= (k) && (k) < a.ph_hi)
#define SEAM(k) do { if (IN(k) && IN((k) + 1)) xcd_barrier(bar); } while (0)
#ifndef REPEAT_MASK
#define REPEAT_MASK 0
#endif
#define REP(k, call) do { if (IN(k)) { call; if ((REPEAT_MASK >> (k)) & 1) { xcd_barrier(bar); call; } } } while (0)
    REP(0, phase_prep(a, lds, G));
    SEAM(0);
    REP(1, phase_hmod(a, G));
    SEAM(1);
    REP(2, phase_proj(a, lds, G));
    SEAM(2);
    REP(3, phase_mixer(a, lds, G));
    SEAM(3);
    REP(4, phase_wo(a, lds, G));
    SEAM(4);
    REP(5, phase_ln1(a, G));
    SEAM(5);
    REP(6, phase_rs(a, lds, G));
    SEAM(6);
    REP(7, phase_route(a, lds, G));
    SEAM(7);
    REP(8, phase_scan(a, lds, G));
    SEAM(8);
    REP(9, phase_lists(a, lds, G));
    SEAM(9);
    REP(10, phase_moe1(a, lds, G));
    SEAM(10);
    REP(11, phase_moe2(a, lds, G));
    SEAM(11);
    REP(12, phase_final(a, G));
#undef IN
#undef SEAM
}

extern "C" void kernel_launch(void* const* d_in, const int* in_sizes, int n_in, void* d_out, int out_size, void* d_ws, size_t ws_size, hipStream_t stream) {
    static int grid = 0;
    if (grid == 0) {
        if (n_in != 23 || out_size != T * DM || ws_size < WS_END) { fprintf(stderr, "kernel_launch: unexpected shapes (n_in %d out %d ws %zu)\n", n_in, out_size, ws_size); grid = -1; return; }
        int dev = 0, cus = 0;
        if (hipGetDevice(&dev) != hipSuccess || hipDeviceGetAttribute(&cus, hipDeviceAttributeMultiprocessorCount, dev) != hipSuccess) { grid = -1; return; }
        if (hipFuncSetAttribute((const void*)fwd_kernel, hipFuncAttributeMaxDynamicSharedMemorySize, LDS_BYTES) != hipSuccess) { fprintf(stderr, "kernel_launch: hipFuncSetAttribute failed\n"); grid = -1; return; }
        int per_cu = 0;
        (void)hipOccupancyMaxActiveBlocksPerMultiprocessor(&per_cu, (const void*)fwd_kernel, NTHREADS, LDS_BYTES);
        (void)hipGetLastError();
        grid = cus > 512 ? 512 : cus;
        if (per_cu < 1) fprintf(stderr, "kernel_launch: occupancy query reports %d blocks per CU\n", per_cu);
    }
    if (grid < 0) return;
    (void)hipMemsetAsync((char*)d_ws + WS_CTL, 0, CTL_ZERO_BYTES, stream);
    Args a{};
    for (int i = 0; i < 23; ++i) a.in[i] = (const float*)d_in[i];
    a.out = (float*)d_out; a.ws = (unsigned char*)d_ws;
#if N_LAUNCH_MODE == 1
    a.ph_lo = 0; a.ph_hi = NPHASES;
    hipLaunchKernelGGL(fwd_kernel, dim3(grid), dim3(NTHREADS), LDS_BYTES, stream, a);
#else
    for (int p = 0; p < NPHASES; ++p) { a.ph_lo = p; a.ph_hi = p + 1; hipLaunchKernelGGL(fwd_kernel, dim3(grid), dim3(NTHREADS), LDS_BYTES, stream, a); }
#endif
}
```

```cpp
#include <hip/hip_runtime.h>
#include <cstdio>
#include <cstdint>

#define LAS __attribute__((address_space(3)))
typedef unsigned short bf16;
typedef short bf16x8 __attribute__((ext_vector_type(8)));
typedef short bf16x4v __attribute__((ext_vector_type(4)));
typedef float f32x4 __attribute__((ext_vector_type(4)));
typedef unsigned u32x4 __attribute__((ext_vector_type(4)));
typedef unsigned u32x2 __attribute__((ext_vector_type(2)));
typedef float f32x2v __attribute__((ext_vector_type(2)));

#ifndef N_LAUNCH_MODE
#define N_LAUNCH_MODE 1
#endif

constexpr int NB = 8, SEQ = 4096, DM = 1024, T = NB * SEQ;
constexpr int HD = 64, NQH = 8, NKVH = 2;
constexpr int INC = 1792, QW = 1280;
constexpr int NE = 256, TOPK = 8, FE = 256;
constexpr int CK = 31, CW = 512;
constexpr int BM = 256, BN = 128;
constexpr int MAXROWS = T * TOPK + NE * BM;
constexpr int MAXTILES = MAXROWS / BM;
constexpr float LN_EPS = 1e-5f;
constexpr float ALPHA = 1.18920711500272106672f;
constexpr int NTHREADS = 512, NWAVES = 8;
constexpr int LDS_BYTES = 147456;

constexpr size_t MiB = 1u << 20;
constexpr size_t WS_CTL = 0, CTL_ZERO_BYTES = 64 * 1024;
constexpr size_t WS_MOD = 1 * MiB;
constexpr size_t WS_WINT = 12 * MiB;
constexpr size_t WS_WOT = 16 * MiB;
constexpr size_t WS_WCAT = 18 * MiB;
constexpr size_t WS_WDST = 20 * MiB;
constexpr size_t WS_WDT = 24 * MiB;
constexpr size_t WS_H = 152 * MiB;
constexpr size_t WS_HS = 312 * MiB;
constexpr size_t WS_SD = 328 * MiB;
constexpr size_t WS_Y = 392 * MiB;
constexpr size_t WS_WGT = 392 * MiB;
constexpr size_t WS_WUT = 520 * MiB;
constexpr size_t WS_H2 = 648 * MiB;
constexpr size_t WS_QKVG = 712 * MiB;
constexpr size_t WS_AC = 792 * MiB;
constexpr size_t WS_LOG = 856 * MiB;
constexpr size_t WS_RDST = 904 * MiB;
constexpr size_t WS_EW = 2 * MiB;
constexpr size_t WS_MIX = 712 * MiB;
constexpr size_t WS_X1B = 936 * MiB;
constexpr size_t WS_END = 1000 * MiB;
constexpr size_t WS_GCNT = 32768;
constexpr int RCAP = T;

__device__ __forceinline__ unsigned f2bf(float f) { unsigned u = __float_as_uint(f); return (u + 0x7fffu + ((u >> 16) & 1u)) >> 16; }
__device__ __forceinline__ unsigned pk2(float lo, float hi) { unsigned r; asm volatile("v_cvt_pk_bf16_f32 %0, %1, %2" : "=v"(r) : "v"(lo), "v"(hi)); return r; }
__device__ __forceinline__ float bf2f(unsigned h) { return __uint_as_float(h << 16); }
__device__ __forceinline__ float bflo(unsigned w) { return __uint_as_float(w << 16); }
__device__ __forceinline__ float bfhi(unsigned w) { return __uint_as_float(w & 0xffff0000u); }
__device__ __forceinline__ float sigmoidf_(float v) { return __builtin_amdgcn_rcpf(1.0f + __builtin_amdgcn_exp2f(-1.44269504089f * v)); }
__device__ __forceinline__ float sigmoidf_ref(float v) { return 1.0f / (1.0f + __expf(-v)); }
__device__ __forceinline__ float siluf_(float v) { return v * __builtin_amdgcn_rcpf(1.0f + __builtin_amdgcn_exp2f(-1.44269504089f * v)); }
__device__ __forceinline__ float wave_sum(float v) {
#pragma unroll
    for (int o = 1; o < 64; o <<= 1) v += __shfl_xor(v, o);
    return v;
}
__device__ __forceinline__ int perm32(int rho) { const int n = rho >> 4, i = rho & 15; return 8 * (i >> 2) + 4 * n + (i & 3); }

#define XB_TMO      128
#define XB_XCNT(j)  (256  + 64 * (j))
#define XB_XSUB(j)  (1280 + 64 * (j))
#define XB_XGEN(j)  (2304 + 64 * (j))
#define XB_TOP      3328
#define XB_TOPGEN   3392
#define XCD_BAR_WORDS 3456
#define XB_SPIN_CAP (1u << 22)
__device__ __forceinline__ unsigned xb_ld(unsigned* p)              { return __hip_atomic_load(p, __ATOMIC_RELAXED, __HIP_MEMORY_SCOPE_AGENT); }
__device__ __forceinline__ unsigned xb_add(unsigned* p, unsigned v) { return __hip_atomic_fetch_add(p, v, __ATOMIC_RELAXED, __HIP_MEMORY_SCOPE_AGENT); }
__device__ __forceinline__ unsigned xb_xcc_id() { return (unsigned)__builtin_amdgcn_s_getreg((3 << 11) | 20) & 0xFu; }
#define XB_SPIN(cond, bar) do { unsigned _sp = 0; while (cond) { __builtin_amdgcn_s_sleep(1); \
    if ((++_sp & 255u) == 0u) { if (xb_ld(&(bar)[XB_TMO])) break; if (_sp > XB_SPIN_CAP) { atomicAdd(&(bar)[XB_TMO], 1u); break; } } } } while (0)
struct XcdBarrier { unsigned* bar; unsigned x; volatile LAS unsigned* st; };
__device__ __forceinline__ XcdBarrier xcd_barrier_post(unsigned* bar, volatile LAS unsigned* st) {
    XcdBarrier b; b.bar = bar; b.x = xb_xcc_id(); b.st = st;
    if (threadIdx.x == 0) (void)xb_add(&bar[XB_XCNT(b.x)], 1u);
    return b;
}
__device__ __forceinline__ void xcd_barrier_complete(unsigned* bar, unsigned x, unsigned& nloc, unsigned& nx) {
    const unsigned G = gridDim.x * gridDim.y * gridDim.z;
    unsigned sum, cnt, mine, sp = 0u;
    for (;;) {
        sum = 0u; cnt = 0u; mine = 0u;
#pragma unroll
        for (unsigned j = 0; j < 16; ++j) { const unsigned c = xb_ld(&bar[XB_XCNT(j)]); sum += c; cnt += (c > 0u) ? 1u : 0u; mine = (j == x) ? c : mine; }
        if (sum == G) break;
        __builtin_amdgcn_s_sleep(1);
        if ((++sp & 255u) == 0u) { if (xb_ld(&bar[XB_TMO])) break; if (sp > XB_SPIN_CAP) { atomicAdd(&bar[XB_TMO], 1u); break; } }
    }
    nloc = mine > 0u ? mine : 1u; nx = cnt > 0u ? cnt : 1u;
}
__device__ __forceinline__ void xcd_barrier(const XcdBarrier& b) {
    asm volatile("s_waitcnt vmcnt(0)" ::: "memory");
    __syncthreads();
    if (threadIdx.x == 0) {
        unsigned* bar = b.bar;
        __builtin_amdgcn_s_waitcnt(0);
        unsigned nloc = b.st[0], nx = b.st[1];
        if (nloc == 0u) { xcd_barrier_complete(bar, b.x, nloc, nx); b.st[0] = nloc; b.st[1] = nx; }
        const unsigned old = xb_add(&bar[XB_XSUB(b.x)], 1u);
        const unsigned gen = old / nloc;
        if (old + 1u == (gen + 1u) * nloc) {
            __builtin_amdgcn_fence(__ATOMIC_RELEASE, "agent");
            asm volatile("s_waitcnt vmcnt(0)" ::: "memory");
            const unsigned og = xb_add(&bar[XB_TOP], 1u);
            const unsigned tg = og / nx;
            if (og + 1u == (tg + 1u) * nx) xb_add(&bar[XB_TOPGEN], 1u);
            else XB_SPIN(xb_ld(&bar[XB_TOPGEN]) == tg, bar);
            __builtin_amdgcn_fence(__ATOMIC_ACQUIRE, "agent");
            xb_add(&bar[XB_XGEN(b.x)], 1u);
            asm volatile("s_waitcnt vmcnt(0)" ::: "memory");
        } else {
            XB_SPIN(xb_ld(&bar[XB_XGEN(b.x)]) == gen, bar);
            __builtin_amdgcn_fence(__ATOMIC_ACQUIRE, "agent");
            asm volatile("s_waitcnt vmcnt(0)" ::: "memory");
        }
    }
    __syncthreads();
}

struct Args {
    const float* in[23];
    float* out;
    unsigned char* ws;
    int ph_lo, ph_hi, flags, pad;
};

namespace pg {
constexpr int HALF = 128, HTB = HALF * 64 * 2, PG_STAGE_BYTES = 8 * HTB;
__device__ __forceinline__ int lds_byte(int r, int c) { const int st = (r >> 4) * 2 + (c >> 5), rr = r & 15, cc = c & 31, ob = rr * 64 + cc * 2; return st * 1024 + (ob ^ (((ob >> 9) & 1) << 5)); }
__device__ __forceinline__ void stage_rc(int b, int& R, int& C) { const int st = b / 1024, sb = b % 1024, swz = sb ^ (((sb >> 9) & 1) << 5); R = (st >> 1) * 16 + swz / 64; C = (st & 1) * 32 + (swz % 64) / 2; }
struct Unit { unsigned a, b0, b1; int r0, c, aux, nv; };
typedef __amdgpu_buffer_rsrc_t rsrc_t;

template <class Epi, class Sched, bool GATHER, int BMAP = 0>
__device__ __forceinline__ void gemm_phase(LAS unsigned char* lds, unsigned char* wsbase, const int K, const Sched& S, const Epi& E) {
    const rsrc_t rs = __builtin_amdgcn_make_buffer_rsrc((void*)wsbase, 0, 0x7fffffff, 0x00020000);
    const int tid = threadIdx.x, wid = __builtin_amdgcn_readfirstlane(tid >> 6), lane = tid & 63, wr = wid >> 2, wc = wid & 3, fr = lane & 15, fq = lane >> 4;
    const int nt = K / 64;
    int Rr[2], Cc[2]; unsigned voffB[2], vA[2][2], nvA[2][2];
#pragma unroll
    for (int i = 0; i < 2; ++i) { stage_rc(tid * 16 + i * 8192, Rr[i], Cc[i]); const int Rb = BMAP ? (64 * (Rr[i] >> 5) + 16 * ((Rr[i] & 15) >> 2) + 4 * ((Rr[i] >> 4) & 1) + (Rr[i] & 3)) : ((Rr[i] & ~31) + perm32(Rr[i] & 31)); voffB[i] = (unsigned)(Rb * K + Cc[i]) * 2u; }
    const unsigned kstep = 128;
    const unsigned ldsw = (unsigned)wid * 1024u;
    const int aoff = lds_byte(wr * 64 + fr, fq * 8), boff = lds_byte(wc * 32 + fr, fq * 8);
#define PG_SA(b, h) (((b) * 2 + (h)) * pg::HTB)
#define PG_SB(b, h) ((4 + (b) * 2 + (h)) * pg::HTB)
#define PG_STG(bufoff, gbase, v0, v1) do { \
        __builtin_amdgcn_raw_ptr_buffer_load_lds(rs, (LAS unsigned*)(lds + (bufoff) + ldsw), 16, (int)(v0), (int)(gbase), 0, 0); \
        __builtin_amdgcn_raw_ptr_buffer_load_lds(rs, (LAS unsigned*)(lds + (bufoff) + ldsw + 8192), 16, (int)(v1), (int)(gbase), 0, 0); } while (0)
#define PG_STGB(bufoff, gbase) PG_STG(bufoff, gbase, voffB[0], voffB[1])
#define PG_LDA(dst, b, h) do { _Pragma("unroll") for (int m = 0; m < 4; ++m) _Pragma("unroll") for (int k = 0; k < 2; ++k) dst[m][k] = *(const LAS bf16x8*)(lds + PG_SA(b, h) + aoff + m * 2048 + k * 1024); } while (0)
#define PG_LDB(dst, b, h) do { _Pragma("unroll") for (int n = 0; n < 2; ++n) _Pragma("unroll") for (int k = 0; k < 2; ++k) dst[n][k] = *(const LAS bf16x8*)(lds + PG_SB(b, h) + boff + n * 2048 + k * 1024); } while (0)
#define PG_MMA(ai, bj, At, Bt) do { __builtin_amdgcn_s_setprio(1); _Pragma("unroll") for (int m = 0; m < 4; ++m) _Pragma("unroll") for (int n = 0; n < 2; ++n) _Pragma("unroll") for (int k = 0; k < 2; ++k) \
        acc[ai][bj][m][n] = __builtin_amdgcn_mfma_f32_16x16x32_bf16(Bt[n][k], At[m][k], acc[ai][bj][m][n], 0, 0, 0); __builtin_amdgcn_s_setprio(0); } while (0)
#define PG_WAIT_V(n) asm volatile("s_waitcnt vmcnt(" #n ")" ::: "memory")
#define PG_WAIT_L(n) asm volatile("s_waitcnt lgkmcnt(" #n ")" ::: "memory")
#define PG_BAR __builtin_amdgcn_s_barrier()
#define PG_SCHED __builtin_amdgcn_sched_barrier(0)
#define PG_VA(dst, u) do { _Pragma("unroll") for (int h = 0; h < 2; ++h) _Pragma("unroll") for (int i = 0; i < 2; ++i) \
        dst[h][i] = GATHER ? (unsigned)(S.row(u, h * pg::HALF + Rr[i]) * K + Cc[i]) * 2u : (unsigned)((h * pg::HALF + Rr[i]) * K + Cc[i]) * 2u; } while (0)
    Unit cur, nxt; int ui = 0;
    if (!S.next(0, cur)) return;
    f32x4 acc[2][2][4][2];
#pragma unroll
    for (int a = 0; a < 2; ++a)
#pragma unroll
        for (int b = 0; b < 2; ++b)
#pragma unroll
            for (int m = 0; m < 4; ++m)
#pragma unroll
                for (int n = 0; n < 2; ++n) acc[a][b][m][n] = (f32x4){0.f, 0.f, 0.f, 0.f};
    bf16x8 At[4][2], B0[2][2], B1[2][2];
    PG_VA(vA, cur);
#pragma unroll
    for (int h = 0; h < 2; ++h)
#pragma unroll
        for (int i = 0; i < 2; ++i) nvA[h][i] = vA[h][i];
    unsigned cA = cur.a, cB0 = cur.b0, cB1 = cur.b1;
    PG_STGB(PG_SB(0, 0), cB0); PG_STGB(PG_SB(0, 1), cB1); PG_STG(PG_SA(0, 0), cA, vA[0][0], vA[0][1]); PG_STG(PG_SA(0, 1), cA, vA[1][0], vA[1][1]);
    if (wr == 1) PG_BAR;
    PG_WAIT_V(2); PG_BAR;
    PG_STGB(PG_SB(1, 0), cB0 + kstep); PG_STG(PG_SA(1, 0), cA + kstep, vA[0][0], vA[0][1]); PG_STGB(PG_SB(1, 1), cB1 + kstep);
    PG_WAIT_V(6); PG_BAR;
    for (;;) {
        const bool has_next = S.next(ui + 1, nxt);
        const unsigned nA = has_next ? nxt.a : cA, nB0 = has_next ? nxt.b0 : cB0, nB1 = has_next ? nxt.b1 : cB1;
        for (int t = 0; t < nt; t += 2) {
            const bool last = (t == nt - 2);
            const unsigned a1 = cA + (unsigned)(t + 1) * kstep;
            const unsigned a2 = last ? nA : cA + (unsigned)(t + 2) * kstep;
            const unsigned b20 = last ? nB0 : cB0 + (unsigned)(t + 2) * kstep, b21 = last ? nB1 : cB1 + (unsigned)(t + 2) * kstep;
            const unsigned a3 = a2 + kstep, b30 = b20 + kstep, b31 = b21 + kstep;
            unsigned wA[2][2];
            if (GATHER) {
                if (last && has_next) PG_VA(nvA, nxt);
#pragma unroll
                for (int h = 0; h < 2; ++h)
#pragma unroll
                    for (int i = 0; i < 2; ++i) wA[h][i] = (last && has_next) ? nvA[h][i] : vA[h][i];
            } else {
#pragma unroll
                for (int h = 0; h < 2; ++h)
#pragma unroll
                    for (int i = 0; i < 2; ++i) wA[h][i] = vA[h][i];
            }
            PG_LDB(B0, 0, 0); PG_LDB(B1, 0, 1); PG_SCHED; PG_LDA(At, 0, 0); PG_STG(PG_SA(1, 1), a1, vA[1][0], vA[1][1]);
            PG_WAIT_V(8); PG_WAIT_L(0); PG_BAR; PG_MMA(0, 0, At, B0); PG_MMA(0, 1, At, B1); PG_BAR; PG_SCHED;
            PG_LDA(At, 0, 1); PG_STGB(PG_SB(0, 0), b20); PG_STGB(PG_SB(0, 1), b21); PG_STG(PG_SA(0, 0), a2, wA[0][0], wA[0][1]);
            PG_WAIT_V(8); PG_WAIT_L(0); PG_BAR; PG_MMA(1, 0, At, B0); PG_MMA(1, 1, At, B1); PG_BAR; PG_SCHED;
            PG_LDB(B0, 1, 0); PG_LDB(B1, 1, 1); PG_SCHED; PG_LDA(At, 1, 0); PG_STG(PG_SA(0, 1), a2, wA[1][0], wA[1][1]);
            PG_WAIT_V(8); PG_WAIT_L(0); PG_BAR; PG_MMA(0, 0, At, B0); PG_MMA(0, 1, At, B1); PG_BAR; PG_SCHED;
            PG_LDA(At, 1, 1); PG_STGB(PG_SB(1, 0), b30); PG_STGB(PG_SB(1, 1), b31); PG_STG(PG_SA(1, 0), a3, wA[0][0], wA[0][1]);
            PG_WAIT_V(8); PG_WAIT_L(0); PG_BAR; PG_MMA(1, 0, At, B0); PG_MMA(1, 1, At, B1); PG_BAR; PG_SCHED;
        }
        if (wr == 0) PG_BAR;
        E(acc, cur, wr, wc, fr, fq);
        if (!has_next) break;
#pragma unroll
        for (int a = 0; a < 2; ++a)
#pragma unroll
            for (int b = 0; b < 2; ++b)
#pragma unroll
                for (int m = 0; m < 4; ++m)
#pragma unroll
                    for (int n = 0; n < 2; ++n) acc[a][b][m][n] = (f32x4){0.f, 0.f, 0.f, 0.f};
        cur = nxt; cA = nA; cB0 = nB0; cB1 = nB1; ++ui;
        if (GATHER) {
#pragma unroll
            for (int h = 0; h < 2; ++h)
#pragma unroll
                for (int i = 0; i < 2; ++i) vA[h][i] = nvA[h][i];
        }
        if (wr == 1) PG_BAR;
    }
    PG_WAIT_V(0);
    PG_BAR;
#undef PG_SA
#undef PG_SB
#undef PG_STG
#undef PG_STGB
#undef PG_LDA
#undef PG_LDB
#undef PG_MMA
#undef PG_WAIT_V
#undef PG_WAIT_L
#undef PG_BAR
#undef PG_SCHED
#undef PG_VA
}
}

struct XcdSplit {
    int NU, G, bx;
    __device__ __forceinline__ bool unit(int i, int& u) const {
        if (G & 7) { u = bx + i * G; return u < NU; }
        const int x = bx & 7, li = bx >> 3, per = G >> 3, q = NU >> 3, r = NU & 7;
        const int start = x * q + (x < r ? x : r), len = q + (x < r ? 1 : 0), k = li + i * per;
        if (k >= len) return false;
        u = start + k; return true;
    }
};
__device__ __forceinline__ void dense_pmpn(int idx, int nN, int& pm, int& pn) { const int nig = 8 * nN, gid = idx / nig, rem = idx % nig; pm = gid * 8 + (rem & 7); pn = rem >> 3; }

__device__ __forceinline__ void store8_bf16(bf16* p, const f32x4& a, const f32x4& b) {
    u32x4 w; w.x = pk2(a[0], a[1]); w.y = pk2(a[2], a[3]); w.z = pk2(b[0], b[1]); w.w = pk2(b[2], b[3]); *(u32x4*)p = w;
}
typedef f32x4 acc_t[2][2][4][2];

__device__ __forceinline__ void transpose_item(const float* src, int K, int N, bf16* dst, int item, float* scr, int lane) {
    const int nblk = N / 64, kb = item / nblk, nb = item % nblk, k0 = kb * 64, n0 = nb * 64;
    const int lr = lane >> 4, lc = (lane & 15) * 4;
    f32x4 v[16];
    const float* sp = src + (size_t)(k0 + lr) * N + n0 + lc;
#pragma unroll
    for (int i = 0; i < 16; ++i) v[i] = __builtin_nontemporal_load((const f32x4*)(sp + (size_t)(4 * i) * N));
#pragma unroll
    for (int i = 0; i < 16; ++i) { float* d = scr + (4 * i + lr) * 65 + lc; d[0] = v[i][0]; d[1] = v[i][1]; d[2] = v[i][2]; d[3] = v[i][3]; }
    asm volatile("s_waitcnt lgkmcnt(0)" ::: "memory");
    const int c = lane & 7;
#pragma unroll
    for (int j = 0; j < 8; ++j) {
        const int n = (lane >> 3) + 8 * j; const float* s = scr + (8 * c) * 65 + n;
        u32x4 o; o.x = pk2(s[0], s[65]); o.y = pk2(s[2 * 65], s[3 * 65]); o.z = pk2(s[4 * 65], s[5 * 65]); o.w = pk2(s[6 * 65], s[7 * 65]);
        *(u32x4*)(dst + (size_t)(n0 + n) * K + k0 + 8 * c) = o;
    }
    asm volatile("s_waitcnt lgkmcnt(0)" ::: "memory");
}

__device__ __forceinline__ void phase_prep(const Args& a, unsigned char* lds, int G) {
    const int tid = threadIdx.x, lane = tid & 63, wid = tid >> 6, bx = blockIdx.x;
    unsigned char* ws = a.ws;
    {
        float* sc = (float*)lds;
        float* red = (float*)(lds + 32768);
        const float* c = a.in[1]; const float* w_ada = a.in[2]; const float* b_ada = a.in[3];
        float* mod = (float*)(ws + WS_MOD);
        for (int cb = bx; cb < 6144 / 32; cb += G) {
            __syncthreads();
            for (int i = tid; i < 8 * 1024; i += NTHREADS) sc[i] = siluf_(c[i]);
            __syncthreads();
            const int kg = tid >> 5, cl = tid & 31, col = cb * 32 + cl;
            float acc[8];
#pragma unroll
            for (int b = 0; b < 8; ++b) acc[b] = 0.f;
            for (int k = kg; k < 1024; k += 16) {
                const float wv = w_ada[(size_t)k * 6144 + col];
#pragma unroll
                for (int b = 0; b < 8; ++b) acc[b] += sc[b * 1024 + k] * wv;
            }
#pragma unroll
            for (int b = 0; b < 8; ++b) red[(kg * 8 + b) * 32 + cl] = acc[b];
            __syncthreads();
            if (tid < 256) {
                const int b = tid >> 5; float s = 0.f;
#pragma unroll
                for (int g = 0; g < 16; ++g) s += red[(g * 8 + b) * 32 + cl];
                mod[b * 6144 + col] = s + b_ada[col];
            }
        }
        __syncthreads();
    }
    {
        float* scr = (float*)(lds + wid * 16640);
        const int gw = bx * NWAVES + wid, NGW = G * NWAVES;
        constexpr int I_IN = 16 * 28, I_O = 16 * 16, I_S = 16 * 4, I_DS = 4 * 16, I_E = 16 * 4 * NE;
        constexpr int NITEMS = I_IN + I_O + 3 * I_S + I_DS + 3 * I_E;
        for (int it = gw; it < NITEMS; it += NGW) {
            int r = it;
            if (r < I_IN) { transpose_item(a.in[4], 1024, INC, (bf16*)(ws + WS_WINT), r, scr, lane); continue; } r -= I_IN;
            if (r < I_O) { transpose_item(a.in[10], 1024, 1024, (bf16*)(ws + WS_WOT), r, scr, lane); continue; } r -= I_O;
            if (r < I_S) { transpose_item(a.in[13], 1024, 256, (bf16*)(ws + WS_WCAT), r, scr, lane); continue; } r -= I_S;
            if (r < I_S) { transpose_item(a.in[18], 1024, 256, (bf16*)(ws + WS_WCAT) + 256 * 1024, r, scr, lane); continue; } r -= I_S;
            if (r < I_S) { transpose_item(a.in[19], 1024, 256, (bf16*)(ws + WS_WCAT) + 512 * 1024, r, scr, lane); continue; } r -= I_S;
            if (r < I_DS) { transpose_item(a.in[20], 256, 1024, (bf16*)(ws + WS_WDST), r, scr, lane); continue; } r -= I_DS;
            if (r < I_E) { const int e = r >> 6; transpose_item(a.in[15] + (size_t)e * 262144, 1024, 256, (bf16*)(ws + WS_WGT) + (size_t)e * 262144, r & 63, scr, lane); continue; } r -= I_E;
            if (r < I_E) { const int e = r >> 6; transpose_item(a.in[16] + (size_t)e * 262144, 1024, 256, (bf16*)(ws + WS_WUT) + (size_t)e * 262144, r & 63, scr, lane); continue; } r -= I_E;
            { const int e = r >> 6; transpose_item(a.in[17] + (size_t)e * 262144, 256, 1024, (bf16*)(ws + WS_WDT) + (size_t)e * 262144, r & 63, scr, lane); }
        }
    }
}

__device__ __forceinline__ void phase_hmod(const Args& a, int G) {
    const float* x = a.in[0]; const float* mod = (const float*)(a.ws + WS_MOD); bf16* h = (bf16*)(a.ws + WS_H2);
    const size_t nchunk = (size_t)T * DM / 8;
    for (size_t i = (size_t)blockIdx.x * NTHREADS + threadIdx.x; i < nchunk; i += (size_t)G * NTHREADS) {
        const size_t e0 = i * 8; const int row = (int)(e0 >> 10), col = (int)(e0 & 1023), b = row >> 12;
        const f32x4 v0 = *(const f32x4*)(x + e0), v1 = *(const f32x4*)(x + e0 + 4);
        const float* sh = mod + b * 6144 + col; const float* sc = sh + 1024;
        const f32x4 s0 = *(const f32x4*)sc, s1 = *(const f32x4*)(sc + 4), h0 = *(const f32x4*)sh, h1 = *(const f32x4*)(sh + 4);
        const f32x4 r0 = v0 * (s0 + 1.0f) + h0, r1 = v1 * (s1 + 1.0f) + h1;
        store8_bf16(h + e0, r0, r1);
    }
}

struct SchedProj {
    XcdSplit xs; unsigned A, Bt;
    __device__ __forceinline__ bool next(int i, pg::Unit& u) const {
        int idx; if (!xs.unit(i, idx)) return false; int pm, pn; dense_pmpn(idx, 7, pm, pn);
        u.a = A + (unsigned)pm * 256 * 2048; u.r0 = pm * 256; u.c = pn; u.aux = 0; u.nv = 0;
        if (pn < 3) { u.b0 = Bt + (unsigned)(256 * pn) * 2048; u.b1 = u.b0 + 128 * 2048; }
        else { const int j = pn - 3; u.b0 = Bt + (unsigned)(768 + 128 * j) * 2048; u.b1 = Bt + (unsigned)(1280 + 128 * j) * 2048; }
        return true; }
    __device__ __forceinline__ int row(const pg::Unit&, int) const { return 0; }
};
struct EpiProj {
    bf16* O;
    __device__ __forceinline__ void operator()(const acc_t& acc, const pg::Unit& u, int wr, int wc, int fr, int fq) const {
        const int row0 = u.r0 + wr * 64 + fr;
        if (u.c < 3) {
#pragma unroll
            for (int ai = 0; ai < 2; ++ai)
#pragma unroll
                for (int m = 0; m < 4; ++m) { bf16* rowp = O + (size_t)(row0 + ai * 128 + m * 16) * QW + 256 * u.c + wc * 32 + 8 * fq;
#pragma unroll
                    for (int bj = 0; bj < 2; ++bj) store8_bf16(rowp + bj * 128, acc[ai][bj][m][0], acc[ai][bj][m][1]); }
        } else {
            const int j = u.c - 3;
#pragma unroll
            for (int ai = 0; ai < 2; ++ai)
#pragma unroll
                for (int m = 0; m < 4; ++m) { bf16* rowp = O + (size_t)(row0 + ai * 128 + m * 16) * QW + 768 + 128 * j + wc * 32 + 8 * fq;
                    f32x4 r0, r1;
#pragma unroll
                    for (int q = 0; q < 4; ++q) { r0[q] = acc[ai][0][m][0][q] * sigmoidf_(acc[ai][1][m][0][q]); r1[q] = acc[ai][0][m][1][q] * sigmoidf_(acc[ai][1][m][1][q]); }
                    store8_bf16(rowp, r0, r1); }
        }
    }
};
__device__ __forceinline__ void phase_proj(const Args& a, unsigned char* lds, int G) {
    SchedProj S{XcdSplit{(T / 256) * 7, G, (int)blockIdx.x}, (unsigned)WS_H2, (unsigned)WS_WINT};
    EpiProj E{(bf16*)(a.ws + WS_QKVG)};
    pg::gemm_phase<EpiProj, SchedProj, false>((LAS unsigned char*)lds, a.ws, DM, S, E);
}

constexpr int VT_STRIDE = 280;
__device__ __forceinline__ void attn_unit(const Args& a, unsigned char* lds, int unit) {
    const bf16* QK = (const bf16*)(a.ws + WS_QKVG); bf16* AC = (bf16*)(a.ws + WS_AC);
    const int tid = threadIdx.x, lane = tid & 63, w = __builtin_amdgcn_readfirstlane(tid >> 6), fr = lane & 15, fq = lane >> 4;
    const int kh = unit & 1, nblk = (unit >> 1) & 31, b = unit >> 6;
    const int tok0 = b * SEQ + nblk * 128;
    unsigned char* Kl = lds;
    bf16* Vt = (bf16*)(lds + 272 * 128);
    __syncthreads();
#pragma unroll 1
    for (int idx = tid; idx < 272 * 8; idx += NTHREADS) {
        const int key = idx >> 3, c = idx & 7;
        u32x4 kv = (u32x4){0u, 0u, 0u, 0u}, vv = (u32x4){0u, 0u, 0u, 0u};
        if (key < 256 && (nblk > 0 || key >= 128)) {
            const bf16* rowp = QK + (size_t)(tok0 - 128 + key) * QW + 512 + 64 * kh + 8 * c;
            kv = *(const u32x4*)rowp; vv = *(const u32x4*)(rowp + 128);
        }
        *(u32x4*)(Kl + key * 128 + ((c ^ (key & 7)) * 16)) = kv;
        bf16* vp = Vt + (8 * c) * VT_STRIDE + key;
        vp[0] = (bf16)(vv.x & 0xffffu); vp[VT_STRIDE] = (bf16)(vv.x >> 16);
        vp[2 * VT_STRIDE] = (bf16)(vv.y & 0xffffu); vp[3 * VT_STRIDE] = (bf16)(vv.y >> 16);
        vp[4 * VT_STRIDE] = (bf16)(vv.z & 0xffffu); vp[5 * VT_STRIDE] = (bf16)(vv.z >> 16);
        vp[6 * VT_STRIDE] = (bf16)(vv.w & 0xffffu); vp[7 * VT_STRIDE] = (bf16)(vv.w >> 16);
    }
    __syncthreads();
    const float* sinks = a.in[5];
#pragma unroll 1
    for (int g = 0; g < 4; ++g) {
        const int h = kh * 4 + g;
        int lofs = 0; asm volatile("" : "+v"(lofs));
        const float slope = exp2f(-(float)(h + 1)), sink = sinks[h];
        const bf16* qp = QK + (size_t)(tok0 + 16 * w + fr) * QW + 64 * h + 8 * fq;
        const bf16x8 q0 = *(const bf16x8*)qp, q1 = *(const bf16x8*)(qp + 32);
        f32x4 st[10];
#pragma unroll
        for (int i = 0; i < 10; ++i) {
            const int key = 16 * (w + i) + fr;
            const unsigned char* kp = Kl + key * 128 + lofs;
            const bf16x8 k0 = *(const bf16x8*)(kp + ((fq ^ (fr & 7)) * 16)), k1 = *(const bf16x8*)(kp + (((fq + 4) ^ (fr & 7)) * 16));
            f32x4 s = (f32x4){0.f, 0.f, 0.f, 0.f};
            s = __builtin_amdgcn_mfma_f32_16x16x32_bf16(k0, q0, s, 0, 0, 0);
            s = __builtin_amdgcn_mfma_f32_16x16x32_bf16(k1, q1, s, 0, 0, 0);
            st[i] = s;
        }
        float mx = -INFINITY;
#pragma unroll
        for (int i = 0; i < 10; ++i)
#pragma unroll
            for (int r = 0; r < 4; ++r) {
                const int dist = 128 + fr - 16 * i - 4 * fq - r;
                const int kj = 16 * (w + i) + 4 * fq + r;
                const bool valid = (dist >= 0) && (dist < 128) && (nblk > 0 || kj >= 128);
                const float s = valid ? (st[i][r] * 0.125f - slope * (float)dist) : -INFINITY;
                st[i][r] = s; mx = fmaxf(mx, s);
            }
        mx = fmaxf(mx, __shfl_xor(mx, 16)); mx = fmaxf(mx, __shfl_xor(mx, 32));
        mx = fmaxf(mx, sink);
        float sum = 0.f;
#pragma unroll
        for (int i = 0; i < 10; ++i)
#pragma unroll
            for (int r = 0; r < 4; ++r) { const float p = __expf(st[i][r] - mx); st[i][r] = p; sum += p; }
        sum += __shfl_xor(sum, 16); sum += __shfl_xor(sum, 32);
        const float inv = 1.0f / (sum + __expf(sink - mx));
        f32x4 o[4];
#pragma unroll
        for (int nt = 0; nt < 4; ++nt) o[nt] = (f32x4){0.f, 0.f, 0.f, 0.f};
#pragma unroll
        for (int s5 = 0; s5 < 5; ++s5) {
            u32x4 pw; pw.x = pk2(st[2 * s5][0], st[2 * s5][1]); pw.y = pk2(st[2 * s5][2], st[2 * s5][3]); pw.z = pk2(st[2 * s5 + 1][0], st[2 * s5 + 1][1]); pw.w = pk2(st[2 * s5 + 1][2], st[2 * s5 + 1][3]);
            const bf16x8 pf = __builtin_bit_cast(bf16x8, pw);
#pragma unroll
            for (int nt = 0; nt < 4; ++nt) {
                const bf16* vp = Vt + (16 * nt + fr) * VT_STRIDE + 16 * (w + 2 * s5) + 4 * fq + lofs;
                const u32x2 va = *(const u32x2*)vp, vb = *(const u32x2*)(vp + 16);
                u32x4 vw; vw.x = va.x; vw.y = va.y; vw.z = vb.x; vw.w = vb.y;
                o[nt] = __builtin_amdgcn_mfma_f32_16x16x32_bf16(__builtin_bit_cast(bf16x8, vw), pf, o[nt], 0, 0, 0);
            }
        }
        bf16* op = AC + (size_t)(tok0 + 16 * w + fr) * DM + 64 * h + 4 * fq;
#pragma unroll
        for (int nt = 0; nt < 4; ++nt) { u32x2 ow; ow.x = pk2(o[nt][0] * inv, o[nt][1] * inv); ow.y = pk2(o[nt][2] * inv, o[nt][3] * inv); *(u32x2*)(op + 16 * nt) = ow; }
    }
}

__device__ __forceinline__ void conv_unit(const Args& a, unsigned char* lds, int unit) {
    const bf16* QK = (const bf16*)(a.ws + WS_QKVG); bf16* AC = (bf16*)(a.ws + WS_AC);
    const int tid = threadIdx.x, lane = tid & 63, wid = tid >> 6;
    const int t0 = unit * 32, b = t0 >> 12, s0 = t0 & 4095, c = tid;
    bf16* inp = (bf16*)lds;
    float* yb = (float*)(lds + 62 * CW * 2);
    __syncthreads();
    for (int idx = tid; idx < 62 * 64; idx += NTHREADS) {
        const int i = idx >> 6, ch = idx & 63, s = s0 - 30 + i;
        u32x4 v = (u32x4){0u, 0u, 0u, 0u};
        if (s >= 0) v = *(const u32x4*)(QK + (size_t)(b * SEQ + s) * QW + 768 + 8 * ch);
        *(u32x4*)(inp + i * CW + 8 * ch) = v;
    }
    const float* cw = a.in[6];
    float wgt[CK];
#pragma unroll
    for (int j = 0; j < CK; ++j) wgt[j] = cw[j * CW + c];
    float acc[32];
    const float bias = a.in[7][c];
#pragma unroll
    for (int t = 0; t < 32; ++t) acc[t] = bias;
    __syncthreads();
#pragma unroll
    for (int i = 0; i < 62; ++i) {
        const float v = bf2f(inp[i * CW + c]);
#pragma unroll
        for (int t = 0; t < 32; ++t) { const int j = i - t; if (j >= 0 && j < CK) acc[t] += v * wgt[j]; }
    }
#pragma unroll
    for (int t = 0; t < 32; ++t) yb[t * CW + c] = acc[t];
    __syncthreads();
    const float* lg = a.in[8]; const float* lb = a.in[9];
    const f32x4 g0 = *(const f32x4*)(lg + 8 * lane), g1 = *(const f32x4*)(lg + 8 * lane + 4), b0 = *(const f32x4*)(lb + 8 * lane), b1 = *(const f32x4*)(lb + 8 * lane + 4);
#pragma unroll
    for (int q = 0; q < 4; ++q) {
        const int t = wid * 4 + q;
        f32x4 v0 = *(const f32x4*)(yb + t * CW + 8 * lane), v1 = *(const f32x4*)(yb + t * CW + 8 * lane + 4);
        const float mean = wave_sum((v0[0] + v0[1]) + (v0[2] + v0[3]) + (v1[0] + v1[1]) + (v1[2] + v1[3])) * (1.0f / CW);
        v0 = v0 - mean; v1 = v1 - mean;
        const float var = wave_sum((v0[0] * v0[0] + v0[1] * v0[1]) + (v0[2] * v0[2] + v0[3] * v0[3]) + (v1[0] * v1[0] + v1[1] * v1[1]) + (v1[2] * v1[2] + v1[3] * v1[3])) * (1.0f / CW);
        const float rstd = rsqrtf(var + LN_EPS);
        f32x4 r0 = v0 * rstd * g0 + b0, r1 = v1 * rstd * g1 + b1;
#pragma unroll
        for (int e = 0; e < 4; ++e) { r0[e] = siluf_(r0[e]); r1[e] = siluf_(r1[e]); }
        store8_bf16(AC + (size_t)(t0 + t) * DM + 512 + 8 * lane, r0, r1);
    }
}

__device__ __forceinline__ void phase_mixer(const Args& a, unsigned char* lds, int G) {
    for (int u = blockIdx.x; u < NB * 32 * NKVH; u += G) attn_unit(a, lds, u);
    for (int u = blockIdx.x; u < T / 32; u += G) conv_unit(a, lds, u);
}

struct SchedWo {
    XcdSplit xs; unsigned A, Bt;
    __device__ __forceinline__ bool next(int i, pg::Unit& u) const {
        int idx; if (!xs.unit(i, idx)) return false; int pm, pn; dense_pmpn(idx, 4, pm, pn);
        u.a = A + (unsigned)pm * 256 * 2048; u.r0 = pm * 256; u.c = pn; u.aux = 0; u.nv = 0;
        u.b0 = Bt + (unsigned)(256 * pn) * 2048; u.b1 = u.b0 + 128 * 2048; return true; }
    __device__ __forceinline__ int row(const pg::Unit&, int) const { return 0; }
};
struct EpiWo {
    const float* mod; bf16* mix;
    __device__ __forceinline__ void operator()(const acc_t& acc, const pg::Unit& u, int wr, int wc, int fr, int fq) const {
        const int row0 = u.r0 + wr * 64 + fr, bb = u.r0 >> 12, col0 = 256 * u.c + wc * 32 + 8 * fq;
        f32x4 g[2][2];
#pragma unroll
        for (int bj = 0; bj < 2; ++bj)
#pragma unroll
            for (int n = 0; n < 2; ++n) g[bj][n] = *(const f32x4*)(mod + bb * 6144 + 2048 + col0 + 128 * bj + 4 * n) + 1.0f;
#pragma unroll
        for (int ai = 0; ai < 2; ++ai)
#pragma unroll
            for (int m = 0; m < 4; ++m) { bf16* rowp = mix + (size_t)(row0 + ai * 128 + m * 16) * DM + col0;
#pragma unroll
                for (int bj = 0; bj < 2; ++bj) store8_bf16(rowp + 128 * bj, g[bj][0] * acc[ai][bj][m][0], g[bj][1] * acc[ai][bj][m][1]); }
    }
};
__device__ __forceinline__ void phase_wo(const Args& a, unsigned char* lds, int G) {
    SchedWo S{XcdSplit{(T / 256) * 4, G, (int)blockIdx.x}, (unsigned)WS_AC, (unsigned)WS_WOT};
    EpiWo E{(const float*)(a.ws + WS_MOD), (bf16*)(a.ws + WS_MIX)};
    pg::gemm_phase<EpiWo, SchedWo, false>((LAS unsigned char*)lds, a.ws, DM, S, E);
}

__device__ __forceinline__ void phase_ln1(const Args& a, int G) {
    const float* mod = (const float*)(a.ws + WS_MOD); const float* x = a.in[0]; const bf16* mix = (const bf16*)(a.ws + WS_MIX);
    bf16* x1b = (bf16*)(a.ws + WS_X1B); bf16* h2 = (bf16*)(a.ws + WS_H2);
    const float* lg = a.in[11]; const float* lb = a.in[12];
    const int lane = threadIdx.x & 63, wid = threadIdx.x >> 6;
    for (int m = blockIdx.x * NWAVES + wid; m < T; m += G * NWAVES) {
        const int bb = m >> 12; const float* xr = x + (size_t)m * DM; const bf16* mr = mix + (size_t)m * DM;
        f32x4 v[4]; float s = 0.f;
#pragma unroll
        for (int q = 0; q < 4; ++q) { const int n = 4 * lane + 256 * q; const f32x4 xv = *(const f32x4*)(xr + n); const u32x2 mw = *(const u32x2*)(mr + n);
            v[q] = xv * ALPHA + (f32x4){bflo(mw.x), bfhi(mw.x), bflo(mw.y), bfhi(mw.y)}; s += (v[q][0] + v[q][1]) + (v[q][2] + v[q][3]); }
        const float mean = wave_sum(s) * (1.0f / DM); float s2 = 0.f;
#pragma unroll
        for (int q = 0; q < 4; ++q) { v[q] = v[q] - mean; s2 += (v[q][0] * v[q][0] + v[q][1] * v[q][1]) + (v[q][2] * v[q][2] + v[q][3] * v[q][3]); }
        const float rstd = rsqrtf(wave_sum(s2) * (1.0f / DM) + LN_EPS);
#pragma unroll
        for (int q = 0; q < 4; ++q) {
            const int n = 4 * lane + 256 * q;
            const f32x4 x1 = v[q] * rstd * *(const f32x4*)(lg + n) + *(const f32x4*)(lb + n);
            u32x2 w1; w1.x = pk2(x1[0], x1[1]); w1.y = pk2(x1[2], x1[3]); *(u32x2*)(x1b + (size_t)m * DM + n) = w1;
            const f32x4 hh = x1 * (*(const f32x4*)(mod + bb * 6144 + 4096 + n) + 1.0f) + *(const f32x4*)(mod + bb * 6144 + 3072 + n);
            u32x2 w; w.x = pk2(hh[0], hh[1]); w.y = pk2(hh[2], hh[3]); *(u32x2*)(h2 + (size_t)m * DM + n) = w;
        }
    }
}

struct SchedRs {
    XcdSplit xs; unsigned A, Bt;
    __device__ __forceinline__ bool next(int i, pg::Unit& u) const {
        int idx; if (!xs.unit(i, idx)) return false; int pm, pn; dense_pmpn(idx, 3, pm, pn);
        u.a = A + (unsigned)pm * 256 * 2048; u.r0 = pm * 256; u.c = pn; u.aux = 0; u.nv = 0;
        if (pn == 0) { u.b0 = Bt; u.b1 = Bt + 128 * 2048; }
        else { const int j = pn - 1; u.b0 = Bt + (unsigned)(256 + 128 * j) * 2048; u.b1 = Bt + (unsigned)(512 + 128 * j) * 2048; }
        return true; }
    __device__ __forceinline__ int row(const pg::Unit&, int) const { return 0; }
};
struct EpiRs {
    float* logits; bf16* hs;
    __device__ __forceinline__ void operator()(const acc_t& acc, const pg::Unit& u, int wr, int wc, int fr, int fq) const {
        const int row0 = u.r0 + wr * 64 + fr;
        if (u.c == 0) {
#pragma unroll
            for (int ai = 0; ai < 2; ++ai)
#pragma unroll
                for (int m = 0; m < 4; ++m) { float* rowp = logits + (size_t)(row0 + ai * 128 + m * 16) * NE + wc * 32 + 8 * fq;
#pragma unroll
                    for (int bj = 0; bj < 2; ++bj) { *(f32x4*)(rowp + 128 * bj) = acc[ai][bj][m][0]; *(f32x4*)(rowp + 128 * bj + 4) = acc[ai][bj][m][1]; } }
        } else {
            const int j = u.c - 1;
#pragma unroll
            for (int ai = 0; ai < 2; ++ai)
#pragma unroll
                for (int m = 0; m < 4; ++m) { bf16* rowp = hs + (size_t)(row0 + ai * 128 + m * 16) * FE + 128 * j + wc * 32 + 8 * fq;
                    f32x4 r0, r1;
#pragma unroll
                    for (int q = 0; q < 4; ++q) { r0[q] = siluf_(acc[ai][0][m][0][q]) * acc[ai][1][m][0][q]; r1[q] = siluf_(acc[ai][0][m][1][q]) * acc[ai][1][m][1][q]; }
                    store8_bf16(rowp, r0, r1); }
        }
    }
};
__device__ __forceinline__ void phase_rs(const Args& a, unsigned char* lds, int G) {
    SchedRs S{XcdSplit{(T / 256) * 3, G, (int)blockIdx.x}, (unsigned)WS_H2, (unsigned)WS_WCAT};
    EpiRs E{(float*)(a.ws + WS_LOG), (bf16*)(a.ws + WS_HS)};
    pg::gemm_phase<EpiRs, SchedRs, false>((LAS unsigned char*)lds, a.ws, DM, S, E);
}

#define DPPF(v, ctrl) __int_as_float(__builtin_amdgcn_update_dpp(0, __float_as_int(v), (ctrl), 0xf, 0xf, true))
__device__ __forceinline__ float wave_max_dpp(float v) {
    v = fmaxf(v, DPPF(v, 0xB1)); v = fmaxf(v, DPPF(v, 0x4E)); v = fmaxf(v, DPPF(v, 0x141)); v = fmaxf(v, DPPF(v, 0x140));
    const float r0 = __int_as_float(__builtin_amdgcn_readlane(__float_as_int(v), 0)), r1 = __int_as_float(__builtin_amdgcn_readlane(__float_as_int(v), 16));
    const float r2 = __int_as_float(__builtin_amdgcn_readlane(__float_as_int(v), 32)), r3 = __int_as_float(__builtin_amdgcn_readlane(__float_as_int(v), 48));
    return fmaxf(fmaxf(r0, r1), fmaxf(r2, r3));
}
__device__ __forceinline__ void phase_route(const Args& a, unsigned char* lds, int G) {
    const float* logits = (const float*)(a.ws + WS_LOG); const float* rbias = a.in[14];
    int* gcount = (int*)(a.ws + WS_GCNT); int* rdst = (int*)(a.ws + WS_RDST); float* ew = (float*)(a.ws + WS_EW);
    const int tid = threadIdx.x, lane = tid & 63, wid = tid >> 6;
    int* hist = (int*)lds; int* base = hist + 256; int* pe = hist + 512; float* pw = (float*)(hist + 512 + 2048);
    __syncthreads();
    if (tid < NE) hist[tid] = 0;
    __syncthreads();
    const int chunk = (T + G - 1) / G, tbeg = blockIdx.x * chunk, tend = min(T, tbeg + chunk);
    const f32x4 bv = *(const f32x4*)(rbias + 4 * lane);
    for (int t = tbeg + wid; t < tend; t += NWAVES) {
        const f32x4 lg = *(const f32x4*)(logits + (size_t)t * NE + 4 * lane);
        float sc[4], v[4];
#pragma unroll
        for (int i = 0; i < 4; ++i) { sc[i] = sigmoidf_ref(lg[i]); v[i] = sc[i] + bv[i]; }
        float a1 = fmaxf(v[0], v[1]), a2 = fminf(v[0], v[1]);
        { const float c1 = fmaxf(v[2], v[3]), c2 = fminf(v[2], v[3]); const float n1 = fmaxf(a1, c1), n2 = fmaxf(fminf(a1, c1), fmaxf(a2, c2)); a1 = n1; a2 = n2; }
        { const float c1 = DPPF(a1, 0xB1), c2 = DPPF(a2, 0xB1); const float n1 = fmaxf(a1, c1), n2 = fmaxf(fminf(a1, c1), fmaxf(a2, c2)); a1 = n1; a2 = n2; }
        { const float c1 = DPPF(a1, 0x4E), c2 = DPPF(a2, 0x4E); const float n1 = fmaxf(a1, c1), n2 = fmaxf(fminf(a1, c1), fmaxf(a2, c2)); a1 = n1; a2 = n2; }
        { const float c1 = DPPF(a1, 0x141), c2 = DPPF(a2, 0x141); const float n1 = fmaxf(a1, c1), n2 = fmaxf(fminf(a1, c1), fmaxf(a2, c2)); a1 = n1; a2 = n2; }
        const float gs = a1 + a2; const int mg = lane >> 3; int rank = 0;
#pragma unroll
        for (int g = 0; g < 8; ++g) { const float o = __int_as_float(__builtin_amdgcn_readlane(__float_as_int(gs), 8 * g)); rank += (o > gs || (o == gs && g < mg)) ? 1 : 0; }
        if (rank >= 4) { v[0] = -INFINITY; v[1] = -INFINITY; v[2] = -INFINITY; v[3] = -INFINITY; }
        int my_e = 0; float my_w = 0.f, wsum = 0.f;
#pragma unroll
        for (int r = 0; r < TOPK; ++r) {
            const float m = fmaxf(fmaxf(v[0], v[1]), fmaxf(v[2], v[3]));
            const float M = wave_max_dpp(m);
            const unsigned long long mask = __ballot(m == M);
            const int L = __builtin_amdgcn_readfirstlane((int)__builtin_ctzll(mask));
            const int li = (v[0] == M) ? 0 : (v[1] == M) ? 1 : (v[2] == M) ? 2 : 3;
            const float ls = (li == 0) ? sc[0] : (li == 1) ? sc[1] : (li == 2) ? sc[2] : sc[3];
            const int wi = __builtin_amdgcn_readlane(li, L);
            const float wv = __int_as_float(__builtin_amdgcn_readlane(__float_as_int(ls), L));
            if (lane == L) { if (li == 0) v[0] = -INFINITY; else if (li == 1) v[1] = -INFINITY; else if (li == 2) v[2] = -INFINITY; else v[3] = -INFINITY; }
            wsum += wv;
            if (lane == r) { my_e = 4 * L + wi; my_w = wv; }
        }
        if (lane < TOPK) {
            const int p = (t - tbeg) * TOPK + lane;
            pe[p] = my_e; pw[p] = my_w / wsum * 2.5f;
            atomicAdd(&hist[my_e], 1);
        }
    }
    __syncthreads();
    if (tid < NE) { const int h = hist[tid]; base[tid] = h ? __hip_atomic_fetch_add(&gcount[tid], h, __ATOMIC_RELAXED, __HIP_MEMORY_SCOPE_AGENT) : 0; hist[tid] = 0; }
    __syncthreads();
    const int np = (tend - tbeg) * TOPK;
    for (int i = tid; i < np; i += NTHREADS) {
        const int e = pe[i];
        const int r = base[e] + atomicAdd(&hist[e], 1);
        rdst[(size_t)e * RCAP + r] = tbeg * TOPK + i; ew[tbeg * TOPK + i] = pw[i];
    }
}

__device__ __forceinline__ int moe_prefix(const int* gcount, int* pref, int* scr) {
    const int tid = threadIdx.x;
    __syncthreads();
    int nt_e = 0;
    if (tid < NE) { nt_e = (gcount[tid] + 255) >> 8; scr[tid] = nt_e; }
    __syncthreads();
    int cur = 0;
    for (int o = 1; o < NE; o <<= 1) {
        if (tid < NE) scr[(cur ^ 1) * 256 + tid] = scr[cur * 256 + tid] + ((tid >= o) ? scr[cur * 256 + tid - o] : 0);
        cur ^= 1;
        __syncthreads();
    }
    if (tid < NE) { const int incl = scr[cur * 256 + tid]; pref[tid] = incl - nt_e; if (tid == NE - 1) pref[NE] = incl; }
    __syncthreads();
    return pref[NE];
}
__device__ __forceinline__ int moe_tile_expert(const int* pref, int tile) {
    int lo = 0, hi = NE - 1;
    while (lo < hi) { const int mid = (lo + hi + 1) >> 1; if (pref[mid] <= tile) lo = mid; else hi = mid - 1; }
    return lo;
}

constexpr int LIST_OFF = pg::PG_STAGE_BYTES, MAX_LISTS = 12, PREF_OFF = LIST_OFF + MAX_LISTS * 1024, DESC_OFF = PREF_OFF + 1040, MAX_DESC = 48;
struct SchedMoe1 {
    XcdSplit xs; unsigned A, Wg, Wu; const int* desc; const int* lists;
    __device__ __forceinline__ bool next(int i, pg::Unit& u) const {
        int idx; if (!xs.unit(i, idx)) return false; const int e = __builtin_amdgcn_readfirstlane(desc[2 * i]), tile = idx >> 1, j = idx & 1;
        u.a = A; u.r0 = tile * 256; u.c = j; u.aux = i; u.nv = 0;
        u.b0 = Wg + (unsigned)(e * 256 + 128 * j) * 2048; u.b1 = Wu + (unsigned)(e * 256 + 128 * j) * 2048; return true; }
    __device__ __forceinline__ int row(const pg::Unit& u, int r) const { return lists[u.aux * 256 + r]; }
};
struct EpiMoe1 {
    bf16* H;
    __device__ __forceinline__ void operator()(const acc_t& acc, const pg::Unit& u, int wr, int wc, int fr, int fq) const {
        const int row0 = u.r0 + wr * 64 + fr;
#pragma unroll
        for (int ai = 0; ai < 2; ++ai)
#pragma unroll
            for (int m = 0; m < 4; ++m) { bf16* rowp = H + (size_t)(row0 + ai * 128 + m * 16) * FE + 128 * u.c + wc * 32 + 8 * fq;
                f32x4 r0, r1;
#pragma unroll
                for (int q = 0; q < 4; ++q) { r0[q] = siluf_(acc[ai][0][m][0][q]) * acc[ai][1][m][0][q]; r1[q] = siluf_(acc[ai][0][m][1][q]) * acc[ai][1][m][1][q]; }
                store8_bf16(rowp, r0, r1); }
    }
};
__device__ __forceinline__ void phase_moe1(const Args& a, unsigned char* lds, int G) {
    const int* gcount = (const int*)(a.ws + WS_GCNT); const int* rdst = (const int*)(a.ws + WS_RDST);
    int* lists = (int*)(lds + LIST_OFF); int* pref = (int*)(lds + PREF_OFF); int* desc = (int*)(lds + DESC_OFF);
    const int ntiles = moe_prefix(gcount, pref, (int*)lds);
    XcdSplit xs{ntiles * 2, G, (int)blockIdx.x};
    for (int i = 0; i < MAX_LISTS; ++i) {
        int idx; if (!xs.unit(i, idx)) break;
        const int tile = idx >> 1, e = moe_tile_expert(pref, tile), tin = tile - pref[e], cnt = gcount[e];
        if (threadIdx.x < 256) { const int pos = tin * 256 + (int)threadIdx.x; lists[i * 256 + threadIdx.x] = (pos < cnt) ? (rdst[(size_t)e * RCAP + pos] >> 3) : 0; }
        if (threadIdx.x == 0) { desc[2 * i] = e; desc[2 * i + 1] = tin; }
    }
    __syncthreads();
    SchedMoe1 S{xs, (unsigned)WS_H2, (unsigned)WS_WGT, (unsigned)WS_WUT, desc, lists};
    EpiMoe1 E{(bf16*)(a.ws + WS_H)};
    pg::gemm_phase<EpiMoe1, SchedMoe1, true>((LAS unsigned char*)lds, a.ws, DM, S, E);
}

struct SchedMoe2 {
    XcdSplit xs; int NU2; unsigned Hb, Wd, hs, Wds; const int* desc;
    __device__ __forceinline__ bool next(int i, pg::Unit& u) const {
        int idx; if (!xs.unit(i, idx)) return false;
        if (idx < NU2) { const int tile = idx >> 2, jn = idx & 3, e = __builtin_amdgcn_readfirstlane(desc[2 * i]), nv = __builtin_amdgcn_readfirstlane(desc[2 * i + 1]);
            u.a = Hb + (unsigned)tile * 256 * 512; u.r0 = tile * 256; u.c = jn; u.aux = e; u.nv = nv;
            u.b0 = Wd + (unsigned)(e * 1024 + 256 * jn) * 512; u.b1 = u.b0 + 8 * 512; }
        else { int pm, pn; dense_pmpn(idx - NU2, 4, pm, pn);
            u.a = hs + (unsigned)pm * 256 * 512; u.r0 = pm * 256; u.c = pn; u.aux = -1; u.nv = 0;
            u.b0 = Wds + (unsigned)(256 * pn) * 512; u.b1 = u.b0 + 8 * 512; }
        return true; }
    __device__ __forceinline__ int row(const pg::Unit&, int) const { return 0; }
};
__device__ __forceinline__ unsigned pk4_fp8(const f32x4& v, float sc) {
    int w = 0;
    w = __builtin_amdgcn_cvt_pk_fp8_f32(__builtin_amdgcn_fmed3f(v[0] * sc, -440.f, 440.f), __builtin_amdgcn_fmed3f(v[1] * sc, -440.f, 440.f), w, false);
    w = __builtin_amdgcn_cvt_pk_fp8_f32(__builtin_amdgcn_fmed3f(v[2] * sc, -440.f, 440.f), __builtin_amdgcn_fmed3f(v[3] * sc, -440.f, 440.f), w, true);
    return (unsigned)w;
}
constexpr float Y_SCALE = 64.0f;
struct EpiMoe2 {
    unsigned char* Y; bf16* SD; const int* rdst; const float* rw; const int* pref; int flags;
    __device__ __forceinline__ void operator()(const acc_t& acc, const pg::Unit& u, int wr, int wc, int fr, int fq) const {
        const int col0 = 256 * u.c + wc * 64 + 16 * fq;
        if (u.aux >= 0) {
            const int tin256 = u.r0 - pref[u.aux] * 256;
            const size_t lbase = (size_t)u.aux * RCAP;
#pragma unroll
            for (int ai = 0; ai < 2; ++ai)
#pragma unroll
                for (int m = 0; m < 4; ++m) { const int pos = tin256 + wr * 64 + fr + ai * 128 + m * 16;
                    if (pos < u.nv && !(flags & 1)) { const int dst = rdst[lbase + pos]; const float wv = rw[dst] * Y_SCALE;
                        u32x4 o; o.x = pk4_fp8(acc[ai][0][m][0], wv); o.y = pk4_fp8(acc[ai][0][m][1], wv); o.z = pk4_fp8(acc[ai][1][m][0], wv); o.w = pk4_fp8(acc[ai][1][m][1], wv);
                        *(u32x4*)(Y + (size_t)dst * DM + col0) = o; } }
        } else {
            const int row0 = u.r0 + wr * 64 + fr;
#pragma unroll
            for (int ai = 0; ai < 2; ++ai)
#pragma unroll
                for (int m = 0; m < 4; ++m) { bf16* rowp = SD + (size_t)(row0 + ai * 128 + m * 16) * DM + col0;
#pragma unroll
                    for (int bj = 0; bj < 2; ++bj) store8_bf16(rowp + 8 * bj, acc[ai][bj][m][0], acc[ai][bj][m][1]); }
        }
    }
};
__device__ __forceinline__ void phase_moe2(const Args& a, unsigned char* lds, int G) {
    const int* gcount = (const int*)(a.ws + WS_GCNT);
    int* pref = (int*)(lds + PREF_OFF); int* desc = (int*)(lds + DESC_OFF);
    const int ntiles = moe_prefix(gcount, pref, (int*)lds);
    const int NU2 = ntiles * 4;
    XcdSplit xs{NU2 + (T / 256) * 4, G, (int)blockIdx.x};
    if (threadIdx.x == 0) {
        for (int i = 0; i < MAX_DESC; ++i) { int idx; if (!xs.unit(i, idx)) break; if (idx >= NU2) break;
            const int e = moe_tile_expert(pref, idx >> 2); desc[2 * i] = e; desc[2 * i + 1] = gcount[e]; }
    }
    __syncthreads();
    SchedMoe2 S{xs, NU2, (unsigned)WS_H, (unsigned)WS_WDT, (unsigned)WS_HS, (unsigned)WS_WDST, desc};
    EpiMoe2 E{(unsigned char*)(a.ws + WS_Y), (bf16*)(a.ws + WS_SD), (const int*)(a.ws + WS_RDST), (const float*)(a.ws + WS_EW), pref, a.flags};
    pg::gemm_phase<EpiMoe2, SchedMoe2, false, 1>((LAS unsigned char*)lds, a.ws, FE, S, E);
}

__device__ __forceinline__ void phase_final(const Args& a, int G) {
    const float* mod = (const float*)(a.ws + WS_MOD); float* out = a.out;
    const bf16* SD = (const bf16*)(a.ws + WS_SD); const unsigned char* Y = (const unsigned char*)(a.ws + WS_Y); const bf16* x1b = (const bf16*)(a.ws + WS_X1B);
    const float* lg = a.in[21]; const float* lb = a.in[22];
    const int lane = threadIdx.x & 63, wid = threadIdx.x >> 6, n0 = 16 * lane;
    for (int m = blockIdx.x * NWAVES + wid; m < T; m += G * NWAVES) {
        const int bb = m >> 12; float* rowp = out + (size_t)m * DM + n0;
        u32x4 yw[TOPK];
#pragma unroll
        for (int k = 0; k < TOPK; ++k) yw[k] = *(const u32x4*)(Y + ((size_t)m * TOPK + k) * DM + n0);
        const u32x4 sa = *(const u32x4*)(SD + (size_t)m * DM + n0), sb = *(const u32x4*)(SD + (size_t)m * DM + n0 + 8);
        const u32x4 xa = *(const u32x4*)(x1b + (size_t)m * DM + n0), xb = *(const u32x4*)(x1b + (size_t)m * DM + n0 + 8);
        f32x4 f[4];
#pragma unroll
        for (int q = 0; q < 4; ++q) f[q] = (f32x4){0.f, 0.f, 0.f, 0.f};
#pragma unroll
        for (int k = 0; k < TOPK; ++k)
#pragma unroll
            for (int q = 0; q < 4; ++q) { const int w = (int)yw[k][q]; const f32x2v lo = __builtin_amdgcn_cvt_pk_f32_fp8(w, false), hi = __builtin_amdgcn_cvt_pk_f32_fp8(w, true);
                f[q][0] += lo.x; f[q][1] += lo.y; f[q][2] += hi.x; f[q][3] += hi.y; }
        f32x4 v[4]; float s = 0.f;
#pragma unroll
        for (int q = 0; q < 4; ++q) {
            const unsigned s0 = (q < 2) ? sa[2 * q] : sb[2 * q - 4], s1 = (q < 2) ? sa[2 * q + 1] : sb[2 * q - 3];
            const unsigned x0 = (q < 2) ? xa[2 * q] : xb[2 * q - 4], x1w = (q < 2) ? xa[2 * q + 1] : xb[2 * q - 3];
            const f32x4 ffn = f[q] * (1.0f / Y_SCALE) + (f32x4){bflo(s0), bfhi(s0), bflo(s1), bfhi(s1)};
            const f32x4 x1 = (f32x4){bflo(x0), bfhi(x0), bflo(x1w), bfhi(x1w)};
            v[q] = x1 * ALPHA + (*(const f32x4*)(mod + bb * 6144 + 5120 + n0 + 4 * q) + 1.0f) * ffn;
            s += (v[q][0] + v[q][1]) + (v[q][2] + v[q][3]);
        }
        const float mean = wave_sum(s) * (1.0f / DM); float s2 = 0.f;
#pragma unroll
        for (int q = 0; q < 4; ++q) { v[q] = v[q] - mean; s2 += (v[q][0] * v[q][0] + v[q][1] * v[q][1]) + (v[q][2] * v[q][2] + v[q][3] * v[q][3]); }
        const float rstd = rsqrtf(wave_sum(s2) * (1.0f / DM) + LN_EPS);
#pragma unroll
        for (int q = 0; q < 4; ++q) *(f32x4*)(rowp + 4 * q) = v[q] * rstd * *(const f32x4*)(lg + n0 + 4 * q) + *(const f32x4*)(lb + n0 + 4 * q);
    }
}

constexpr int NPHASES = 11;
__global__ void __launch_bounds__(NTHREADS, 2) fwd_kernel(Args a) {
    extern __shared__ __attribute__((aligned(16))) unsigned char lds[];
    const int G = gridDim.x;
    volatile LAS unsigned* misc = (volatile LAS unsigned*)(LAS unsigned char*)(lds + LDS_BYTES - 64);
    if (threadIdx.x < 16) misc[threadIdx.x] = 0u;
    __syncthreads();
    XcdBarrier bar; bar.bar = (unsigned*)(a.ws + WS_CTL); bar.x = 0; bar.st = nullptr;
    const bool multi = (a.ph_hi - a.ph_lo) > 1;
    if (multi) bar = xcd_barrier_post((unsigned*)(a.ws + WS_CTL), misc);
#define IN(k) (a.ph_lo <= (k) && (k) < a.ph_hi)
#define SEAM(k) do { if (IN(k) && IN((k) + 1)) xcd_barrier(bar); } while (0)
#ifndef REPEAT_MASK
#define REPEAT_MASK 0
#endif
#define REP(k, call) do { if (IN(k)) { call; if ((REPEAT_MASK >> (k)) & 1) { xcd_barrier(bar); Args a2 = a; a2.flags = PROBE_FLAGS; { const Args& a = a2; call; } } } } while (0)
#ifndef PROBE_FLAGS
#define PROBE_FLAGS 0
#endif
    REP(0, phase_prep(a, lds, G));
    SEAM(0);
    REP(1, phase_hmod(a, G));
    SEAM(1);
    REP(2, phase_proj(a, lds, G));
    SEAM(2);
    REP(3, phase_mixer(a, lds, G));
    SEAM(3);
    REP(4, phase_wo(a, lds, G));
    SEAM(4);
    REP(5, phase_ln1(a, G));
    SEAM(5);
    REP(6, phase_rs(a, lds, G));
    SEAM(6);
    REP(7, phase_route(a, lds, G));
    SEAM(7);
    REP(8, phase_moe1(a, lds, G));
    SEAM(8);
    REP(9, phase_moe2(a, lds, G));
    SEAM(9);
    REP(10, phase_final(a, G));
#undef IN
#undef SEAM
}

extern "C" void kernel_launch(void* const* d_in, const int* in_sizes, int n_in, void* d_out, int out_size, void* d_ws, size_t ws_size, hipStream_t stream) {
    static int grid = 0;
    if (grid == 0) {
        if (n_in != 23 || out_size != T * DM || ws_size < WS_END) { fprintf(stderr, "kernel_launch: unexpected shapes (n_in %d out %d ws %zu)\n", n_in, out_size, ws_size); grid = -1; return; }
        int dev = 0, cus = 0;
        if (hipGetDevice(&dev) != hipSuccess || hipDeviceGetAttribute(&cus, hipDeviceAttributeMultiprocessorCount, dev) != hipSuccess) { grid = -1; return; }
        if (hipFuncSetAttribute((const void*)fwd_kernel, hipFuncAttributeMaxDynamicSharedMemorySize, LDS_BYTES) != hipSuccess) { fprintf(stderr, "kernel_launch: hipFuncSetAttribute failed\n"); grid = -1; return; }
        int per_cu = 0;
        (void)hipOccupancyMaxActiveBlocksPerMultiprocessor(&per_cu, (const void*)fwd_kernel, NTHREADS, LDS_BYTES);
        (void)hipGetLastError();
        grid = cus > 512 ? 512 : cus;
        if (per_cu < 1) fprintf(stderr, "kernel_launch: occupancy query reports %d blocks per CU\n", per_cu);
    }
    if (grid < 0) return;
    (void)hipMemsetAsync((char*)d_ws + WS_CTL, 0, CTL_ZERO_BYTES, stream);
    Args a{};
    for (int i = 0; i < 23; ++i) a.in[i] = (const float*)d_in[i];
    a.out = (float*)d_out; a.ws = (unsigned char*)d_ws;
#if N_LAUNCH_MODE == 1
    a.ph_lo = 0; a.ph_hi = NPHASES;
    hipLaunchKernelGGL(fwd_kernel, dim3(grid), dim3(NTHREADS), LDS_BYTES, stream, a);
#else
    for (int p = 0; p < NPHASES; ++p) { a.ph_lo = p; a.ph_hi = p + 1; hipLaunchKernelGGL(fwd_kernel, dim3(grid), dim3(NTHREADS), LDS_BYTES, stream, a); }
#endif
}
```

```cpp
#include <hip/hip_runtime.h>
#include <cstdio>
#include <cstdint>

#define LAS __attribute__((address_space(3)))
typedef unsigned short bf16;
typedef short bf16x8 __attribute__((ext_vector_type(8)));
typedef short bf16x4v __attribute__((ext_vector_type(4)));
typedef float f32x4 __attribute__((ext_vector_type(4)));
typedef unsigned u32x4 __attribute__((ext_vector_type(4)));
typedef unsigned u32x2 __attribute__((ext_vector_type(2)));
typedef float f32x2v __attribute__((ext_vector_type(2)));

#ifndef N_LAUNCH_MODE
#define N_LAUNCH_MODE 1
#endif

constexpr int NB = 8, SEQ = 4096, DM = 1024, T = NB * SEQ;
constexpr int HD = 64, NQH = 8, NKVH = 2;
constexpr int INC = 1792, QW = 1280;
constexpr int NE = 256, TOPK = 8, FE = 256;
constexpr int CK = 31, CW = 512;
constexpr int BM = 256, BN = 128;
constexpr int MAXROWS = T * TOPK + NE * BM;
constexpr int MAXTILES = MAXROWS / BM;
constexpr float LN_EPS = 1e-5f;
constexpr float ALPHA = 1.18920711500272106672f;
constexpr int NTHREADS = 512, NWAVES = 8;
constexpr int LDS_BYTES = 147456;

constexpr size_t MiB = 1u << 20;
constexpr size_t WS_CTL = 0, CTL_ZERO_BYTES = 64 * 1024;
constexpr size_t WS_MOD = 1 * MiB;
constexpr size_t WS_WINT = 12 * MiB;
constexpr size_t WS_WOT = 16 * MiB;
constexpr size_t WS_WCAT = 18 * MiB;
constexpr size_t WS_WDST = 20 * MiB;
constexpr size_t WS_WDT8 = 24 * MiB;
constexpr size_t WS_H8 = 88 * MiB;
constexpr size_t WS_HS = 168 * MiB;
constexpr size_t WS_SD = 184 * MiB;
constexpr size_t WS_X1B = 248 * MiB;
constexpr size_t WS_RDST = 312 * MiB;
constexpr size_t WS_Y = 344 * MiB;
constexpr size_t WS_WGT8 = 344 * MiB;
constexpr size_t WS_WUT8 = 408 * MiB;
constexpr size_t WS_H2Q = 472 * MiB;
constexpr size_t WS_LOG = 504 * MiB;
constexpr size_t WS_H2 = 600 * MiB;
constexpr size_t WS_QKVG = 664 * MiB;
constexpr size_t WS_MIX = 664 * MiB;
constexpr size_t WS_AC = 744 * MiB;
constexpr size_t WS_EW = 2 * MiB;
constexpr size_t WS_END = 808 * MiB;
constexpr size_t WS_GCNT = 32768;
constexpr int RCAP = T;

__device__ __forceinline__ unsigned f2bf(float f) { unsigned u = __float_as_uint(f); return (u + 0x7fffu + ((u >> 16) & 1u)) >> 16; }
__device__ __forceinline__ unsigned pk2(float lo, float hi) { unsigned r; asm volatile("v_cvt_pk_bf16_f32 %0, %1, %2" : "=v"(r) : "v"(lo), "v"(hi)); return r; }
__device__ __forceinline__ float bf2f(unsigned h) { return __uint_as_float(h << 16); }
__device__ __forceinline__ float bflo(unsigned w) { return __uint_as_float(w << 16); }
__device__ __forceinline__ float bfhi(unsigned w) { return __uint_as_float(w & 0xffff0000u); }
__device__ __forceinline__ float sigmoidf_(float v) { return __builtin_amdgcn_rcpf(1.0f + __builtin_amdgcn_exp2f(-1.44269504089f * v)); }
__device__ __forceinline__ float sigmoidf_ref(float v) { return 1.0f / (1.0f + __expf(-v)); }
__device__ __forceinline__ float siluf_(float v) { return v * __builtin_amdgcn_rcpf(1.0f + __builtin_amdgcn_exp2f(-1.44269504089f * v)); }
__device__ __forceinline__ float wave_sum(float v) {
#pragma unroll
    for (int o = 1; o < 64; o <<= 1) v += __shfl_xor(v, o);
    return v;
}
__device__ __forceinline__ int perm32(int rho) { const int n = rho >> 4, i = rho & 15; return 8 * (i >> 2) + 4 * n + (i & 3); }

#define XB_TMO      128
#define XB_XCNT(j)  (256  + 64 * (j))
#define XB_XSUB(j)  (1280 + 64 * (j))
#define XB_XGEN(j)  (2304 + 64 * (j))
#define XB_TOP      3328
#define XB_TOPGEN   3392
#define XCD_BAR_WORDS 3456
#define XB_SPIN_CAP (1u << 22)
__device__ __forceinline__ unsigned xb_ld(unsigned* p)              { return __hip_atomic_load(p, __ATOMIC_RELAXED, __HIP_MEMORY_SCOPE_AGENT); }
__device__ __forceinline__ unsigned xb_add(unsigned* p, unsigned v) { return __hip_atomic_fetch_add(p, v, __ATOMIC_RELAXED, __HIP_MEMORY_SCOPE_AGENT); }
__device__ __forceinline__ unsigned xb_xcc_id() { return (unsigned)__builtin_amdgcn_s_getreg((3 << 11) | 20) & 0xFu; }
#define XB_SPIN(cond, bar) do { unsigned _sp = 0; while (cond) { __builtin_amdgcn_s_sleep(1); \
    if ((++_sp & 255u) == 0u) { if (xb_ld(&(bar)[XB_TMO])) break; if (_sp > XB_SPIN_CAP) { atomicAdd(&(bar)[XB_TMO], 1u); break; } } } } while (0)
struct XcdBarrier { unsigned* bar; unsigned x; volatile LAS unsigned* st; };
__device__ __forceinline__ XcdBarrier xcd_barrier_post(unsigned* bar, volatile LAS unsigned* st) {
    XcdBarrier b; b.bar = bar; b.x = xb_xcc_id(); b.st = st;
    if (threadIdx.x == 0) (void)xb_add(&bar[XB_XCNT(b.x)], 1u);
    return b;
}
__device__ __forceinline__ void xcd_barrier_complete(unsigned* bar, unsigned x, unsigned& nloc, unsigned& nx) {
    const unsigned G = gridDim.x * gridDim.y * gridDim.z;
    unsigned sum, cnt, mine, sp = 0u;
    for (;;) {
        sum = 0u; cnt = 0u; mine = 0u;
#pragma unroll
        for (unsigned j = 0; j < 16; ++j) { const unsigned c = xb_ld(&bar[XB_XCNT(j)]); sum += c; cnt += (c > 0u) ? 1u : 0u; mine = (j == x) ? c : mine; }
        if (sum == G) break;
        __builtin_amdgcn_s_sleep(1);
        if ((++sp & 255u) == 0u) { if (xb_ld(&bar[XB_TMO])) break; if (sp > XB_SPIN_CAP) { atomicAdd(&bar[XB_TMO], 1u); break; } }
    }
    nloc = mine > 0u ? mine : 1u; nx = cnt > 0u ? cnt : 1u;
}
__device__ __forceinline__ void xcd_barrier(const XcdBarrier& b) {
    asm volatile("s_waitcnt vmcnt(0)" ::: "memory");
    __syncthreads();
    if (threadIdx.x == 0) {
        unsigned* bar = b.bar;
        __builtin_amdgcn_s_waitcnt(0);
        unsigned nloc = b.st[0], nx = b.st[1];
        if (nloc == 0u) { xcd_barrier_complete(bar, b.x, nloc, nx); b.st[0] = nloc; b.st[1] = nx; }
        const unsigned old = xb_add(&bar[XB_XSUB(b.x)], 1u);
        const unsigned gen = old / nloc;
        if (old + 1u == (gen + 1u) * nloc) {
            __builtin_amdgcn_fence(__ATOMIC_RELEASE, "agent");
            asm volatile("s_waitcnt vmcnt(0)" ::: "memory");
            const unsigned og = xb_add(&bar[XB_TOP], 1u);
            const unsigned tg = og / nx;
            if (og + 1u == (tg + 1u) * nx) xb_add(&bar[XB_TOPGEN], 1u);
            else XB_SPIN(xb_ld(&bar[XB_TOPGEN]) == tg, bar);
            __builtin_amdgcn_fence(__ATOMIC_ACQUIRE, "agent");
            xb_add(&bar[XB_XGEN(b.x)], 1u);
            asm volatile("s_waitcnt vmcnt(0)" ::: "memory");
        } else {
            XB_SPIN(xb_ld(&bar[XB_XGEN(b.x)]) == gen, bar);
            __builtin_amdgcn_fence(__ATOMIC_ACQUIRE, "agent");
            asm volatile("s_waitcnt vmcnt(0)" ::: "memory");
        }
    }
    __syncthreads();
}

struct Args {
    const float* in[23];
    float* out;
    unsigned char* ws;
    int ph_lo, ph_hi, flags, pad;
};

namespace pg {
constexpr int HALF = 128, HTB = HALF * 64 * 2, PG_STAGE_BYTES = 8 * HTB;
__device__ __forceinline__ int lds_byte(int r, int c) { const int st = (r >> 4) * 2 + (c >> 5), rr = r & 15, cc = c & 31, ob = rr * 64 + cc * 2; return st * 1024 + (ob ^ (((ob >> 9) & 1) << 5)); }
__device__ __forceinline__ void stage_rc(int b, int& R, int& C) { const int st = b / 1024, sb = b % 1024, swz = sb ^ (((sb >> 9) & 1) << 5); R = (st >> 1) * 16 + swz / 64; C = (st & 1) * 32 + (swz % 64) / 2; }
struct Unit { unsigned a, b0, b1; int r0, c, aux, nv; };
typedef int i32x8 __attribute__((ext_vector_type(8)));
typedef int i32x4 __attribute__((ext_vector_type(4)));
__device__ __forceinline__ bf16x8 lo8(const i32x8& v) { return __builtin_bit_cast(bf16x8, (i32x4)__builtin_shufflevector(v, v, 0, 1, 2, 3)); }
__device__ __forceinline__ bf16x8 hi8(const i32x8& v) { return __builtin_bit_cast(bf16x8, (i32x4)__builtin_shufflevector(v, v, 4, 5, 6, 7)); }
__device__ __forceinline__ i32x8 cat8(const bf16x8 lo, const bf16x8 hi) { const i32x4 a = __builtin_bit_cast(i32x4, lo), b = __builtin_bit_cast(i32x4, hi); return __builtin_shufflevector(a, b, 0, 1, 2, 3, 4, 5, 6, 7); }
typedef __amdgpu_buffer_rsrc_t rsrc_t;

template <class Epi, class Sched, bool GATHER, int BMAP = 0, bool F8 = false, int SCW = 127, int SCA = 127>
__device__ __forceinline__ void gemm_phase(LAS unsigned char* lds, unsigned char* wsbase, const int ROWB, const Sched& S, const Epi& E) {
    const rsrc_t rs = __builtin_amdgcn_make_buffer_rsrc((void*)wsbase, 0, 0x7fffffff, 0x00020000);
    const int tid = threadIdx.x, wid = __builtin_amdgcn_readfirstlane(tid >> 6), lane = tid & 63, wr = wid >> 2, wc = wid & 3, fr = lane & 15, fq = lane >> 4;
    int nt = ROWB / 128; asm volatile("" : "+s"(nt));
    int Rr[2], Cc[2]; unsigned voffB[2], vA[2][2], nvA[2][2];
#pragma unroll
    for (int i = 0; i < 2; ++i) { stage_rc(tid * 16 + i * 8192, Rr[i], Cc[i]); const int Rb = BMAP ? (64 * (Rr[i] >> 5) + 16 * ((Rr[i] & 15) >> 2) + 4 * ((Rr[i] >> 4) & 1) + (Rr[i] & 3)) : ((Rr[i] & ~31) + perm32(Rr[i] & 31)); voffB[i] = (unsigned)(Rb * ROWB + Cc[i] * 2); }
    const unsigned kstep = 128;
    const unsigned ldsw = (unsigned)wid * 1024u;
    const int aoff = lds_byte(wr * 64 + fr, fq * 8), boff = lds_byte(wc * 32 + fr, fq * 8);
#define PG_SA(b, h) (((b) * 2 + (h)) * pg::HTB)
#define PG_SB(b, h) ((4 + (b) * 2 + (h)) * pg::HTB)
#define PG_STG(bufoff, gbase, v0, v1) do { \
        __builtin_amdgcn_raw_ptr_buffer_load_lds(rs, (LAS unsigned*)(lds + (bufoff) + ldsw), 16, (int)(v0), (int)(gbase), 0, 0); \
        __builtin_amdgcn_raw_ptr_buffer_load_lds(rs, (LAS unsigned*)(lds + (bufoff) + ldsw + 8192), 16, (int)(v1), (int)(gbase), 0, 0); } while (0)
#define PG_STGB(bufoff, gbase) PG_STG(bufoff, gbase, voffB[0], voffB[1])
#define PG_LD16(off) (*(const LAS bf16x8*)(lds + (off)))
#define PG_LDA(dst, b, h) do { _Pragma("unroll") for (int m = 0; m < 4; ++m) dst[m] = pg::cat8(PG_LD16(PG_SA(b, h) + aoff + m * 2048), PG_LD16(PG_SA(b, h) + aoff + m * 2048 + 1024)); } while (0)
#define PG_LDB(dst, b, h) do { _Pragma("unroll") for (int n = 0; n < 2; ++n) dst[n] = pg::cat8(PG_LD16(PG_SB(b, h) + boff + n * 2048), PG_LD16(PG_SB(b, h) + boff + n * 2048 + 1024)); } while (0)
#define PG_MMA(ai, bj, At, Bt) do { __builtin_amdgcn_s_setprio(1); \
        if (F8) { _Pragma("unroll") for (int m = 0; m < 4; ++m) _Pragma("unroll") for (int n = 0; n < 2; ++n) \
            asm volatile("v_mfma_scale_f32_16x16x128_f8f6f4 %0, %1, %2, %0, %3, %4 op_sel_hi:[0,0,0]" : "+v"(acc[ai][bj][m][n]) : "v"(Bt[n]), "v"(At[m]), "v"(scw), "v"(sca)); } \
        else { _Pragma("unroll") for (int m = 0; m < 4; ++m) _Pragma("unroll") for (int n = 0; n < 2; ++n) { \
            acc[ai][bj][m][n] = __builtin_amdgcn_mfma_f32_16x16x32_bf16(pg::lo8(Bt[n]), pg::lo8(At[m]), acc[ai][bj][m][n], 0, 0, 0); \
            acc[ai][bj][m][n] = __builtin_amdgcn_mfma_f32_16x16x32_bf16(pg::hi8(Bt[n]), pg::hi8(At[m]), acc[ai][bj][m][n], 0, 0, 0); } } \
        __builtin_amdgcn_s_setprio(0); } while (0)
#define PG_WAIT_V(n) asm volatile("s_waitcnt vmcnt(" #n ")" ::: "memory")
#define PG_WAIT_L(n) asm volatile("s_waitcnt lgkmcnt(" #n ")" ::: "memory")
#define PG_BAR __builtin_amdgcn_s_barrier()
#define PG_SCHED __builtin_amdgcn_sched_barrier(0)
#define PG_VA(dst, u) do { _Pragma("unroll") for (int h = 0; h < 2; ++h) _Pragma("unroll") for (int i = 0; i < 2; ++i) \
        dst[h][i] = GATHER ? (unsigned)(S.row(u, h * pg::HALF + Rr[i]) * ROWB + Cc[i] * 2) : (unsigned)((h * pg::HALF + Rr[i]) * ROWB + Cc[i] * 2); } while (0)
    Unit cur, nxt; int ui = 0;
    if (!S.next(0, cur)) return;
    f32x4 acc[2][2][4][2];
#pragma unroll
    for (int a = 0; a < 2; ++a)
#pragma unroll
        for (int b = 0; b < 2; ++b)
#pragma unroll
            for (int m = 0; m < 4; ++m)
#pragma unroll
                for (int n = 0; n < 2; ++n) acc[a][b][m][n] = (f32x4){0.f, 0.f, 0.f, 0.f};
    pg::i32x8 At[4], B0[2], B1[2];
    int scw = SCW * 0x01010101, sca = SCA * 0x01010101; asm volatile("" : "+v"(scw), "+v"(sca));
    PG_VA(vA, cur);
#pragma unroll
    for (int h = 0; h < 2; ++h)
#pragma unroll
        for (int i = 0; i < 2; ++i) nvA[h][i] = vA[h][i];
    unsigned cA = cur.a, cB0 = cur.b0, cB1 = cur.b1;
    PG_STGB(PG_SB(0, 0), cB0); PG_STGB(PG_SB(0, 1), cB1); PG_STG(PG_SA(0, 0), cA, vA[0][0], vA[0][1]); PG_STG(PG_SA(0, 1), cA, vA[1][0], vA[1][1]);
    if (wr == 1) PG_BAR;
    PG_WAIT_V(2); PG_BAR;
    PG_STGB(PG_SB(1, 0), cB0 + kstep); PG_STG(PG_SA(1, 0), cA + kstep, vA[0][0], vA[0][1]); PG_STGB(PG_SB(1, 1), cB1 + kstep);
    PG_WAIT_V(6); PG_BAR;
    for (;;) {
        const bool has_next = S.next(ui + 1, nxt);
        const unsigned nA = has_next ? nxt.a : cA, nB0 = has_next ? nxt.b0 : cB0, nB1 = has_next ? nxt.b1 : cB1;
#pragma unroll 1
        for (int t = 0; t < nt; t += 2) {
            const bool last = (t == nt - 2);
            const unsigned a1 = cA + (unsigned)(t + 1) * kstep;
            const unsigned a2 = last ? nA : cA + (unsigned)(t + 2) * kstep;
            const unsigned b20 = last ? nB0 : cB0 + (unsigned)(t + 2) * kstep, b21 = last ? nB1 : cB1 + (unsigned)(t + 2) * kstep;
            const unsigned a3 = a2 + kstep, b30 = b20 + kstep, b31 = b21 + kstep;
            unsigned wA[2][2];
            if (GATHER) {
                if (last && has_next) PG_VA(nvA, nxt);
#pragma unroll
                for (int h = 0; h < 2; ++h)
#pragma unroll
                    for (int i = 0; i < 2; ++i) wA[h][i] = (last && has_next) ? nvA[h][i] : vA[h][i];
            } else {
#pragma unroll
                for (int h = 0; h < 2; ++h)
#pragma unroll
                    for (int i = 0; i < 2; ++i) wA[h][i] = vA[h][i];
            }
            const bool after_epi = (t == 0) && (ui > 0);
            PG_LDB(B0, 0, 0); PG_LDB(B1, 0, 1); PG_SCHED; PG_LDA(At, 0, 0); PG_STG(PG_SA(1, 1), a1, vA[1][0], vA[1][1]);
            if (after_epi && Epi::NST >= 16) PG_WAIT_V(24); else if (after_epi && Epi::NST >= 8) PG_WAIT_V(16); else PG_WAIT_V(8);
            PG_WAIT_L(0); PG_BAR; PG_MMA(0, 0, At, B0); PG_MMA(0, 1, At, B1); PG_BAR; PG_SCHED;
            PG_LDA(At, 0, 1); PG_STGB(PG_SB(0, 0), b20); PG_STGB(PG_SB(0, 1), b21); PG_STG(PG_SA(0, 0), a2, wA[0][0], wA[0][1]);
            if (after_epi && Epi::NST >= 16) PG_WAIT_V(24); else if (after_epi && Epi::NST >= 8) PG_WAIT_V(16); else PG_WAIT_V(8);
            PG_WAIT_L(0); PG_BAR; PG_MMA(1, 0, At, B0); PG_MMA(1, 1, At, B1); PG_BAR; PG_SCHED;
            PG_LDB(B0, 1, 0); PG_LDB(B1, 1, 1); PG_SCHED; PG_LDA(At, 1, 0); PG_STG(PG_SA(0, 1), a2, wA[1][0], wA[1][1]);
            PG_WAIT_V(8); PG_WAIT_L(0); PG_BAR; PG_MMA(0, 0, At, B0); PG_MMA(0, 1, At, B1); PG_BAR; PG_SCHED;
            PG_LDA(At, 1, 1); PG_STGB(PG_SB(1, 0), b30); PG_STGB(PG_SB(1, 1), b31); PG_STG(PG_SA(1, 0), a3, wA[0][0], wA[0][1]);
            PG_WAIT_V(8); PG_WAIT_L(0); PG_BAR; PG_MMA(1, 0, At, B0); PG_MMA(1, 1, At, B1); PG_BAR; PG_SCHED;
        }
        if (F8) asm volatile("s_nop 15\n\ts_nop 15" ::: "memory");
        if (wr == 0) PG_BAR;
        E(acc, cur, wr, wc, fr, fq);
        if (!has_next) break;
#pragma unroll
        for (int a = 0; a < 2; ++a)
#pragma unroll
            for (int b = 0; b < 2; ++b)
#pragma unroll
                for (int m = 0; m < 4; ++m)
#pragma unroll
                    for (int n = 0; n < 2; ++n) acc[a][b][m][n] = (f32x4){0.f, 0.f, 0.f, 0.f};
        cur = nxt; cA = nA; cB0 = nB0; cB1 = nB1; ++ui;
        if (GATHER) {
#pragma unroll
            for (int h = 0; h < 2; ++h)
#pragma unroll
                for (int i = 0; i < 2; ++i) vA[h][i] = nvA[h][i];
        }
        if (wr == 1) PG_BAR;
    }
    PG_WAIT_V(0);
    PG_BAR;
#undef PG_SA
#undef PG_SB
#undef PG_STG
#undef PG_STGB
#undef PG_LD16
#undef PG_LDA
#undef PG_LDB
#undef PG_MMA
#undef PG_WAIT_V
#undef PG_WAIT_L
#undef PG_BAR
#undef PG_SCHED
#undef PG_VA
}
}

struct XcdSplit {
    int NU, G, bx;
    __device__ __forceinline__ bool unit(int i, int& u) const {
        if (G & 7) { u = bx + i * G; return u < NU; }
        const int x = bx & 7, li = bx >> 3, per = G >> 3, q = NU >> 3, r = NU & 7;
        const int start = x * q + (x < r ? x : r), len = q + (x < r ? 1 : 0), k = li + i * per;
        if (k >= len) return false;
        u = start + k; return true;
    }
};
__device__ __forceinline__ void dense_pmpn(int idx, int nN, int& pm, int& pn) { const int nig = 8 * nN, gid = idx / nig, rem = idx % nig; pm = gid * 8 + (rem & 7); pn = rem >> 3; }

__device__ __forceinline__ void store8_bf16(bf16* p, const f32x4& a, const f32x4& b) {
    u32x4 w; w.x = pk2(a[0], a[1]); w.y = pk2(a[2], a[3]); w.z = pk2(b[0], b[1]); w.w = pk2(b[2], b[3]); *(u32x4*)p = w;
}
typedef f32x4 acc_t[2][2][4][2];

__device__ __forceinline__ unsigned pk4_fp8(const f32x4& v, float sc) {
    int w = 0;
    w = __builtin_amdgcn_cvt_pk_fp8_f32(__builtin_amdgcn_fmed3f(v[0] * sc, -440.f, 440.f), __builtin_amdgcn_fmed3f(v[1] * sc, -440.f, 440.f), w, false);
    w = __builtin_amdgcn_cvt_pk_fp8_f32(__builtin_amdgcn_fmed3f(v[2] * sc, -440.f, 440.f), __builtin_amdgcn_fmed3f(v[3] * sc, -440.f, 440.f), w, true);
    return (unsigned)w;
}
constexpr float Y_SCALE = 64.0f;
constexpr float W8_SCALE = 32.0f, H8_SCALE = 8.0f;
__device__ __forceinline__ void transpose_item(const float* src, int K, int N, bf16* dst, int item, float* scr, int lane) {
    const int nblk = N / 64, kb = item / nblk, nb = item % nblk, k0 = kb * 64, n0 = nb * 64;
    const int lr = lane >> 4, lc = (lane & 15) * 4;
    f32x4 v[16];
    const float* sp = src + (size_t)(k0 + lr) * N + n0 + lc;
#pragma unroll
    for (int i = 0; i < 16; ++i) v[i] = __builtin_nontemporal_load((const f32x4*)(sp + (size_t)(4 * i) * N));
#pragma unroll
    for (int i = 0; i < 16; ++i) { float* d = scr + (4 * i + lr) * 65 + lc; d[0] = v[i][0]; d[1] = v[i][1]; d[2] = v[i][2]; d[3] = v[i][3]; }
    asm volatile("s_waitcnt lgkmcnt(0)" ::: "memory");
    const int c = lane & 7;
#pragma unroll
    for (int j = 0; j < 8; ++j) {
        const int n = (lane >> 3) + 8 * j; const float* s = scr + (8 * c) * 65 + n;
        u32x4 o; o.x = pk2(s[0], s[65]); o.y = pk2(s[2 * 65], s[3 * 65]); o.z = pk2(s[4 * 65], s[5 * 65]); o.w = pk2(s[6 * 65], s[7 * 65]);
        *(u32x4*)(dst + (size_t)(n0 + n) * K + k0 + 8 * c) = o;
    }
    asm volatile("s_waitcnt lgkmcnt(0)" ::: "memory");
}

__device__ __forceinline__ void transpose_item_f8(const float* src, int K, int N, unsigned char* dst, int item, float* scr, int lane) {
    const int nblk = N / 64, kb = item / nblk, nb = item % nblk, k0 = kb * 64, n0 = nb * 64;
    const int lr = lane >> 4, lc = (lane & 15) * 4;
    f32x4 v[16];
    const float* sp = src + (size_t)(k0 + lr) * N + n0 + lc;
#pragma unroll
    for (int i = 0; i < 16; ++i) v[i] = __builtin_nontemporal_load((const f32x4*)(sp + (size_t)(4 * i) * N));
#pragma unroll
    for (int i = 0; i < 16; ++i) { float* d = scr + (4 * i + lr) * 65 + lc; d[0] = v[i][0]; d[1] = v[i][1]; d[2] = v[i][2]; d[3] = v[i][3]; }
    asm volatile("s_waitcnt lgkmcnt(0)" ::: "memory");
    const int c = lane & 7;
#pragma unroll
    for (int j = 0; j < 8; ++j) {
        const int n = (lane >> 3) + 8 * j; const float* sx = scr + (8 * c) * 65 + n;
        u32x2 o; o.x = pk4_fp8((f32x4){sx[0], sx[65], sx[2 * 65], sx[3 * 65]}, W8_SCALE); o.y = pk4_fp8((f32x4){sx[4 * 65], sx[5 * 65], sx[6 * 65], sx[7 * 65]}, W8_SCALE);
        *(u32x2*)(dst + (size_t)(n0 + n) * K + k0 + 8 * c) = o;
    }
    asm volatile("s_waitcnt lgkmcnt(0)" ::: "memory");
}

__device__ __forceinline__ void phase_prep(const Args& a, unsigned char* lds, int G) {
    const int tid = threadIdx.x, lane = tid & 63, wid = tid >> 6, bx = blockIdx.x;
    unsigned char* ws = a.ws;
    {
        float* sc = (float*)lds;
        float* red = (float*)(lds + 32768);
        const float* c = a.in[1]; const float* w_ada = a.in[2]; const float* b_ada = a.in[3];
        float* mod = (float*)(ws + WS_MOD);
        for (int cb = bx; cb < 6144 / 32; cb += G) {
            __syncthreads();
            for (int i = tid; i < 8 * 1024; i += NTHREADS) sc[i] = siluf_(c[i]);
            __syncthreads();
            const int kg = tid >> 5, cl = tid & 31, col = cb * 32 + cl;
            float acc[8];
#pragma unroll
            for (int b = 0; b < 8; ++b) acc[b] = 0.f;
            for (int k = kg; k < 1024; k += 16) {
                const float wv = w_ada[(size_t)k * 6144 + col];
#pragma unroll
                for (int b = 0; b < 8; ++b) acc[b] += sc[b * 1024 + k] * wv;
            }
#pragma unroll
            for (int b = 0; b < 8; ++b) red[(kg * 8 + b) * 32 + cl] = acc[b];
            __syncthreads();
            if (tid < 256) {
                const int b = tid >> 5; float s = 0.f;
#pragma unroll
                for (int g = 0; g < 16; ++g) s += red[(g * 8 + b) * 32 + cl];
                mod[b * 6144 + col] = s + b_ada[col];
            }
        }
        __syncthreads();
    }
    {
        float* scr = (float*)(lds + wid * 16640);
        const int gw = bx * NWAVES + wid, NGW = G * NWAVES;
        constexpr int I_IN = 16 * 28, I_O = 16 * 16, I_S = 16 * 4, I_DS = 4 * 16, I_E = 16 * 4 * NE;
        constexpr int NITEMS = I_IN + I_O + 3 * I_S + I_DS + 3 * I_E;
        for (int it = gw; it < NITEMS; it += NGW) {
            int r = it;
            if (r < I_IN) { transpose_item(a.in[4], 1024, INC, (bf16*)(ws + WS_WINT), r, scr, lane); continue; } r -= I_IN;
            if (r < I_O) { transpose_item(a.in[10], 1024, 1024, (bf16*)(ws + WS_WOT), r, scr, lane); continue; } r -= I_O;
            if (r < I_S) { transpose_item(a.in[13], 1024, 256, (bf16*)(ws + WS_WCAT), r, scr, lane); continue; } r -= I_S;
            if (r < I_S) { transpose_item(a.in[18], 1024, 256, (bf16*)(ws + WS_WCAT) + 256 * 1024, r, scr, lane); continue; } r -= I_S;
            if (r < I_S) { transpose_item(a.in[19], 1024, 256, (bf16*)(ws + WS_WCAT) + 512 * 1024, r, scr, lane); continue; } r -= I_S;
            if (r < I_DS) { transpose_item(a.in[20], 256, 1024, (bf16*)(ws + WS_WDST), r, scr, lane); continue; } r -= I_DS;
            if (r < I_E) { const int e = r >> 6; transpose_item_f8(a.in[15] + (size_t)e * 262144, 1024, 256, ws + WS_WGT8 + (size_t)e * 262144, r & 63, scr, lane); continue; } r -= I_E;
            if (r < I_E) { const int e = r >> 6; transpose_item_f8(a.in[16] + (size_t)e * 262144, 1024, 256, ws + WS_WUT8 + (size_t)e * 262144, r & 63, scr, lane); continue; } r -= I_E;
            { const int e = r >> 6; transpose_item_f8(a.in[17] + (size_t)e * 262144, 256, 1024, ws + WS_WDT8 + (size_t)e * 262144, r & 63, scr, lane); }
        }
    }
}

__device__ __forceinline__ void phase_hmod(const Args& a, int G) {
    const float* x = a.in[0]; const float* mod = (const float*)(a.ws + WS_MOD); bf16* h = (bf16*)(a.ws + WS_H2);
    const size_t nchunk = (size_t)T * DM / 8;
    for (size_t i = (size_t)blockIdx.x * NTHREADS + threadIdx.x; i < nchunk; i += (size_t)G * NTHREADS) {
        const size_t e0 = i * 8; const int row = (int)(e0 >> 10), col = (int)(e0 & 1023), b = row >> 12;
        const f32x4 v0 = *(const f32x4*)(x + e0), v1 = *(const f32x4*)(x + e0 + 4);
        const float* sh = mod + b * 6144 + col; const float* sc = sh + 1024;
        const f32x4 s0 = *(const f32x4*)sc, s1 = *(const f32x4*)(sc + 4), h0 = *(const f32x4*)sh, h1 = *(const f32x4*)(sh + 4);
        const f32x4 r0 = v0 * (s0 + 1.0f) + h0, r1 = v1 * (s1 + 1.0f) + h1;
        store8_bf16(h + e0, r0, r1);
    }
}

struct SchedProj {
    XcdSplit xs; unsigned A, Bt;
    __device__ __forceinline__ bool next(int i, pg::Unit& u) const {
        int idx; if (!xs.unit(i, idx)) return false; int pm, pn; dense_pmpn(idx, 7, pm, pn);
        u.a = A + (unsigned)pm * 256 * 2048; u.r0 = pm * 256; u.c = pn; u.aux = 0; u.nv = 0;
        if (pn < 3) { u.b0 = Bt + (unsigned)(256 * pn) * 2048; u.b1 = u.b0 + 128 * 2048; }
        else { const int j = pn - 3; u.b0 = Bt + (unsigned)(768 + 128 * j) * 2048; u.b1 = Bt + (unsigned)(1280 + 128 * j) * 2048; }
        return true; }
    __device__ __forceinline__ int row(const pg::Unit&, int) const { return 0; }
};
struct EpiProj {
    static constexpr int NST = 8;
    bf16* O;
    __device__ __forceinline__ void operator()(const acc_t& acc, const pg::Unit& u, int wr, int wc, int fr, int fq) const {
        const int row0 = u.r0 + wr * 64 + fr;
        if (u.c < 3) {
#pragma unroll
            for (int ai = 0; ai < 2; ++ai)
#pragma unroll
                for (int m = 0; m < 4; ++m) { bf16* rowp = O + (size_t)(row0 + ai * 128 + m * 16) * QW + 256 * u.c + wc * 32 + 8 * fq;
#pragma unroll
                    for (int bj = 0; bj < 2; ++bj) store8_bf16(rowp + bj * 128, acc[ai][bj][m][0], acc[ai][bj][m][1]); }
        } else {
            const int j = u.c - 3;
#pragma unroll
            for (int ai = 0; ai < 2; ++ai)
#pragma unroll
                for (int m = 0; m < 4; ++m) { bf16* rowp = O + (size_t)(row0 + ai * 128 + m * 16) * QW + 768 + 128 * j + wc * 32 + 8 * fq;
                    f32x4 r0, r1;
#pragma unroll
                    for (int q = 0; q < 4; ++q) { r0[q] = acc[ai][0][m][0][q] * sigmoidf_(acc[ai][1][m][0][q]); r1[q] = acc[ai][0][m][1][q] * sigmoidf_(acc[ai][1][m][1][q]); }
                    store8_bf16(rowp, r0, r1); }
        }
    }
};
__device__ __forceinline__ void phase_proj(const Args& a, unsigned char* lds, int G) {
    SchedProj S{XcdSplit{(T / 256) * 7, G, (int)blockIdx.x}, (unsigned)WS_H2, (unsigned)WS_WINT};
    EpiProj E{(bf16*)(a.ws + WS_QKVG)};
    pg::gemm_phase<EpiProj, SchedProj, false>((LAS unsigned char*)lds, a.ws, DM * 2, S, E);
}

constexpr int VT_STRIDE = 280;
__device__ __forceinline__ void attn_unit(const Args& a, unsigned char* lds, int unit) {
    const bf16* QK = (const bf16*)(a.ws + WS_QKVG); bf16* AC = (bf16*)(a.ws + WS_AC);
    const int tid = threadIdx.x, lane = tid & 63, w = __builtin_amdgcn_readfirstlane(tid >> 6), fr = lane & 15, fq = lane >> 4;
    const int kh = unit & 1, nblk = (unit >> 1) & 31, b = unit >> 6;
    const int tok0 = b * SEQ + nblk * 128;
    unsigned char* Kl = lds;
    bf16* Vt = (bf16*)(lds + 272 * 128);
    __syncthreads();
#pragma unroll 1
    for (int idx = tid; idx < 272 * 8; idx += NTHREADS) {
        const int key = idx >> 3, c = idx & 7;
        u32x4 kv = (u32x4){0u, 0u, 0u, 0u}, vv = (u32x4){0u, 0u, 0u, 0u};
        if (key < 256 && (nblk > 0 || key >= 128)) {
            const bf16* rowp = QK + (size_t)(tok0 - 128 + key) * QW + 512 + 64 * kh + 8 * c;
            kv = *(const u32x4*)rowp; vv = *(const u32x4*)(rowp + 128);
        }
        *(u32x4*)(Kl + key * 128 + ((c ^ (key & 7)) * 16)) = kv;
        bf16* vp = Vt + (8 * c) * VT_STRIDE + key;
        vp[0] = (bf16)(vv.x & 0xffffu); vp[VT_STRIDE] = (bf16)(vv.x >> 16);
        vp[2 * VT_STRIDE] = (bf16)(vv.y & 0xffffu); vp[3 * VT_STRIDE] = (bf16)(vv.y >> 16);
        vp[4 * VT_STRIDE] = (bf16)(vv.z & 0xffffu); vp[5 * VT_STRIDE] = (bf16)(vv.z >> 16);
        vp[6 * VT_STRIDE] = (bf16)(vv.w & 0xffffu); vp[7 * VT_STRIDE] = (bf16)(vv.w >> 16);
    }
    __syncthreads();
    const float* sinks = a.in[5];
#pragma unroll 1
    for (int g = 0; g < 4; ++g) {
        const int h = kh * 4 + g;
        int lofs = 0; asm volatile("" : "+v"(lofs));
        const float slope = exp2f(-(float)(h + 1)), sink = sinks[h];
        const bf16* qp = QK + (size_t)(tok0 + 16 * w + fr) * QW + 64 * h + 8 * fq;
        const bf16x8 q0 = *(const bf16x8*)qp, q1 = *(const bf16x8*)(qp + 32);
        f32x4 st[10];
#pragma unroll
        for (int i = 0; i < 10; ++i) {
            const int key = 16 * (w + i) + fr;
            const unsigned char* kp = Kl + key * 128 + lofs;
            const bf16x8 k0 = *(const bf16x8*)(kp + ((fq ^ (fr & 7)) * 16)), k1 = *(const bf16x8*)(kp + (((fq + 4) ^ (fr & 7)) * 16));
            f32x4 s = (f32x4){0.f, 0.f, 0.f, 0.f};
            s = __builtin_amdgcn_mfma_f32_16x16x32_bf16(k0, q0, s, 0, 0, 0);
            s = __builtin_amdgcn_mfma_f32_16x16x32_bf16(k1, q1, s, 0, 0, 0);
            st[i] = s;
        }
        float mx = -INFINITY;
#pragma unroll
        for (int i = 0; i < 10; ++i)
#pragma unroll
            for (int r = 0; r < 4; ++r) {
                const int dist = 128 + fr - 16 * i - 4 * fq - r;
                const int kj = 16 * (w + i) + 4 * fq + r;
                const bool valid = (dist >= 0) && (dist < 128) && (nblk > 0 || kj >= 128);
                const float s = valid ? (st[i][r] * 0.125f - slope * (float)dist) : -INFINITY;
                st[i][r] = s; mx = fmaxf(mx, s);
            }
        mx = fmaxf(mx, __shfl_xor(mx, 16)); mx = fmaxf(mx, __shfl_xor(mx, 32));
        mx = fmaxf(mx, sink);
        float sum = 0.f;
#pragma unroll
        for (int i = 0; i < 10; ++i)
#pragma unroll
            for (int r = 0; r < 4; ++r) { const float p = __expf(st[i][r] - mx); st[i][r] = p; sum += p; }
        sum += __shfl_xor(sum, 16); sum += __shfl_xor(sum, 32);
        const float inv = 1.0f / (sum + __expf(sink - mx));
        f32x4 o[4];
#pragma unroll
        for (int nt = 0; nt < 4; ++nt) o[nt] = (f32x4){0.f, 0.f, 0.f, 0.f};
#pragma unroll
        for (int s5 = 0; s5 < 5; ++s5) {
            u32x4 pw; pw.x = pk2(st[2 * s5][0], st[2 * s5][1]); pw.y = pk2(st[2 * s5][2], st[2 * s5][3]); pw.z = pk2(st[2 * s5 + 1][0], st[2 * s5 + 1][1]); pw.w = pk2(st[2 * s5 + 1][2], st[2 * s5 + 1][3]);
            const bf16x8 pf = __builtin_bit_cast(bf16x8, pw);
#pragma unroll
            for (int nt = 0; nt < 4; ++nt) {
                const bf16* vp = Vt + (16 * nt + fr) * VT_STRIDE + 16 * (w + 2 * s5) + 4 * fq + lofs;
                const u32x2 va = *(const u32x2*)vp, vb = *(const u32x2*)(vp + 16);
                u32x4 vw; vw.x = va.x; vw.y = va.y; vw.z = vb.x; vw.w = vb.y;
                o[nt] = __builtin_amdgcn_mfma_f32_16x16x32_bf16(__builtin_bit_cast(bf16x8, vw), pf, o[nt], 0, 0, 0);
            }
        }
        bf16* op = AC + (size_t)(tok0 + 16 * w + fr) * DM + 64 * h + 4 * fq;
#pragma unroll
        for (int nt = 0; nt < 4; ++nt) { u32x2 ow; ow.x = pk2(o[nt][0] * inv, o[nt][1] * inv); ow.y = pk2(o[nt][2] * inv, o[nt][3] * inv); *(u32x2*)(op + 16 * nt) = ow; }
    }
}

__device__ __forceinline__ void conv_unit(const Args& a, unsigned char* lds, int unit) {
    const bf16* QK = (const bf16*)(a.ws + WS_QKVG); bf16* AC = (bf16*)(a.ws + WS_AC);
    const int tid = threadIdx.x, lane = tid & 63, wid = tid >> 6;
    const int t0 = unit * 32, b = t0 >> 12, s0 = t0 & 4095, c = tid;
    bf16* inp = (bf16*)lds;
    float* yb = (float*)(lds + 62 * CW * 2);
    __syncthreads();
    for (int idx = tid; idx < 62 * 64; idx += NTHREADS) {
        const int i = idx >> 6, ch = idx & 63, s = s0 - 30 + i;
        u32x4 v = (u32x4){0u, 0u, 0u, 0u};
        if (s >= 0) v = *(const u32x4*)(QK + (size_t)(b * SEQ + s) * QW + 768 + 8 * ch);
        *(u32x4*)(inp + i * CW + 8 * ch) = v;
    }
    const float* cw = a.in[6];
    float wgt[CK];
#pragma unroll
    for (int j = 0; j < CK; ++j) wgt[j] = cw[j * CW + c];
    float acc[32];
    const float bias = a.in[7][c];
#pragma unroll
    for (int t = 0; t < 32; ++t) acc[t] = bias;
    __syncthreads();
#pragma unroll
    for (int i = 0; i < 62; ++i) {
        const float v = bf2f(inp[i * CW + c]);
#pragma unroll
        for (int t = 0; t < 32; ++t) { const int j = i - t; if (j >= 0 && j < CK) acc[t] += v * wgt[j]; }
    }
#pragma unroll
    for (int t = 0; t < 32; ++t) yb[t * CW + c] = acc[t];
    __syncthreads();
    const float* lg = a.in[8]; const float* lb = a.in[9];
    const f32x4 g0 = *(const f32x4*)(lg + 8 * lane), g1 = *(const f32x4*)(lg + 8 * lane + 4), b0 = *(const f32x4*)(lb + 8 * lane), b1 = *(const f32x4*)(lb + 8 * lane + 4);
#pragma unroll
    for (int q = 0; q < 4; ++q) {
        const int t = wid * 4 + q;
        f32x4 v0 = *(const f32x4*)(yb + t * CW + 8 * lane), v1 = *(const f32x4*)(yb + t * CW + 8 * lane + 4);
        const float mean = wave_sum((v0[0] + v0[1]) + (v0[2] + v0[3]) + (v1[0] + v1[1]) + (v1[2] + v1[3])) * (1.0f / CW);
        v0 = v0 - mean; v1 = v1 - mean;
        const float var = wave_sum((v0[0] * v0[0] + v0[1] * v0[1]) + (v0[2] * v0[2] + v0[3] * v0[3]) + (v1[0] * v1[0] + v1[1] * v1[1]) + (v1[2] * v1[2] + v1[3] * v1[3])) * (1.0f / CW);
        const float rstd = rsqrtf(var + LN_EPS);
        f32x4 r0 = v0 * rstd * g0 + b0, r1 = v1 * rstd * g1 + b1;
#pragma unroll
        for (int e = 0; e < 4; ++e) { r0[e] = siluf_(r0[e]); r1[e] = siluf_(r1[e]); }
        store8_bf16(AC + (size_t)(t0 + t) * DM + 512 + 8 * lane, r0, r1);
    }
}

__device__ __forceinline__ void phase_mixer(const Args& a, unsigned char* lds, int G) {
    if (!(a.flags & 2)) for (int u = blockIdx.x; u < NB * 32 * NKVH; u += G) attn_unit(a, lds, u);
    if (!(a.flags & 4)) for (int u = blockIdx.x; u < T / 32; u += G) conv_unit(a, lds, u);
}

struct SchedWo {
    XcdSplit xs; unsigned A, Bt;
    __device__ __forceinline__ bool next(int i, pg::Unit& u) const {
        int idx; if (!xs.unit(i, idx)) return false; int pm, pn; dense_pmpn(idx, 4, pm, pn);
        u.a = A + (unsigned)pm * 256 * 2048; u.r0 = pm * 256; u.c = pn; u.aux = 0; u.nv = 0;
        u.b0 = Bt + (unsigned)(256 * pn) * 2048; u.b1 = u.b0 + 128 * 2048; return true; }
    __device__ __forceinline__ int row(const pg::Unit&, int) const { return 0; }
};
struct EpiWo {
    static constexpr int NST = 16;
    const float* mod; bf16* mix;
    __device__ __forceinline__ void operator()(const acc_t& acc, const pg::Unit& u, int wr, int wc, int fr, int fq) const {
        const int row0 = u.r0 + wr * 64 + fr, bb = u.r0 >> 12, col0 = 256 * u.c + wc * 32 + 8 * fq;
        f32x4 g[2][2];
#pragma unroll
        for (int bj = 0; bj < 2; ++bj)
#pragma unroll
            for (int n = 0; n < 2; ++n) g[bj][n] = *(const f32x4*)(mod + bb * 6144 + 2048 + col0 + 128 * bj + 4 * n) + 1.0f;
#pragma unroll
        for (int ai = 0; ai < 2; ++ai)
#pragma unroll
            for (int m = 0; m < 4; ++m) { bf16* rowp = mix + (size_t)(row0 + ai * 128 + m * 16) * DM + col0;
#pragma unroll
                for (int bj = 0; bj < 2; ++bj) store8_bf16(rowp + 128 * bj, g[bj][0] * acc[ai][bj][m][0], g[bj][1] * acc[ai][bj][m][1]); }
    }
};
__device__ __forceinline__ void phase_wo(const Args& a, unsigned char* lds, int G) {
    SchedWo S{XcdSplit{(T / 256) * 4, G, (int)blockIdx.x}, (unsigned)WS_AC, (unsigned)WS_WOT};
    EpiWo E{(const float*)(a.ws + WS_MOD), (bf16*)(a.ws + WS_MIX)};
    pg::gemm_phase<EpiWo, SchedWo, false>((LAS unsigned char*)lds, a.ws, DM * 2, S, E);
}

__device__ __forceinline__ void phase_ln1(const Args& a, int G) {
    const float* mod = (const float*)(a.ws + WS_MOD); const float* x = a.in[0]; const bf16* mix = (const bf16*)(a.ws + WS_MIX);
    bf16* x1b = (bf16*)(a.ws + WS_X1B); bf16* h2 = (bf16*)(a.ws + WS_H2); unsigned char* h2q = a.ws + WS_H2Q;
    const float* lg = a.in[11]; const float* lb = a.in[12];
    const int lane = threadIdx.x & 63, wid = threadIdx.x >> 6;
    for (int m = blockIdx.x * NWAVES + wid; m < T; m += G * NWAVES) {
        const int bb = m >> 12; const float* xr = x + (size_t)m * DM; const bf16* mr = mix + (size_t)m * DM;
        f32x4 v[4]; float s = 0.f;
#pragma unroll
        for (int q = 0; q < 4; ++q) { const int n = 4 * lane + 256 * q; const f32x4 xv = *(const f32x4*)(xr + n); const u32x2 mw = *(const u32x2*)(mr + n);
            v[q] = xv * ALPHA + (f32x4){bflo(mw.x), bfhi(mw.x), bflo(mw.y), bfhi(mw.y)}; s += (v[q][0] + v[q][1]) + (v[q][2] + v[q][3]); }
        const float mean = wave_sum(s) * (1.0f / DM); float s2 = 0.f;
#pragma unroll
        for (int q = 0; q < 4; ++q) { v[q] = v[q] - mean; s2 += (v[q][0] * v[q][0] + v[q][1] * v[q][1]) + (v[q][2] * v[q][2] + v[q][3] * v[q][3]); }
        const float rstd = rsqrtf(wave_sum(s2) * (1.0f / DM) + LN_EPS);
#pragma unroll
        for (int q = 0; q < 4; ++q) {
            const int n = 4 * lane + 256 * q;
            const f32x4 x1 = v[q] * rstd * *(const f32x4*)(lg + n) + *(const f32x4*)(lb + n);
            u32x2 w1; w1.x = pk2(x1[0], x1[1]); w1.y = pk2(x1[2], x1[3]); *(u32x2*)(x1b + (size_t)m * DM + n) = w1;
            const f32x4 hh = x1 * (*(const f32x4*)(mod + bb * 6144 + 4096 + n) + 1.0f) + *(const f32x4*)(mod + bb * 6144 + 3072 + n);
            u32x2 w; w.x = pk2(hh[0], hh[1]); w.y = pk2(hh[2], hh[3]); *(u32x2*)(h2 + (size_t)m * DM + n) = w;
            *(unsigned*)(h2q + (size_t)m * DM + n) = pk4_fp8(hh, 1.0f);
        }
    }
}

struct SchedRs {
    XcdSplit xs; unsigned A, Bt;
    __device__ __forceinline__ bool next(int i, pg::Unit& u) const {
        int idx; if (!xs.unit(i, idx)) return false; int pm, pn; dense_pmpn(idx, 3, pm, pn);
        u.a = A + (unsigned)pm * 256 * 2048; u.r0 = pm * 256; u.c = pn; u.aux = 0; u.nv = 0;
        if (pn == 0) { u.b0 = Bt; u.b1 = Bt + 128 * 2048; }
        else { const int j = pn - 1; u.b0 = Bt + (unsigned)(256 + 128 * j) * 2048; u.b1 = Bt + (unsigned)(512 + 128 * j) * 2048; }
        return true; }
    __device__ __forceinline__ int row(const pg::Unit&, int) const { return 0; }
};
struct EpiRs {
    static constexpr int NST = 8;
    float* logits; bf16* hs;
    __device__ __forceinline__ void operator()(const acc_t& acc, const pg::Unit& u, int wr, int wc, int fr, int fq) const {
        const int row0 = u.r0 + wr * 64 + fr;
        if (u.c == 0) {
#pragma unroll
            for (int ai = 0; ai < 2; ++ai)
#pragma unroll
                for (int m = 0; m < 4; ++m) { float* rowp = logits + (size_t)(row0 + ai * 128 + m * 16) * NE + wc * 32 + 8 * fq;
#pragma unroll
                    for (int bj = 0; bj < 2; ++bj) { *(f32x4*)(rowp + 128 * bj) = acc[ai][bj][m][0]; *(f32x4*)(rowp + 128 * bj + 4) = acc[ai][bj][m][1]; } }
        } else {
            const int j = u.c - 1;
#pragma unroll
            for (int ai = 0; ai < 2; ++ai)
#pragma unroll
                for (int m = 0; m < 4; ++m) { bf16* rowp = hs + (size_t)(row0 + ai * 128 + m * 16) * FE + 128 * j + wc * 32 + 8 * fq;
                    f32x4 r0, r1;
#pragma unroll
                    for (int q = 0; q < 4; ++q) { r0[q] = siluf_(acc[ai][0][m][0][q]) * acc[ai][1][m][0][q]; r1[q] = siluf_(acc[ai][0][m][1][q]) * acc[ai][1][m][1][q]; }
                    store8_bf16(rowp, r0, r1); }
        }
    }
};
__device__ __forceinline__ void phase_rs(const Args& a, unsigned char* lds, int G) {
    SchedRs S{XcdSplit{(T / 256) * 3, G, (int)blockIdx.x}, (unsigned)WS_H2, (unsigned)WS_WCAT};
    EpiRs E{(float*)(a.ws + WS_LOG), (bf16*)(a.ws + WS_HS)};
    pg::gemm_phase<EpiRs, SchedRs, false>((LAS unsigned char*)lds, a.ws, DM * 2, S, E);
}

#define DPPF(v, ctrl) __int_as_float(__builtin_amdgcn_update_dpp(0, __float_as_int(v), (ctrl), 0xf, 0xf, true))
__device__ __forceinline__ float wave_max_dpp(float v) {
    v = fmaxf(v, DPPF(v, 0xB1)); v = fmaxf(v, DPPF(v, 0x4E)); v = fmaxf(v, DPPF(v, 0x141)); v = fmaxf(v, DPPF(v, 0x140));
    const float r0 = __int_as_float(__builtin_amdgcn_readlane(__float_as_int(v), 0)), r1 = __int_as_float(__builtin_amdgcn_readlane(__float_as_int(v), 16));
    const float r2 = __int_as_float(__builtin_amdgcn_readlane(__float_as_int(v), 32)), r3 = __int_as_float(__builtin_amdgcn_readlane(__float_as_int(v), 48));
    return fmaxf(fmaxf(r0, r1), fmaxf(r2, r3));
}
__device__ __forceinline__ void phase_route(const Args& a, unsigned char* lds, int G) {
    const float* logits = (const float*)(a.ws + WS_LOG); const float* rbias = a.in[14];
    int* gcount = (int*)(a.ws + WS_GCNT); int* rdst = (int*)(a.ws + WS_RDST); float* ew = (float*)(a.ws + WS_EW);
    const int tid = threadIdx.x, lane = tid & 63, wid = tid >> 6;
    int* hist = (int*)lds; int* base = hist + 256; int* pe = hist + 512; float* pw = (float*)(hist + 512 + 2048);
    __syncthreads();
    if (tid < NE) hist[tid] = 0;
    __syncthreads();
    const int chunk = (T + G - 1) / G, tbeg = blockIdx.x * chunk, tend = min(T, tbeg + chunk);
    const f32x4 bv = *(const f32x4*)(rbias + 4 * lane);
    for (int t = tbeg + wid; t < tend; t += NWAVES) {
        const f32x4 lg = *(const f32x4*)(logits + (size_t)t * NE + 4 * lane);
        float sc[4], v[4];
#pragma unroll
        for (int i = 0; i < 4; ++i) { sc[i] = sigmoidf_ref(lg[i]); v[i] = sc[i] + bv[i]; }
        float a1 = fmaxf(v[0], v[1]), a2 = fminf(v[0], v[1]);
        { const float c1 = fmaxf(v[2], v[3]), c2 = fminf(v[2], v[3]); const float n1 = fmaxf(a1, c1), n2 = fmaxf(fminf(a1, c1), fmaxf(a2, c2)); a1 = n1; a2 = n2; }
        { const float c1 = DPPF(a1, 0xB1), c2 = DPPF(a2, 0xB1); const float n1 = fmaxf(a1, c1), n2 = fmaxf(fminf(a1, c1), fmaxf(a2, c2)); a1 = n1; a2 = n2; }
        { const float c1 = DPPF(a1, 0x4E), c2 = DPPF(a2, 0x4E); const float n1 = fmaxf(a1, c1), n2 = fmaxf(fminf(a1, c1), fmaxf(a2, c2)); a1 = n1; a2 = n2; }
        { const float c1 = DPPF(a1, 0x141), c2 = DPPF(a2, 0x141); const float n1 = fmaxf(a1, c1), n2 = fmaxf(fminf(a1, c1), fmaxf(a2, c2)); a1 = n1; a2 = n2; }
        const float gs = a1 + a2; const int mg = lane >> 3; int rank = 0;
#pragma unroll
        for (int g = 0; g < 8; ++g) { const float o = __int_as_float(__builtin_amdgcn_readlane(__float_as_int(gs), 8 * g)); rank += (o > gs || (o == gs && g < mg)) ? 1 : 0; }
        if (rank >= 4) { v[0] = -INFINITY; v[1] = -INFINITY; v[2] = -INFINITY; v[3] = -INFINITY; }
        int my_e = 0; float my_w = 0.f, wsum = 0.f;
#pragma unroll
        for (int r = 0; r < TOPK; ++r) {
            const float m = fmaxf(fmaxf(v[0], v[1]), fmaxf(v[2], v[3]));
            const float M = wave_max_dpp(m);
            const unsigned long long mask = __ballot(m == M);
            const int L = __builtin_amdgcn_readfirstlane((int)__builtin_ctzll(mask));
            const int li = (v[0] == M) ? 0 : (v[1] == M) ? 1 : (v[2] == M) ? 2 : 3;
            const float ls = (li == 0) ? sc[0] : (li == 1) ? sc[1] : (li == 2) ? sc[2] : sc[3];
            const int wi = __builtin_amdgcn_readlane(li, L);
            const float wv = __int_as_float(__builtin_amdgcn_readlane(__float_as_int(ls), L));
            if (lane == L) { if (li == 0) v[0] = -INFINITY; else if (li == 1) v[1] = -INFINITY; else if (li == 2) v[2] = -INFINITY; else v[3] = -INFINITY; }
            wsum += wv;
            if (lane == r) { my_e = 4 * L + wi; my_w = wv; }
        }
        if (lane < TOPK) {
            const int p = (t - tbeg) * TOPK + lane;
            pe[p] = my_e; pw[p] = my_w / wsum * 2.5f;
            atomicAdd(&hist[my_e], 1);
        }
    }
    __syncthreads();
    if (tid < NE) { const int h = hist[tid]; base[tid] = h ? __hip_atomic_fetch_add(&gcount[tid], h, __ATOMIC_RELAXED, __HIP_MEMORY_SCOPE_AGENT) : 0; hist[tid] = 0; }
    __syncthreads();
    const int np = (tend - tbeg) * TOPK;
    for (int i = tid; i < np; i += NTHREADS) {
        const int e = pe[i];
        const int r = base[e] + atomicAdd(&hist[e], 1);
        rdst[(size_t)e * RCAP + r] = tbeg * TOPK + i; ew[tbeg * TOPK + i] = pw[i];
    }
}

__device__ __forceinline__ int moe_prefix(const int* gcount, int* pref, int* scr) {
    const int tid = threadIdx.x;
    __syncthreads();
    int nt_e = 0;
    if (tid < NE) { nt_e = (gcount[tid] + 255) >> 8; scr[tid] = nt_e; }
    __syncthreads();
    int cur = 0;
    for (int o = 1; o < NE; o <<= 1) {
        if (tid < NE) scr[(cur ^ 1) * 256 + tid] = scr[cur * 256 + tid] + ((tid >= o) ? scr[cur * 256 + tid - o] : 0);
        cur ^= 1;
        __syncthreads();
    }
    if (tid < NE) { const int incl = scr[cur * 256 + tid]; pref[tid] = incl - nt_e; if (tid == NE - 1) pref[NE] = incl; }
    __syncthreads();
    return pref[NE];
}
__device__ __forceinline__ int moe_tile_expert(const int* pref, int tile) {
    int lo = 0, hi = NE - 1;
    while (lo < hi) { const int mid = (lo + hi + 1) >> 1; if (pref[mid] <= tile) lo = mid; else hi = mid - 1; }
    return lo;
}

constexpr int LIST_OFF = pg::PG_STAGE_BYTES, MAX_LISTS = 12, PREF_OFF = LIST_OFF + MAX_LISTS * 1024, DESC_OFF = PREF_OFF + 1040, MAX_DESC = 48;
struct SchedMoe1 {
    XcdSplit xs; unsigned A, Wg, Wu; const int* desc; const int* lists;
    __device__ __forceinline__ bool next(int i, pg::Unit& u) const {
        int idx; if (!xs.unit(i, idx)) return false; const int e = __builtin_amdgcn_readfirstlane(desc[2 * i]), tile = idx >> 1, j = idx & 1;
        u.a = A; u.r0 = tile * 256; u.c = j; u.aux = i; u.nv = 0;
        u.b0 = Wg + (unsigned)(e * 256 + 128 * j) * 1024; u.b1 = Wu + (unsigned)(e * 256 + 128 * j) * 1024; return true; }
    __device__ __forceinline__ int row(const pg::Unit& u, int r) const { return lists[u.aux * 256 + r]; }
};
struct EpiMoe1 {
    static constexpr int NST = 8;
    unsigned char* H8;
    __device__ __forceinline__ void operator()(const acc_t& acc, const pg::Unit& u, int wr, int wc, int fr, int fq) const {
        const int row0 = u.r0 + wr * 64 + fr;
#pragma unroll
        for (int ai = 0; ai < 2; ++ai)
#pragma unroll
            for (int m = 0; m < 4; ++m) { unsigned char* rowp = H8 + (size_t)(row0 + ai * 128 + m * 16) * FE + 128 * u.c + wc * 32 + 8 * fq;
                f32x4 r0, r1;
#pragma unroll
                for (int q = 0; q < 4; ++q) { r0[q] = siluf_(acc[ai][0][m][0][q]) * acc[ai][1][m][0][q]; r1[q] = siluf_(acc[ai][0][m][1][q]) * acc[ai][1][m][1][q]; }
                u32x2 o; o.x = pk4_fp8(r0, H8_SCALE); o.y = pk4_fp8(r1, H8_SCALE); *(u32x2*)rowp = o; }
    }
};
__device__ __forceinline__ void phase_moe1(const Args& a, unsigned char* lds, int G) {
    const int* gcount = (const int*)(a.ws + WS_GCNT); const int* rdst = (const int*)(a.ws + WS_RDST);
    int* lists = (int*)(lds + LIST_OFF); int* pref = (int*)(lds + PREF_OFF); int* desc = (int*)(lds + DESC_OFF);
    const int ntiles = moe_prefix(gcount, pref, (int*)lds);
    XcdSplit xs{ntiles * 2, G, (int)blockIdx.x};
    for (int i = 0; i < MAX_LISTS; ++i) {
        int idx; if (!xs.unit(i, idx)) break;
        const int tile = idx >> 1, e = moe_tile_expert(pref, tile), tin = tile - pref[e], cnt = gcount[e];
        if (threadIdx.x < 256) { const int pos = tin * 256 + (int)threadIdx.x; lists[i * 256 + threadIdx.x] = (pos < cnt) ? (rdst[(size_t)e * RCAP + pos] >> 3) : 0; }
        if (threadIdx.x == 0) { desc[2 * i] = e; desc[2 * i + 1] = tin; }
    }
    __syncthreads();
    SchedMoe1 S{xs, (unsigned)WS_H2Q, (unsigned)WS_WGT8, (unsigned)WS_WUT8, desc, lists};
    EpiMoe1 E{a.ws + WS_H8};
    pg::gemm_phase<EpiMoe1, SchedMoe1, true, 0, true, 122, 127>((LAS unsigned char*)lds, a.ws, DM, S, E);
}

struct SchedMoe2 {
    XcdSplit xs; unsigned Hb, Wd; const int* desc;
    __device__ __forceinline__ bool next(int i, pg::Unit& u) const {
        int idx; if (!xs.unit(i, idx)) return false;
        const int tile = idx >> 2, jn = idx & 3, e = __builtin_amdgcn_readfirstlane(desc[2 * i]), nv = __builtin_amdgcn_readfirstlane(desc[2 * i + 1]);
        u.a = Hb + (unsigned)tile * 256 * 256; u.r0 = tile * 256; u.c = jn; u.aux = e; u.nv = nv;
        u.b0 = Wd + (unsigned)(e * 1024 + 256 * jn) * 256; u.b1 = u.b0 + 8 * 256;
        return true; }
    __device__ __forceinline__ int row(const pg::Unit&, int) const { return 0; }
};
struct SchedSd {
    XcdSplit xs; unsigned hs, Wds;
    __device__ __forceinline__ bool next(int i, pg::Unit& u) const {
        int idx; if (!xs.unit(i, idx)) return false; int pm, pn; dense_pmpn(idx, 4, pm, pn);
        u.a = hs + (unsigned)pm * 256 * 512; u.r0 = pm * 256; u.c = pn; u.aux = -1; u.nv = 0;
        u.b0 = Wds + (unsigned)(256 * pn) * 512; u.b1 = u.b0 + 8 * 512;
        return true; }
    __device__ __forceinline__ int row(const pg::Unit&, int) const { return 0; }
};
struct EpiMoe2 {
    static constexpr int NST = 0;
    unsigned char* Y; bf16* SD; const int* rdst; const float* rw; const int* pref; int flags;
    __device__ __forceinline__ void operator()(const acc_t& acc, const pg::Unit& u, int wr, int wc, int fr, int fq) const {
        const int col0 = 256 * u.c + wc * 64 + 16 * fq;
        if (u.aux >= 0) {
            const int tin256 = u.r0 - pref[u.aux] * 256;
            const size_t lbase = (size_t)u.aux * RCAP;
#pragma unroll
            for (int ai = 0; ai < 2; ++ai)
#pragma unroll
                for (int m = 0; m < 4; ++m) { const int pos = tin256 + wr * 64 + fr + ai * 128 + m * 16;
                    if (pos < u.nv && !(flags & 1)) { const int dst = rdst[lbase + pos]; const float wv = rw[dst] * Y_SCALE;
                        u32x4 o; o.x = pk4_fp8(acc[ai][0][m][0], wv); o.y = pk4_fp8(acc[ai][0][m][1], wv); o.z = pk4_fp8(acc[ai][1][m][0], wv); o.w = pk4_fp8(acc[ai][1][m][1], wv);
                        *(u32x4*)(Y + (size_t)dst * DM + col0) = o; } }
        } else {
            const int row0 = u.r0 + wr * 64 + fr;
#pragma unroll
            for (int ai = 0; ai < 2; ++ai)
#pragma unroll
                for (int m = 0; m < 4; ++m) { bf16* rowp = SD + (size_t)(row0 + ai * 128 + m * 16) * DM + col0;
#pragma unroll
                    for (int bj = 0; bj < 2; ++bj) store8_bf16(rowp + 8 * bj, acc[ai][bj][m][0], acc[ai][bj][m][1]); }
        }
    }
};
__device__ __forceinline__ void phase_moe2(const Args& a, unsigned char* lds, int G) {
    const int* gcount = (const int*)(a.ws + WS_GCNT);
    int* pref = (int*)(lds + PREF_OFF); int* desc = (int*)(lds + DESC_OFF);
    const int ntiles = moe_prefix(gcount, pref, (int*)lds);
    const int NU2 = ntiles * 4;
    XcdSplit xs{NU2, G, (int)blockIdx.x};
    if (threadIdx.x == 0) {
        for (int i = 0; i < MAX_DESC; ++i) { int idx; if (!xs.unit(i, idx)) break;
            const int e = moe_tile_expert(pref, idx >> 2); desc[2 * i] = e; desc[2 * i + 1] = gcount[e]; }
    }
    __syncthreads();
    EpiMoe2 E{(unsigned char*)(a.ws + WS_Y), (bf16*)(a.ws + WS_SD), (const int*)(a.ws + WS_RDST), (const float*)(a.ws + WS_EW), pref, a.flags};
    { SchedMoe2 S{xs, (unsigned)WS_H8, (unsigned)WS_WDT8, desc};
      pg::gemm_phase<EpiMoe2, SchedMoe2, false, 1, true, 122, 124>((LAS unsigned char*)lds, a.ws, FE, S, E); }
    { SchedSd S{XcdSplit{(T / 256) * 4, G, (int)blockIdx.x}, (unsigned)WS_HS, (unsigned)WS_WDST};
      pg::gemm_phase<EpiMoe2, SchedSd, false, 1>((LAS unsigned char*)lds, a.ws, FE * 2, S, E); }
}

__device__ __forceinline__ void phase_final(const Args& a, int G) {
    const float* mod = (const float*)(a.ws + WS_MOD); float* out = a.out;
    const bf16* SD = (const bf16*)(a.ws + WS_SD); const unsigned char* Y = (const unsigned char*)(a.ws + WS_Y); const bf16* x1b = (const bf16*)(a.ws + WS_X1B);
    const float* lg = a.in[21]; const float* lb = a.in[22];
    const int lane = threadIdx.x & 63, wid = threadIdx.x >> 6, n0 = 16 * lane;
    for (int m = blockIdx.x * NWAVES + wid; m < T; m += G * NWAVES) {
        const int bb = m >> 12; float* rowp = out + (size_t)m * DM + n0;
        u32x4 yw[TOPK];
#pragma unroll
        for (int k = 0; k < TOPK; ++k) yw[k] = *(const u32x4*)(Y + ((size_t)m * TOPK + k) * DM + n0);
        const u32x4 sa = *(const u32x4*)(SD + (size_t)m * DM + n0), sb = *(const u32x4*)(SD + (size_t)m * DM + n0 + 8);
        const u32x4 xa = *(const u32x4*)(x1b + (size_t)m * DM + n0), xb = *(const u32x4*)(x1b + (size_t)m * DM + n0 + 8);
        f32x4 f[4];
#pragma unroll
        for (int q = 0; q < 4; ++q) f[q] = (f32x4){0.f, 0.f, 0.f, 0.f};
#pragma unroll
        for (int k = 0; k < TOPK; ++k)
#pragma unroll
            for (int q = 0; q < 4; ++q) { const int w = (int)yw[k][q]; const f32x2v lo = __builtin_amdgcn_cvt_pk_f32_fp8(w, false), hi = __builtin_amdgcn_cvt_pk_f32_fp8(w, true);
                f[q][0] += lo.x; f[q][1] += lo.y; f[q][2] += hi.x; f[q][3] += hi.y; }
        f32x4 v[4]; float s = 0.f;
#pragma unroll
        for (int q = 0; q < 4; ++q) {
            const unsigned s0 = (q < 2) ? sa[2 * q] : sb[2 * q - 4], s1 = (q < 2) ? sa[2 * q + 1] : sb[2 * q - 3];
            const unsigned x0 = (q < 2) ? xa[2 * q] : xb[2 * q - 4], x1w = (q < 2) ? xa[2 * q + 1] : xb[2 * q - 3];
            const f32x4 ffn = f[q] * (1.0f / Y_SCALE) + (f32x4){bflo(s0), bfhi(s0), bflo(s1), bfhi(s1)};
            const f32x4 x1 = (f32x4){bflo(x0), bfhi(x0), bflo(x1w), bfhi(x1w)};
            v[q] = x1 * ALPHA + (*(const f32x4*)(mod + bb * 6144 + 5120 + n0 + 4 * q) + 1.0f) * ffn;
            s += (v[q][0] + v[q][1]) + (v[q][2] + v[q][3]);
        }
        const float mean = wave_sum(s) * (1.0f / DM); float s2 = 0.f;
#pragma unroll
        for (int q = 0; q < 4; ++q) { v[q] = v[q] - mean; s2 += (v[q][0] * v[q][0] + v[q][1] * v[q][1]) + (v[q][2] * v[q][2] + v[q][3] * v[q][3]); }
        const float rstd = rsqrtf(wave_sum(s2) * (1.0f / DM) + LN_EPS);
#pragma unroll
        for (int q = 0; q < 4; ++q) *(f32x4*)(rowp + 4 * q) = v[q] * rstd * *(const f32x4*)(lg + n0 + 4 * q) + *(const f32x4*)(lb + n0 + 4 * q);
    }
}

constexpr int NPHASES = 11;
__global__ void __launch_bounds__(NTHREADS, 2) fwd_kernel(Args a) {
    extern __shared__ __attribute__((aligned(16))) unsigned char lds[];
    const int G = gridDim.x;
    volatile LAS unsigned* misc = (volatile LAS unsigned*)(LAS unsigned char*)(lds + LDS_BYTES - 64);
    if (threadIdx.x < 16) misc[threadIdx.x] = 0u;
    __syncthreads();
    XcdBarrier bar; bar.bar = (unsigned*)(a.ws + WS_CTL); bar.x = 0; bar.st = nullptr;
    const bool multi = (a.ph_hi - a.ph_lo) > 1;
    if (multi) bar = xcd_barrier_post((unsigned*)(a.ws + WS_CTL), misc);
#define IN(k) (a.ph_lo <= (k) && (k) < a.ph_hi)
#define SEAM(k) do { if (IN(k) && IN((k) + 1)) xcd_barrier(bar); } while (0)
#ifndef REPEAT_MASK
#define REPEAT_MASK 0
#endif
#define REP(k, call) do { if (IN(k)) { call; if ((REPEAT_MASK >> (k)) & 1) { xcd_barrier(bar); Args a2 = a; a2.flags = PROBE_FLAGS; { const Args& a = a2; call; } } } } while (0)
#ifndef PROBE_FLAGS
#define PROBE_FLAGS 0
#endif
    REP(0, phase_prep(a, lds, G));
    SEAM(0);
    REP(1, phase_hmod(a, G));
    SEAM(1);
    REP(2, phase_proj(a, lds, G));
    SEAM(2);
    REP(3, phase_mixer(a, lds, G));
    SEAM(3);
    REP(4, phase_wo(a, lds, G));
    SEAM(4);
    REP(5, phase_ln1(a, G));
    SEAM(5);
    REP(6, phase_rs(a, lds, G));
    SEAM(6);
    REP(7, phase_route(a, lds, G));
    SEAM(7);
    REP(8, phase_moe1(a, lds, G));
    SEAM(8);
    REP(9, phase_moe2(a, lds, G));
    SEAM(9);
    REP(10, phase_final(a, G));
#undef IN
#undef SEAM
}

extern "C" void kernel_launch(void* const* d_in, const int* in_sizes, int n_in, void* d_out, int out_size, void* d_ws, size_t ws_size, hipStream_t stream) {
    static int grid = 0;
    if (grid == 0) {
        if (n_in != 23 || out_size != T * DM || ws_size < WS_END) { fprintf(stderr, "kernel_launch: unexpected shapes (n_in %d out %d ws %zu)\n", n_in, out_size, ws_size); grid = -1; return; }
        int dev = 0, cus = 0;
        if (hipGetDevice(&dev) != hipSuccess || hipDeviceGetAttribute(&cus, hipDeviceAttributeMultiprocessorCount, dev) != hipSuccess) { grid = -1; return; }
        if (hipFuncSetAttribute((const void*)fwd_kernel, hipFuncAttributeMaxDynamicSharedMemorySize, LDS_BYTES) != hipSuccess) { fprintf(stderr, "kernel_launch: hipFuncSetAttribute failed\n"); grid = -1; return; }
        int per_cu = 0;
        (void)hipOccupancyMaxActiveBlocksPerMultiprocessor(&per_cu, (const void*)fwd_kernel, NTHREADS, LDS_BYTES);
        (void)hipGetLastError();
        grid = cus > 512 ? 512 : cus;
        if (per_cu < 1) fprintf(stderr, "kernel_launch: occupancy query reports %d blocks per CU\n", per_cu);
    }
    if (grid < 0) return;
    (void)hipMemsetAsync((char*)d_ws + WS_CTL, 0, CTL_ZERO_BYTES, stream);
    Args a{};
    for (int i = 0; i < 23; ++i) a.in[i] = (const float*)d_in[i];
    a.out = (float*)d_out; a.ws = (unsigned char*)d_ws;
#if N_LAUNCH_MODE == 1
    a.ph_lo = 0; a.ph_hi = NPHASES;
    hipLaunchKernelGGL(fwd_kernel, dim3(grid), dim3(NTHREADS), LDS_BYTES, stream, a);
#else
    for (int p = 0; p < NPHASES; ++p) { a.ph_lo = p; a.ph_hi = p + 1; hipLaunchKernelGGL(fwd_kernel, dim3(grid), dim3(NTHREADS), LDS_BYTES, stream, a); }
#endif
}
```

```cpp
#include <hip/hip_runtime.h>
#include <cstdio>
#include <cstdint>

#define LAS __attribute__((address_space(3)))
typedef unsigned short bf16;
typedef short bf16x8 __attribute__((ext_vector_type(8)));
typedef short bf16x4v __attribute__((ext_vector_type(4)));
typedef float f32x4 __attribute__((ext_vector_type(4)));
typedef unsigned u32x4 __attribute__((ext_vector_type(4)));
typedef unsigned u32x2 __attribute__((ext_vector_type(2)));
typedef float f32x2v __attribute__((ext_vector_type(2)));

#ifndef N_LAUNCH_MODE
#define N_LAUNCH_MODE 1
#endif

constexpr int NB = 8, SEQ = 4096, DM = 1024, T = NB * SEQ;
constexpr int HD = 64, NQH = 8, NKVH = 2;
constexpr int INC = 1792, QW = 1280;
constexpr int NE = 256, TOPK = 8, FE = 256;
constexpr int CK = 31, CW = 512;
constexpr int BM = 256, BN = 128;
constexpr int MAXROWS = T * TOPK + NE * BM;
constexpr int MAXTILES = MAXROWS / BM;
constexpr float LN_EPS = 1e-5f;
constexpr float ALPHA = 1.18920711500272106672f;
constexpr int NTHREADS = 512, NWAVES = 8;
constexpr int LDS_BYTES = 147456;

constexpr size_t MiB = 1u << 20;
constexpr size_t WS_CTL = 0, CTL_ZERO_BYTES = 64 * 1024;
constexpr size_t WS_MOD = 1 * MiB;
constexpr size_t WS_WINT = 12 * MiB;
constexpr size_t WS_WOT = 16 * MiB;
constexpr size_t WS_WCAT = 18 * MiB;
constexpr size_t WS_WDST = 20 * MiB;
constexpr size_t WS_WDT8 = 24 * MiB;
constexpr size_t WS_H8 = 88 * MiB;
constexpr size_t WS_HS = 168 * MiB;
constexpr size_t WS_SD = 184 * MiB;
constexpr size_t WS_X1B = 248 * MiB;
constexpr size_t WS_RDST = 312 * MiB;
constexpr size_t WS_Y = 344 * MiB;
constexpr size_t WS_WGT8 = 344 * MiB;
constexpr size_t WS_WUT8 = 408 * MiB;
constexpr size_t WS_H2Q = 472 * MiB;
constexpr size_t WS_LOG = 504 * MiB;
constexpr size_t WS_H2 = 600 * MiB;
constexpr size_t WS_QKVG = 664 * MiB;
constexpr size_t WS_MIX = 664 * MiB;
constexpr size_t WS_AC = 744 * MiB;
constexpr size_t WS_EW = 2 * MiB;
constexpr size_t WS_RER = 3 * MiB;
constexpr size_t WS_END = 808 * MiB;
constexpr size_t WS_GCNT = 32768;
constexpr int RCAP = T;

__device__ __forceinline__ unsigned f2bf(float f) { unsigned u = __float_as_uint(f); return (u + 0x7fffu + ((u >> 16) & 1u)) >> 16; }
__device__ __forceinline__ unsigned pk2(float lo, float hi) { unsigned r; asm volatile("v_cvt_pk_bf16_f32 %0, %1, %2" : "=v"(r) : "v"(lo), "v"(hi)); return r; }
__device__ __forceinline__ float bf2f(unsigned h) { return __uint_as_float(h << 16); }
__device__ __forceinline__ float bflo(unsigned w) { return __uint_as_float(w << 16); }
__device__ __forceinline__ float bfhi(unsigned w) { return __uint_as_float(w & 0xffff0000u); }
__device__ __forceinline__ float sigmoidf_(float v) { return __builtin_amdgcn_rcpf(1.0f + __builtin_amdgcn_exp2f(-1.44269504089f * v)); }
__device__ __forceinline__ float sigmoidf_ref(float v) { return 1.0f / (1.0f + __expf(-v)); }
__device__ __forceinline__ float siluf_(float v) { return v * __builtin_amdgcn_rcpf(1.0f + __builtin_amdgcn_exp2f(-1.44269504089f * v)); }
__device__ __forceinline__ float wave_sum(float v) {
#pragma unroll
    for (int o = 1; o < 64; o <<= 1) v += __shfl_xor(v, o);
    return v;
}
__device__ __forceinline__ int perm32(int rho) { const int n = rho >> 4, i = rho & 15; return 8 * (i >> 2) + 4 * n + (i & 3); }

#define XB_TMO      128
#define XB_XCNT(j)  (256  + 64 * (j))
#define XB_XSUB(j)  (1280 + 64 * (j))
#define XB_XGEN(j)  (2304 + 64 * (j))
#define XB_TOP      3328
#define XB_TOPGEN   3392
#define XCD_BAR_WORDS 3456
#define XB_SPIN_CAP (1u << 22)
__device__ __forceinline__ unsigned xb_ld(unsigned* p)              { return __hip_atomic_load(p, __ATOMIC_RELAXED, __HIP_MEMORY_SCOPE_AGENT); }
__device__ __forceinline__ unsigned xb_add(unsigned* p, unsigned v) { return __hip_atomic_fetch_add(p, v, __ATOMIC_RELAXED, __HIP_MEMORY_SCOPE_AGENT); }
__device__ __forceinline__ unsigned xb_xcc_id() { return (unsigned)__builtin_amdgcn_s_getreg((3 << 11) | 20) & 0xFu; }
#define XB_SPIN(cond, bar) do { unsigned _sp = 0; while (cond) { __builtin_amdgcn_s_sleep(1); \
    if ((++_sp & 255u) == 0u) { if (xb_ld(&(bar)[XB_TMO])) break; if (_sp > XB_SPIN_CAP) { atomicAdd(&(bar)[XB_TMO], 1u); break; } } } } while (0)
struct XcdBarrier { unsigned* bar; unsigned x; volatile LAS unsigned* st; };
__device__ __forceinline__ XcdBarrier xcd_barrier_post(unsigned* bar, volatile LAS unsigned* st) {
    XcdBarrier b; b.bar = bar; b.x = xb_xcc_id(); b.st = st;
    if (threadIdx.x == 0) (void)xb_add(&bar[XB_XCNT(b.x)], 1u);
    return b;
}
__device__ __forceinline__ void xcd_barrier_complete(unsigned* bar, unsigned x, unsigned& nloc, unsigned& nx) {
    const unsigned G = gridDim.x * gridDim.y * gridDim.z;
    unsigned sum, cnt, mine, sp = 0u;
    for (;;) {
        sum = 0u; cnt = 0u; mine = 0u;
#pragma unroll
        for (unsigned j = 0; j < 16; ++j) { const unsigned c = xb_ld(&bar[XB_XCNT(j)]); sum += c; cnt += (c > 0u) ? 1u : 0u; mine = (j == x) ? c : mine; }
        if (sum == G) break;
        __builtin_amdgcn_s_sleep(1);
        if ((++sp & 255u) == 0u) { if (xb_ld(&bar[XB_TMO])) break; if (sp > XB_SPIN_CAP) { atomicAdd(&bar[XB_TMO], 1u); break; } }
    }
    nloc = mine > 0u ? mine : 1u; nx = cnt > 0u ? cnt : 1u;
}
__device__ __forceinline__ void xcd_barrier(const XcdBarrier& b) {
    asm volatile("s_waitcnt vmcnt(0)" ::: "memory");
    __syncthreads();
    if (threadIdx.x == 0) {
        unsigned* bar = b.bar;
        __builtin_amdgcn_s_waitcnt(0);
        unsigned nloc = b.st[0], nx = b.st[1];
        if (nloc == 0u) { xcd_barrier_complete(bar, b.x, nloc, nx); b.st[0] = nloc; b.st[1] = nx; }
        const unsigned old = xb_add(&bar[XB_XSUB(b.x)], 1u);
        const unsigned gen = old / nloc;
        if (old + 1u == (gen + 1u) * nloc) {
            __builtin_amdgcn_fence(__ATOMIC_RELEASE, "agent");
            asm volatile("s_waitcnt vmcnt(0)" ::: "memory");
            const unsigned og = xb_add(&bar[XB_TOP], 1u);
            const unsigned tg = og / nx;
            if (og + 1u == (tg + 1u) * nx) xb_add(&bar[XB_TOPGEN], 1u);
            else XB_SPIN(xb_ld(&bar[XB_TOPGEN]) == tg, bar);
            __builtin_amdgcn_fence(__ATOMIC_ACQUIRE, "agent");
            xb_add(&bar[XB_XGEN(b.x)], 1u);
            asm volatile("s_waitcnt vmcnt(0)" ::: "memory");
        } else {
            XB_SPIN(xb_ld(&bar[XB_XGEN(b.x)]) == gen, bar);
            __builtin_amdgcn_fence(__ATOMIC_ACQUIRE, "agent");
            asm volatile("s_waitcnt vmcnt(0)" ::: "memory");
        }
    }
    __syncthreads();
}

struct Args {
    const float* in[23];
    float* out;
    unsigned char* ws;
    int ph_lo, ph_hi, flags, pad;
};

namespace pg {
constexpr int HALF = 128, HTB = HALF * 64 * 2, PG_STAGE_BYTES = 8 * HTB;
__device__ __forceinline__ int lds_byte(int r, int c) { const int st = (r >> 4) * 2 + (c >> 5), rr = r & 15, cc = c & 31, ob = rr * 64 + cc * 2; return st * 1024 + (ob ^ (((ob >> 9) & 1) << 5)); }
__device__ __forceinline__ void stage_rc(int b, int& R, int& C) { const int st = b / 1024, sb = b % 1024, swz = sb ^ (((sb >> 9) & 1) << 5); R = (st >> 1) * 16 + swz / 64; C = (st & 1) * 32 + (swz % 64) / 2; }
struct Unit { unsigned a, b0, b1; int r0, c, aux, nv; };
typedef int i32x8 __attribute__((ext_vector_type(8)));
typedef int i32x4 __attribute__((ext_vector_type(4)));
__device__ __forceinline__ bf16x8 lo8(const i32x8& v) { return __builtin_bit_cast(bf16x8, (i32x4)__builtin_shufflevector(v, v, 0, 1, 2, 3)); }
__device__ __forceinline__ bf16x8 hi8(const i32x8& v) { return __builtin_bit_cast(bf16x8, (i32x4)__builtin_shufflevector(v, v, 4, 5, 6, 7)); }
__device__ __forceinline__ i32x8 cat8(const bf16x8 lo, const bf16x8 hi) { const i32x4 a = __builtin_bit_cast(i32x4, lo), b = __builtin_bit_cast(i32x4, hi); return __builtin_shufflevector(a, b, 0, 1, 2, 3, 4, 5, 6, 7); }
typedef __amdgpu_buffer_rsrc_t rsrc_t;

template <class Epi, class Sched, bool GATHER, int BMAP = 0, bool F8 = false, int SCW = 127, int SCA = 127>
__device__ __forceinline__ void gemm_phase(LAS unsigned char* lds, unsigned char* wsbase, const int ROWB, const Sched& S, const Epi& E) {
    const rsrc_t rs = __builtin_amdgcn_make_buffer_rsrc((void*)wsbase, 0, 0x7fffffff, 0x00020000);
    const int tid = threadIdx.x, wid = __builtin_amdgcn_readfirstlane(tid >> 6), lane = tid & 63, wr = wid >> 2, wc = wid & 3, fr = lane & 15, fq = lane >> 4;
    int nt = ROWB / 128; asm volatile("" : "+s"(nt));
    int Rr[2], Cc[2]; unsigned voffB[2], vA[2][2], nvA[2][2];
#pragma unroll
    for (int i = 0; i < 2; ++i) { stage_rc(tid * 16 + i * 8192, Rr[i], Cc[i]); const int Rb = BMAP ? (64 * (Rr[i] >> 5) + 16 * ((Rr[i] & 15) >> 2) + 4 * ((Rr[i] >> 4) & 1) + (Rr[i] & 3)) : ((Rr[i] & ~31) + perm32(Rr[i] & 31)); voffB[i] = (unsigned)(Rb * ROWB + Cc[i] * 2); }
    const unsigned kstep = 128;
    const unsigned ldsw = (unsigned)wid * 1024u;
    const int aoff = lds_byte(wr * 64 + fr, fq * 8), boff = lds_byte(wc * 32 + fr, fq * 8);
#define PG_SA(b, h) (((b) * 2 + (h)) * pg::HTB)
#define PG_SB(b, h) ((4 + (b) * 2 + (h)) * pg::HTB)
#define PG_STG(bufoff, gbase, v0, v1) do { \
        __builtin_amdgcn_raw_ptr_buffer_load_lds(rs, (LAS unsigned*)(lds + (bufoff) + ldsw), 16, (int)(v0), (int)(gbase), 0, 0); \
        __builtin_amdgcn_raw_ptr_buffer_load_lds(rs, (LAS unsigned*)(lds + (bufoff) + ldsw + 8192), 16, (int)(v1), (int)(gbase), 0, 0); } while (0)
#define PG_STGB(bufoff, gbase) PG_STG(bufoff, gbase, voffB[0], voffB[1])
#define PG_LD16(off) (*(const LAS bf16x8*)(lds + (off)))
#define PG_LDA(dst, b, h) do { _Pragma("unroll") for (int m = 0; m < 4; ++m) dst[m] = pg::cat8(PG_LD16(PG_SA(b, h) + aoff + m * 2048), PG_LD16(PG_SA(b, h) + aoff + m * 2048 + 1024)); } while (0)
#define PG_LDB(dst, b, h) do { _Pragma("unroll") for (int n = 0; n < 2; ++n) dst[n] = pg::cat8(PG_LD16(PG_SB(b, h) + boff + n * 2048), PG_LD16(PG_SB(b, h) + boff + n * 2048 + 1024)); } while (0)
#define PG_MMA(ai, bj, At, Bt) do { __builtin_amdgcn_s_setprio(1); \
        if (F8) { _Pragma("unroll") for (int m = 0; m < 4; ++m) _Pragma("unroll") for (int n = 0; n < 2; ++n) \
            asm volatile("v_mfma_scale_f32_16x16x128_f8f6f4 %0, %1, %2, %0, %3, %4 op_sel_hi:[0,0,0]" : "+v"(acc[ai][bj][m][n]) : "v"(Bt[n]), "v"(At[m]), "v"(scw), "v"(sca)); } \
        else { _Pragma("unroll") for (int m = 0; m < 4; ++m) _Pragma("unroll") for (int n = 0; n < 2; ++n) { \
            acc[ai][bj][m][n] = __builtin_amdgcn_mfma_f32_16x16x32_bf16(pg::lo8(Bt[n]), pg::lo8(At[m]), acc[ai][bj][m][n], 0, 0, 0); \
            acc[ai][bj][m][n] = __builtin_amdgcn_mfma_f32_16x16x32_bf16(pg::hi8(Bt[n]), pg::hi8(At[m]), acc[ai][bj][m][n], 0, 0, 0); } } \
        __builtin_amdgcn_s_setprio(0); } while (0)
#define PG_WAIT_V(n) asm volatile("s_waitcnt vmcnt(" #n ")" ::: "memory")
#define PG_WAIT_L(n) asm volatile("s_waitcnt lgkmcnt(" #n ")" ::: "memory")
#define PG_BAR __builtin_amdgcn_s_barrier()
#define PG_SCHED __builtin_amdgcn_sched_barrier(0)
#define PG_VA(dst, u) do { _Pragma("unroll") for (int h = 0; h < 2; ++h) _Pragma("unroll") for (int i = 0; i < 2; ++i) \
        dst[h][i] = GATHER ? (unsigned)(S.row(u, h * pg::HALF + Rr[i]) * ROWB + Cc[i] * 2) : (unsigned)((h * pg::HALF + Rr[i]) * ROWB + Cc[i] * 2); } while (0)
    Unit cur, nxt; int ui = 0;
    if (!S.next(0, cur)) return;
    f32x4 acc[2][2][4][2];
#pragma unroll
    for (int a = 0; a < 2; ++a)
#pragma unroll
        for (int b = 0; b < 2; ++b)
#pragma unroll
            for (int m = 0; m < 4; ++m)
#pragma unroll
                for (int n = 0; n < 2; ++n) acc[a][b][m][n] = (f32x4){0.f, 0.f, 0.f, 0.f};
    pg::i32x8 At[4], B0[2], B1[2];
    int scw = SCW * 0x01010101, sca = SCA * 0x01010101; asm volatile("" : "+v"(scw), "+v"(sca));
    PG_VA(vA, cur);
#pragma unroll
    for (int h = 0; h < 2; ++h)
#pragma unroll
        for (int i = 0; i < 2; ++i) nvA[h][i] = vA[h][i];
    unsigned cA = cur.a, cB0 = cur.b0, cB1 = cur.b1;
    PG_STGB(PG_SB(0, 0), cB0); PG_STGB(PG_SB(0, 1), cB1); PG_STG(PG_SA(0, 0), cA, vA[0][0], vA[0][1]); PG_STG(PG_SA(0, 1), cA, vA[1][0], vA[1][1]);
    if (wr == 1) PG_BAR;
    PG_WAIT_V(2); PG_BAR;
    PG_STGB(PG_SB(1, 0), cB0 + kstep); PG_STG(PG_SA(1, 0), cA + kstep, vA[0][0], vA[0][1]); PG_STGB(PG_SB(1, 1), cB1 + kstep);
    PG_WAIT_V(6); PG_BAR;
    for (;;) {
        const bool has_next = S.next(ui + 1, nxt);
        const unsigned nA = has_next ? nxt.a : cA, nB0 = has_next ? nxt.b0 : cB0, nB1 = has_next ? nxt.b1 : cB1;
#pragma unroll 1
        for (int t = 0; t < nt; t += 2) {
            const bool last = (t == nt - 2);
            const unsigned a1 = cA + (unsigned)(t + 1) * kstep;
            const unsigned a2 = last ? nA : cA + (unsigned)(t + 2) * kstep;
            const unsigned b20 = last ? nB0 : cB0 + (unsigned)(t + 2) * kstep, b21 = last ? nB1 : cB1 + (unsigned)(t + 2) * kstep;
            const unsigned a3 = a2 + kstep, b30 = b20 + kstep, b31 = b21 + kstep;
            unsigned wA[2][2];
            if (GATHER) {
                if (last && has_next) PG_VA(nvA, nxt);
#pragma unroll
                for (int h = 0; h < 2; ++h)
#pragma unroll
                    for (int i = 0; i < 2; ++i) wA[h][i] = (last && has_next) ? nvA[h][i] : vA[h][i];
            } else {
#pragma unroll
                for (int h = 0; h < 2; ++h)
#pragma unroll
                    for (int i = 0; i < 2; ++i) wA[h][i] = vA[h][i];
            }
            const bool after_epi = (t == 0) && (ui > 0);
            PG_LDB(B0, 0, 0); PG_LDB(B1, 0, 1); PG_SCHED; PG_LDA(At, 0, 0); PG_STG(PG_SA(1, 1), a1, vA[1][0], vA[1][1]);
            if (after_epi && Epi::NST >= 16) PG_WAIT_V(24); else if (after_epi && Epi::NST >= 8) PG_WAIT_V(16); else PG_WAIT_V(8);
            PG_WAIT_L(0); PG_BAR; PG_MMA(0, 0, At, B0); PG_MMA(0, 1, At, B1); PG_BAR; PG_SCHED;
            PG_LDA(At, 0, 1); PG_STGB(PG_SB(0, 0), b20); PG_STGB(PG_SB(0, 1), b21); PG_STG(PG_SA(0, 0), a2, wA[0][0], wA[0][1]);
            if (after_epi && Epi::NST >= 16) PG_WAIT_V(24); else if (after_epi && Epi::NST >= 8) PG_WAIT_V(16); else PG_WAIT_V(8);
            PG_WAIT_L(0); PG_BAR; PG_MMA(1, 0, At, B0); PG_MMA(1, 1, At, B1); PG_BAR; PG_SCHED;
            PG_LDB(B0, 1, 0); PG_LDB(B1, 1, 1); PG_SCHED; PG_LDA(At, 1, 0); PG_STG(PG_SA(0, 1), a2, wA[1][0], wA[1][1]);
            PG_WAIT_V(8); PG_WAIT_L(0); PG_BAR; PG_MMA(0, 0, At, B0); PG_MMA(0, 1, At, B1); PG_BAR; PG_SCHED;
            PG_LDA(At, 1, 1); PG_STGB(PG_SB(1, 0), b30); PG_STGB(PG_SB(1, 1), b31); PG_STG(PG_SA(1, 0), a3, wA[0][0], wA[0][1]);
            PG_WAIT_V(8); PG_WAIT_L(0); PG_BAR; PG_MMA(1, 0, At, B0); PG_MMA(1, 1, At, B1); PG_BAR; PG_SCHED;
        }
        if (F8) asm volatile("s_nop 15\n\ts_nop 15" ::: "memory");
        if (wr == 0) PG_BAR;
        E(acc, cur, wr, wc, fr, fq);
        if (!has_next) break;
#pragma unroll
        for (int a = 0; a < 2; ++a)
#pragma unroll
            for (int b = 0; b < 2; ++b)
#pragma unroll
                for (int m = 0; m < 4; ++m)
#pragma unroll
                    for (int n = 0; n < 2; ++n) acc[a][b][m][n] = (f32x4){0.f, 0.f, 0.f, 0.f};
        cur = nxt; cA = nA; cB0 = nB0; cB1 = nB1; ++ui;
        if (GATHER) {
#pragma unroll
            for (int h = 0; h < 2; ++h)
#pragma unroll
                for (int i = 0; i < 2; ++i) vA[h][i] = nvA[h][i];
        }
        if (wr == 1) PG_BAR;
    }
    PG_WAIT_V(0);
    PG_BAR;
#undef PG_SA
#undef PG_SB
#undef PG_STG
#undef PG_STGB
#undef PG_LD16
#undef PG_LDA
#undef PG_LDB
#undef PG_MMA
#undef PG_WAIT_V
#undef PG_WAIT_L
#undef PG_BAR
#undef PG_SCHED
#undef PG_VA
}
}

struct XcdSplit {
    int NU, G, bx;
    __device__ __forceinline__ bool unit(int i, int& u) const {
        if (G & 7) { u = bx + i * G; return u < NU; }
        const int x = bx & 7, li = bx >> 3, per = G >> 3, q = NU >> 3, r = NU & 7;
        const int start = x * q + (x < r ? x : r), len = q + (x < r ? 1 : 0), k = li + i * per;
        if (k >= len) return false;
        u = start + k; return true;
    }
};
__device__ __forceinline__ void dense_pmpn(int idx, int nN, int& pm, int& pn) { const int nig = 8 * nN, gid = idx / nig, rem = idx % nig; pm = gid * 8 + (rem & 7); pn = rem >> 3; }

__device__ __forceinline__ void store8_bf16(bf16* p, const f32x4& a, const f32x4& b) {
    u32x4 w; w.x = pk2(a[0], a[1]); w.y = pk2(a[2], a[3]); w.z = pk2(b[0], b[1]); w.w = pk2(b[2], b[3]); *(u32x4*)p = w;
}
typedef f32x4 acc_t[2][2][4][2];

__device__ __forceinline__ unsigned pk4_fp8(const f32x4& v, float sc) {
    int w = 0;
    w = __builtin_amdgcn_cvt_pk_fp8_f32(__builtin_amdgcn_fmed3f(v[0] * sc, -440.f, 440.f), __builtin_amdgcn_fmed3f(v[1] * sc, -440.f, 440.f), w, false);
    w = __builtin_amdgcn_cvt_pk_fp8_f32(__builtin_amdgcn_fmed3f(v[2] * sc, -440.f, 440.f), __builtin_amdgcn_fmed3f(v[3] * sc, -440.f, 440.f), w, true);
    return (unsigned)w;
}
constexpr float Y_SCALE = 64.0f;
constexpr float W8_SCALE = 32.0f, H8_SCALE = 8.0f;
__device__ __forceinline__ void transpose_item(const float* src, int K, int N, bf16* dst, int item, float* scr, int lane) {
    const int nblk = N / 64, kb = item / nblk, nb = item % nblk, k0 = kb * 64, n0 = nb * 64;
    const int lr = lane >> 4, lc = (lane & 15) * 4;
    f32x4 v[16];
    const float* sp = src + (size_t)(k0 + lr) * N + n0 + lc;
#pragma unroll
    for (int i = 0; i < 16; ++i) v[i] = __builtin_nontemporal_load((const f32x4*)(sp + (size_t)(4 * i) * N));
#pragma unroll
    for (int i = 0; i < 16; ++i) { float* d = scr + (4 * i + lr) * 65 + lc; d[0] = v[i][0]; d[1] = v[i][1]; d[2] = v[i][2]; d[3] = v[i][3]; }
    asm volatile("s_waitcnt lgkmcnt(0)" ::: "memory");
    const int c = lane & 7;
#pragma unroll
    for (int j = 0; j < 8; ++j) {
        const int n = (lane >> 3) + 8 * j; const float* s = scr + (8 * c) * 65 + n;
        u32x4 o; o.x = pk2(s[0], s[65]); o.y = pk2(s[2 * 65], s[3 * 65]); o.z = pk2(s[4 * 65], s[5 * 65]); o.w = pk2(s[6 * 65], s[7 * 65]);
        *(u32x4*)(dst + (size_t)(n0 + n) * K + k0 + 8 * c) = o;
    }
    asm volatile("s_waitcnt lgkmcnt(0)" ::: "memory");
}

__device__ __forceinline__ void transpose_item_f8(const float* src, int K, int N, unsigned char* dst, int item, float* scr, int lane) {
    const int nblk = N / 64, kb = item / nblk, nb = item % nblk, k0 = kb * 64, n0 = nb * 64;
    const int lr = lane >> 4, lc = (lane & 15) * 4;
    f32x4 v[16];
    const float* sp = src + (size_t)(k0 + lr) * N + n0 + lc;
#pragma unroll
    for (int i = 0; i < 16; ++i) v[i] = __builtin_nontemporal_load((const f32x4*)(sp + (size_t)(4 * i) * N));
#pragma unroll
    for (int i = 0; i < 16; ++i) { float* d = scr + (4 * i + lr) * 65 + lc; d[0] = v[i][0]; d[1] = v[i][1]; d[2] = v[i][2]; d[3] = v[i][3]; }
    asm volatile("s_waitcnt lgkmcnt(0)" ::: "memory");
    const int c = lane & 7;
#pragma unroll
    for (int j = 0; j < 8; ++j) {
        const int n = (lane >> 3) + 8 * j; const float* sx = scr + (8 * c) * 65 + n;
        u32x2 o; o.x = pk4_fp8((f32x4){sx[0], sx[65], sx[2 * 65], sx[3 * 65]}, W8_SCALE); o.y = pk4_fp8((f32x4){sx[4 * 65], sx[5 * 65], sx[6 * 65], sx[7 * 65]}, W8_SCALE);
        *(u32x2*)(dst + (size_t)(n0 + n) * K + k0 + 8 * c) = o;
    }
    asm volatile("s_waitcnt lgkmcnt(0)" ::: "memory");
}

constexpr int TR_I_IN = 16 * 28, TR_I_O = 16 * 16, TR_I_S = 16 * 4, TR_I_DS = 4 * 16, TR_I_E = 16 * 4 * NE;
constexpr int TR_NITEMS = TR_I_IN + TR_I_O + 3 * TR_I_S + TR_I_DS + 3 * TR_I_E;
constexpr int FILL_ITEMS = 7168;
__device__ __forceinline__ void transpose_dispatch(const Args& a, int it, float* scr, int lane) {
    unsigned char* ws = a.ws; int r = it;
    if (r < TR_I_IN) { transpose_item(a.in[4], 1024, INC, (bf16*)(ws + WS_WINT), r, scr, lane); return; } r -= TR_I_IN;
    if (r < TR_I_O) { transpose_item(a.in[10], 1024, 1024, (bf16*)(ws + WS_WOT), r, scr, lane); return; } r -= TR_I_O;
    if (r < TR_I_S) { transpose_item(a.in[13], 1024, 256, (bf16*)(ws + WS_WCAT), r, scr, lane); return; } r -= TR_I_S;
    if (r < TR_I_S) { transpose_item(a.in[18], 1024, 256, (bf16*)(ws + WS_WCAT) + 256 * 1024, r, scr, lane); return; } r -= TR_I_S;
    if (r < TR_I_S) { transpose_item(a.in[19], 1024, 256, (bf16*)(ws + WS_WCAT) + 512 * 1024, r, scr, lane); return; } r -= TR_I_S;
    if (r < TR_I_DS) { transpose_item(a.in[20], 256, 1024, (bf16*)(ws + WS_WDST), r, scr, lane); return; } r -= TR_I_DS;
    if (r < TR_I_E) { const int e = r >> 6; transpose_item_f8(a.in[15] + (size_t)e * 262144, 1024, 256, ws + WS_WGT8 + (size_t)e * 262144, r & 63, scr, lane); return; } r -= TR_I_E;
    if (r < TR_I_E) { const int e = r >> 6; transpose_item_f8(a.in[16] + (size_t)e * 262144, 1024, 256, ws + WS_WUT8 + (size_t)e * 262144, r & 63, scr, lane); return; } r -= TR_I_E;
    { const int e = r >> 6; transpose_item_f8(a.in[17] + (size_t)e * 262144, 256, 1024, ws + WS_WDT8 + (size_t)e * 262144, r & 63, scr, lane); }
}
__device__ __forceinline__ void phase_prep(const Args& a, unsigned char* lds, int G) {
    const int tid = threadIdx.x, lane = tid & 63, wid = tid >> 6, bx = blockIdx.x;
    unsigned char* ws = a.ws;
    {
        float* sc = (float*)lds;
        float* red = (float*)(lds + 32768);
        const float* c = a.in[1]; const float* w_ada = a.in[2]; const float* b_ada = a.in[3];
        float* mod = (float*)(ws + WS_MOD);
        for (int cb = bx; cb < 6144 / 32; cb += G) {
            __syncthreads();
            for (int i = tid; i < 8 * 1024; i += NTHREADS) sc[i] = siluf_(c[i]);
            __syncthreads();
            const int kg = tid >> 5, cl = tid & 31, col = cb * 32 + cl;
            float acc[8];
#pragma unroll
            for (int b = 0; b < 8; ++b) acc[b] = 0.f;
            for (int k = kg; k < 1024; k += 16) {
                const float wv = w_ada[(size_t)k * 6144 + col];
#pragma unroll
                for (int b = 0; b < 8; ++b) acc[b] += sc[b * 1024 + k] * wv;
            }
#pragma unroll
            for (int b = 0; b < 8; ++b) red[(kg * 8 + b) * 32 + cl] = acc[b];
            __syncthreads();
            if (tid < 256) {
                const int b = tid >> 5; float s = 0.f;
#pragma unroll
                for (int g = 0; g < 16; ++g) s += red[(g * 8 + b) * 32 + cl];
                mod[b * 6144 + col] = s + b_ada[col];
            }
        }
        __syncthreads();
    }
    {
        float* scr = (float*)(lds + wid * 16640);
        const int gw = bx * NWAVES + wid, NGW = G * NWAVES;
        for (int it = gw; it < TR_NITEMS - 2 * FILL_ITEMS; it += NGW) transpose_dispatch(a, it, scr, lane);
    }
}
__device__ __forceinline__ void transpose_filler(const Args& a, unsigned char* lds, int G, int part) {
    if ((G & 7) || (int)(blockIdx.x >> 3) < (G >> 4)) return;
    __syncthreads();
    const int lane = threadIdx.x & 63, wid = threadIdx.x >> 6;
    float* scr = (float*)(lds + wid * 16640);
    const int nidle = G >> 1, w = ((int)(blockIdx.x & 7) * (G >> 4) + ((int)(blockIdx.x >> 3) - (G >> 4))) * NWAVES + wid;
    const int base = TR_NITEMS - (2 - part) * FILL_ITEMS;
    for (int it = w; it < FILL_ITEMS; it += nidle * NWAVES) transpose_dispatch(a, base + it, scr, lane);
}

__device__ __forceinline__ void phase_hmod(const Args& a, int G) {
    const float* x = a.in[0]; const float* mod = (const float*)(a.ws + WS_MOD); bf16* h = (bf16*)(a.ws + WS_H2);
    const size_t nchunk = (size_t)T * DM / 8;
    for (size_t i = (size_t)blockIdx.x * NTHREADS + threadIdx.x; i < nchunk; i += (size_t)G * NTHREADS) {
        const size_t e0 = i * 8; const int row = (int)(e0 >> 10), col = (int)(e0 & 1023), b = row >> 12;
        const f32x4 v0 = *(const f32x4*)(x + e0), v1 = *(const f32x4*)(x + e0 + 4);
        const float* sh = mod + b * 6144 + col; const float* sc = sh + 1024;
        const f32x4 s0 = *(const f32x4*)sc, s1 = *(const f32x4*)(sc + 4), h0 = *(const f32x4*)sh, h1 = *(const f32x4*)(sh + 4);
        const f32x4 r0 = v0 * (s0 + 1.0f) + h0, r1 = v1 * (s1 + 1.0f) + h1;
        store8_bf16(h + e0, r0, r1);
    }
}

struct SchedProj {
    XcdSplit xs; unsigned A, Bt;
    __device__ __forceinline__ bool next(int i, pg::Unit& u) const {
        int idx; if (!xs.unit(i, idx)) return false; int pm, pn; dense_pmpn(idx, 7, pm, pn);
        u.a = A + (unsigned)pm * 256 * 2048; u.r0 = pm * 256; u.c = pn; u.aux = 0; u.nv = 0;
        if (pn < 3) { u.b0 = Bt + (unsigned)(256 * pn) * 2048; u.b1 = u.b0 + 128 * 2048; }
        else { const int j = pn - 3; u.b0 = Bt + (unsigned)(768 + 128 * j) * 2048; u.b1 = Bt + (unsigned)(1280 + 128 * j) * 2048; }
        return true; }
    __device__ __forceinline__ int row(const pg::Unit&, int) const { return 0; }
};
struct EpiProj {
    static constexpr int NST = 8;
    bf16* O;
    __device__ __forceinline__ void operator()(const acc_t& acc, const pg::Unit& u, int wr, int wc, int fr, int fq) const {
        const int row0 = u.r0 + wr * 64 + fr;
        if (u.c < 3) {
#pragma unroll
            for (int ai = 0; ai < 2; ++ai)
#pragma unroll
                for (int m = 0; m < 4; ++m) { bf16* rowp = O + (size_t)(row0 + ai * 128 + m * 16) * QW + 256 * u.c + wc * 32 + 8 * fq;
#pragma unroll
                    for (int bj = 0; bj < 2; ++bj) store8_bf16(rowp + bj * 128, acc[ai][bj][m][0], acc[ai][bj][m][1]); }
        } else {
            const int j = u.c - 3;
#pragma unroll
            for (int ai = 0; ai < 2; ++ai)
#pragma unroll
                for (int m = 0; m < 4; ++m) { bf16* rowp = O + (size_t)(row0 + ai * 128 + m * 16) * QW + 768 + 128 * j + wc * 32 + 8 * fq;
                    f32x4 r0, r1;
#pragma unroll
                    for (int q = 0; q < 4; ++q) { r0[q] = acc[ai][0][m][0][q] * sigmoidf_(acc[ai][1][m][0][q]); r1[q] = acc[ai][0][m][1][q] * sigmoidf_(acc[ai][1][m][1][q]); }
                    store8_bf16(rowp, r0, r1); }
        }
    }
};
__device__ __forceinline__ void phase_proj(const Args& a, unsigned char* lds, int G) {
    SchedProj S{XcdSplit{(T / 256) * 7, G, (int)blockIdx.x}, (unsigned)WS_H2, (unsigned)WS_WINT};
    EpiProj E{(bf16*)(a.ws + WS_QKVG)};
    pg::gemm_phase<EpiProj, SchedProj, false>((LAS unsigned char*)lds, a.ws, DM * 2, S, E);
    transpose_filler(a, lds, G, 0);
}

constexpr int VT_STRIDE = 280;
__device__ __forceinline__ void attn_unit(const Args& a, unsigned char* lds, int unit) {
    const bf16* QK = (const bf16*)(a.ws + WS_QKVG); bf16* AC = (bf16*)(a.ws + WS_AC);
    const int tid = threadIdx.x, lane = tid & 63, w = __builtin_amdgcn_readfirstlane(tid >> 6), fr = lane & 15, fq = lane >> 4;
    const int kh = unit & 1, nblk = (unit >> 1) & 31, b = unit >> 6;
    const int tok0 = b * SEQ + nblk * 128;
    unsigned char* Kl = lds;
    bf16* Vt = (bf16*)(lds + 272 * 128);
    __syncthreads();
#pragma unroll 1
    for (int idx = tid; idx < 272 * 8; idx += NTHREADS) {
        const int key = idx >> 3, c = idx & 7;
        u32x4 kv = (u32x4){0u, 0u, 0u, 0u}, vv = (u32x4){0u, 0u, 0u, 0u};
        if (key < 256 && (nblk > 0 || key >= 128)) {
            const bf16* rowp = QK + (size_t)(tok0 - 128 + key) * QW + 512 + 64 * kh + 8 * c;
            kv = *(const u32x4*)rowp; vv = *(const u32x4*)(rowp + 128);
        }
        *(u32x4*)(Kl + key * 128 + ((c ^ (key & 7)) * 16)) = kv;
        bf16* vp = Vt + (8 * c) * VT_STRIDE + key;
        vp[0] = (bf16)(vv.x & 0xffffu); vp[VT_STRIDE] = (bf16)(vv.x >> 16);
        vp[2 * VT_STRIDE] = (bf16)(vv.y & 0xffffu); vp[3 * VT_STRIDE] = (bf16)(vv.y >> 16);
        vp[4 * VT_STRIDE] = (bf16)(vv.z & 0xffffu); vp[5 * VT_STRIDE] = (bf16)(vv.z >> 16);
        vp[6 * VT_STRIDE] = (bf16)(vv.w & 0xffffu); vp[7 * VT_STRIDE] = (bf16)(vv.w >> 16);
    }
    __syncthreads();
    const float* sinks = a.in[5];
#pragma unroll 1
    for (int g = 0; g < 4; ++g) {
        const int h = kh * 4 + g;
        int lofs = 0; asm volatile("" : "+v"(lofs));
        const float slope = exp2f(-(float)(h + 1)), sink = sinks[h];
        const bf16* qp = QK + (size_t)(tok0 + 16 * w + fr) * QW + 64 * h + 8 * fq;
        const bf16x8 q0 = *(const bf16x8*)qp, q1 = *(const bf16x8*)(qp + 32);
        f32x4 st[10];
#pragma unroll
        for (int i = 0; i < 10; ++i) {
            const int key = 16 * (w + i) + fr;
            const unsigned char* kp = Kl + key * 128 + lofs;
            const bf16x8 k0 = *(const bf16x8*)(kp + ((fq ^ (fr & 7)) * 16)), k1 = *(const bf16x8*)(kp + (((fq + 4) ^ (fr & 7)) * 16));
            f32x4 s = (f32x4){0.f, 0.f, 0.f, 0.f};
            s = __builtin_amdgcn_mfma_f32_16x16x32_bf16(k0, q0, s, 0, 0, 0);
            s = __builtin_amdgcn_mfma_f32_16x16x32_bf16(k1, q1, s, 0, 0, 0);
            st[i] = s;
        }
        float mx = -INFINITY;
#pragma unroll
        for (int i = 0; i < 10; ++i)
#pragma unroll
            for (int r = 0; r < 4; ++r) {
                const int dist = 128 + fr - 16 * i - 4 * fq - r;
                const int kj = 16 * (w + i) + 4 * fq + r;
                const bool valid = (dist >= 0) && (dist < 128) && (nblk > 0 || kj >= 128);
                const float s = valid ? (st[i][r] * 0.125f - slope * (float)dist) : -INFINITY;
                st[i][r] = s; mx = fmaxf(mx, s);
            }
        mx = fmaxf(mx, __shfl_xor(mx, 16)); mx = fmaxf(mx, __shfl_xor(mx, 32));
        mx = fmaxf(mx, sink);
        float sum = 0.f;
#pragma unroll
        for (int i = 0; i < 10; ++i)
#pragma unroll
            for (int r = 0; r < 4; ++r) { const float p = __expf(st[i][r] - mx); st[i][r] = p; sum += p; }
        sum += __shfl_xor(sum, 16); sum += __shfl_xor(sum, 32);
        const float inv = 1.0f / (sum + __expf(sink - mx));
        f32x4 o[4];
#pragma unroll
        for (int nt = 0; nt < 4; ++nt) o[nt] = (f32x4){0.f, 0.f, 0.f, 0.f};
#pragma unroll
        for (int s5 = 0; s5 < 5; ++s5) {
            u32x4 pw; pw.x = pk2(st[2 * s5][0], st[2 * s5][1]); pw.y = pk2(st[2 * s5][2], st[2 * s5][3]); pw.z = pk2(st[2 * s5 + 1][0], st[2 * s5 + 1][1]); pw.w = pk2(st[2 * s5 + 1][2], st[2 * s5 + 1][3]);
            const bf16x8 pf = __builtin_bit_cast(bf16x8, pw);
#pragma unroll
            for (int nt = 0; nt < 4; ++nt) {
                const bf16* vp = Vt + (16 * nt + fr) * VT_STRIDE + 16 * (w + 2 * s5) + 4 * fq + lofs;
                const u32x2 va = *(const u32x2*)vp, vb = *(const u32x2*)(vp + 16);
                u32x4 vw; vw.x = va.x; vw.y = va.y; vw.z = vb.x; vw.w = vb.y;
                o[nt] = __builtin_amdgcn_mfma_f32_16x16x32_bf16(__builtin_bit_cast(bf16x8, vw), pf, o[nt], 0, 0, 0);
            }
        }
        bf16* op = AC + (size_t)(tok0 + 16 * w + fr) * DM + 64 * h + 4 * fq;
#pragma unroll
        for (int nt = 0; nt < 4; ++nt) { u32x2 ow; ow.x = pk2(o[nt][0] * inv, o[nt][1] * inv); ow.y = pk2(o[nt][2] * inv, o[nt][3] * inv); *(u32x2*)(op + 16 * nt) = ow; }
    }
}

typedef float f32x2c __attribute__((ext_vector_type(2)));
__device__ __forceinline__ void conv_prefetch(const bf16* QK, int unit, int tid, u32x4 (&pf)[8]) {
    const int t0 = unit * 32, b = t0 >> 12, s0 = t0 & 4095;
#pragma unroll
    for (int q = 0; q < 8; ++q) {
        const int idx = tid + q * NTHREADS, i = idx >> 6, ch = idx & 63, sq = s0 - 30 + i;
        pf[q] = (u32x4){0u, 0u, 0u, 0u};
        if (i < 62 && sq >= 0) pf[q] = *(const u32x4*)(QK + (size_t)(b * SEQ + sq) * QW + 768 + 8 * ch);
    }
}
__device__ __forceinline__ void phase_conv(const Args& a, unsigned char* lds, int G) {
    const bf16* QK = (const bf16*)(a.ws + WS_QKVG); bf16* AC = (bf16*)(a.ws + WS_AC);
    const int tid = threadIdx.x, lane = tid & 63, wid = tid >> 6, c = tid;
    bf16* inp = (bf16*)lds;
    float* yb = (float*)(lds + 62 * CW * 2);
    const float* cw = a.in[6];
    f32x2c W2[32];
#pragma unroll
    for (int idx = 0; idx < 32; ++idx) {
        const float lo = (idx >= 1) ? cw[(31 - idx) * CW + c] : 0.f;
        const float hi = (idx <= 30) ? cw[(30 - idx) * CW + c] : 0.f;
        W2[idx] = (f32x2c){lo, hi};
    }
    const float bias = a.in[7][c];
    const float* lg = a.in[8]; const float* lb = a.in[9];
    const f32x4 g0 = *(const f32x4*)(lg + 8 * lane), g1 = *(const f32x4*)(lg + 8 * lane + 4), b0 = *(const f32x4*)(lb + 8 * lane), b1 = *(const f32x4*)(lb + 8 * lane + 4);
    u32x4 pf[8];
    int unit = blockIdx.x;
    if (unit < T / 32) conv_prefetch(QK, unit, tid, pf);
    for (; unit < T / 32; unit += G) {
        const int t0 = unit * 32;
        __syncthreads();
#pragma unroll
        for (int q = 0; q < 8; ++q) { const int idx = tid + q * NTHREADS, i = idx >> 6, ch = idx & 63; if (i < 62) *(u32x4*)(inp + i * CW + 8 * ch) = pf[q]; }
        __syncthreads();
        if (unit + G < T / 32) conv_prefetch(QK, unit + G, tid, pf);
        f32x2c acc[16];
#pragma unroll
        for (int tp = 0; tp < 16; ++tp) acc[tp] = (f32x2c){bias, bias};
#pragma unroll
        for (int i = 0; i < 62; ++i) {
            const float v = bf2f(inp[i * CW + c]); const f32x2c v2 = (f32x2c){v, v};
#pragma unroll
            for (int tp = 0; tp < 16; ++tp) { const int idx = 31 - i + 2 * tp;
                if (idx >= 0 && idx <= 31) acc[tp] = __builtin_elementwise_fma(v2, W2[idx], acc[tp]); }
        }
#pragma unroll
        for (int tp = 0; tp < 16; ++tp) { yb[(2 * tp) * CW + c] = acc[tp].x; yb[(2 * tp + 1) * CW + c] = acc[tp].y; }
        __syncthreads();
#pragma unroll
        for (int q = 0; q < 4; ++q) {
            const int t = wid * 4 + q;
            f32x4 v0 = *(const f32x4*)(yb + t * CW + 8 * lane), v1 = *(const f32x4*)(yb + t * CW + 8 * lane + 4);
            const float mean = wave_sum((v0[0] + v0[1]) + (v0[2] + v0[3]) + (v1[0] + v1[1]) + (v1[2] + v1[3])) * (1.0f / CW);
            v0 = v0 - mean; v1 = v1 - mean;
            const float var = wave_sum((v0[0] * v0[0] + v0[1] * v0[1]) + (v0[2] * v0[2] + v0[3] * v0[3]) + (v1[0] * v1[0] + v1[1] * v1[1]) + (v1[2] * v1[2] + v1[3] * v1[3])) * (1.0f / CW);
            const float rstd = rsqrtf(var + LN_EPS);
            f32x4 r0 = v0 * rstd * g0 + b0, r1 = v1 * rstd * g1 + b1;
#pragma unroll
            for (int e = 0; e < 4; ++e) { r0[e] = siluf_(r0[e]); r1[e] = siluf_(r1[e]); }
            store8_bf16(AC + (size_t)(t0 + t) * DM + 512 + 8 * lane, r0, r1);
        }
    }
}

__device__ __forceinline__ void phase_mixer(const Args& a, unsigned char* lds, int G) {
    if (!(a.flags & 2)) for (int u = blockIdx.x; u < NB * 32 * NKVH; u += G) attn_unit(a, lds, u);
    if (!(a.flags & 4)) phase_conv(a, lds, G);
}

struct SchedWo {
    XcdSplit xs; unsigned A, Bt;
    __device__ __forceinline__ bool next(int i, pg::Unit& u) const {
        int idx; if (!xs.unit(i, idx)) return false; int pm, pn; dense_pmpn(idx, 4, pm, pn);
        u.a = A + (unsigned)pm * 256 * 2048; u.r0 = pm * 256; u.c = pn; u.aux = 0; u.nv = 0;
        u.b0 = Bt + (unsigned)(256 * pn) * 2048; u.b1 = u.b0 + 128 * 2048; return true; }
    __device__ __forceinline__ int row(const pg::Unit&, int) const { return 0; }
};
struct EpiWo {
    static constexpr int NST = 16;
    const float* mod; bf16* mix;
    __device__ __forceinline__ void operator()(const acc_t& acc, const pg::Unit& u, int wr, int wc, int fr, int fq) const {
        const int row0 = u.r0 + wr * 64 + fr, bb = u.r0 >> 12, col0 = 256 * u.c + wc * 32 + 8 * fq;
        f32x4 g[2][2];
#pragma unroll
        for (int bj = 0; bj < 2; ++bj)
#pragma unroll
            for (int n = 0; n < 2; ++n) g[bj][n] = *(const f32x4*)(mod + bb * 6144 + 2048 + col0 + 128 * bj + 4 * n) + 1.0f;
#pragma unroll
        for (int ai = 0; ai < 2; ++ai)
#pragma unroll
            for (int m = 0; m < 4; ++m) { bf16* rowp = mix + (size_t)(row0 + ai * 128 + m * 16) * DM + col0;
#pragma unroll
                for (int bj = 0; bj < 2; ++bj) store8_bf16(rowp + 128 * bj, g[bj][0] * acc[ai][bj][m][0], g[bj][1] * acc[ai][bj][m][1]); }
    }
};
__device__ __forceinline__ void phase_wo(const Args& a, unsigned char* lds, int G) {
    SchedWo S{XcdSplit{(T / 256) * 4, G, (int)blockIdx.x}, (unsigned)WS_AC, (unsigned)WS_WOT};
    EpiWo E{(const float*)(a.ws + WS_MOD), (bf16*)(a.ws + WS_MIX)};
    pg::gemm_phase<EpiWo, SchedWo, false>((LAS unsigned char*)lds, a.ws, DM * 2, S, E);
}

__device__ __forceinline__ void phase_ln1(const Args& a, int G) {
    const float* mod = (const float*)(a.ws + WS_MOD); const float* x = a.in[0]; const bf16* mix = (const bf16*)(a.ws + WS_MIX);
    bf16* x1b = (bf16*)(a.ws + WS_X1B); bf16* h2 = (bf16*)(a.ws + WS_H2); unsigned char* h2q = a.ws + WS_H2Q;
    const float* lg = a.in[11]; const float* lb = a.in[12];
    const int lane = threadIdx.x & 63, wid = threadIdx.x >> 6, n0 = 16 * lane;
    f32x4 g4[4], b4[4];
#pragma unroll
    for (int q = 0; q < 4; ++q) { g4[q] = *(const f32x4*)(lg + n0 + 4 * q); b4[q] = *(const f32x4*)(lb + n0 + 4 * q); }
    for (int m = blockIdx.x * NWAVES + wid; m < T; m += G * NWAVES) {
        const int bb = m >> 12; const float* xr = x + (size_t)m * DM + n0;
        const u32x4 ma = *(const u32x4*)(mix + (size_t)m * DM + n0), mb = *(const u32x4*)(mix + (size_t)m * DM + n0 + 8);
        f32x4 v[4]; float s = 0.f;
#pragma unroll
        for (int q = 0; q < 4; ++q) { const unsigned w0 = (q < 2) ? ma[2 * q] : mb[2 * q - 4], w1 = (q < 2) ? ma[2 * q + 1] : mb[2 * q - 3];
            v[q] = *(const f32x4*)(xr + 4 * q) * ALPHA + (f32x4){bflo(w0), bfhi(w0), bflo(w1), bfhi(w1)}; s += (v[q][0] + v[q][1]) + (v[q][2] + v[q][3]); }
        const float mean = wave_sum(s) * (1.0f / DM); float s2 = 0.f;
#pragma unroll
        for (int q = 0; q < 4; ++q) { v[q] = v[q] - mean; s2 += (v[q][0] * v[q][0] + v[q][1] * v[q][1]) + (v[q][2] * v[q][2] + v[q][3] * v[q][3]); }
        const float rstd = rsqrtf(wave_sum(s2) * (1.0f / DM) + LN_EPS);
        u32x4 xo[2], ho[2], qo;
#pragma unroll
        for (int q = 0; q < 4; ++q) {
            const f32x4 x1 = v[q] * rstd * g4[q] + b4[q];
            const f32x4 hh = x1 * (*(const f32x4*)(mod + bb * 6144 + 4096 + n0 + 4 * q) + 1.0f) + *(const f32x4*)(mod + bb * 6144 + 3072 + n0 + 4 * q);
            xo[q >> 1][2 * (q & 1)] = pk2(x1[0], x1[1]); xo[q >> 1][2 * (q & 1) + 1] = pk2(x1[2], x1[3]);
            ho[q >> 1][2 * (q & 1)] = pk2(hh[0], hh[1]); ho[q >> 1][2 * (q & 1) + 1] = pk2(hh[2], hh[3]);
            qo[q] = pk4_fp8(hh, 1.0f);
        }
        *(u32x4*)(x1b + (size_t)m * DM + n0) = xo[0]; *(u32x4*)(x1b + (size_t)m * DM + n0 + 8) = xo[1];
        *(u32x4*)(h2 + (size_t)m * DM + n0) = ho[0]; *(u32x4*)(h2 + (size_t)m * DM + n0 + 8) = ho[1];
        *(u32x4*)(h2q + (size_t)m * DM + n0) = qo;
    }
}

struct SchedRs {
    XcdSplit xs; unsigned A, Bt;
    __device__ __forceinline__ bool next(int i, pg::Unit& u) const {
        int idx; if (!xs.unit(i, idx)) return false; int pm, pn; dense_pmpn(idx, 3, pm, pn);
        u.a = A + (unsigned)pm * 256 * 2048; u.r0 = pm * 256; u.c = pn; u.aux = 0; u.nv = 0;
        if (pn == 0) { u.b0 = Bt; u.b1 = Bt + 128 * 2048; }
        else { const int j = pn - 1; u.b0 = Bt + (unsigned)(256 + 128 * j) * 2048; u.b1 = Bt + (unsigned)(512 + 128 * j) * 2048; }
        return true; }
    __device__ __forceinline__ int row(const pg::Unit&, int) const { return 0; }
};
struct EpiRs {
    static constexpr int NST = 8;
    float* logits; bf16* hs;
    __device__ __forceinline__ void operator()(const acc_t& acc, const pg::Unit& u, int wr, int wc, int fr, int fq) const {
        const int row0 = u.r0 + wr * 64 + fr;
        if (u.c == 0) {
#pragma unroll
            for (int ai = 0; ai < 2; ++ai)
#pragma unroll
                for (int m = 0; m < 4; ++m) { float* rowp = logits + (size_t)(row0 + ai * 128 + m * 16) * NE + wc * 32 + 8 * fq;
#pragma unroll
                    for (int bj = 0; bj < 2; ++bj) { *(f32x4*)(rowp + 128 * bj) = acc[ai][bj][m][0]; *(f32x4*)(rowp + 128 * bj + 4) = acc[ai][bj][m][1]; } }
        } else {
            const int j = u.c - 1;
#pragma unroll
            for (int ai = 0; ai < 2; ++ai)
#pragma unroll
                for (int m = 0; m < 4; ++m) { bf16* rowp = hs + (size_t)(row0 + ai * 128 + m * 16) * FE + 128 * j + wc * 32 + 8 * fq;
                    f32x4 r0, r1;
#pragma unroll
                    for (int q = 0; q < 4; ++q) { r0[q] = siluf_(acc[ai][0][m][0][q]) * acc[ai][1][m][0][q]; r1[q] = siluf_(acc[ai][0][m][1][q]) * acc[ai][1][m][1][q]; }
                    store8_bf16(rowp, r0, r1); }
        }
    }
};
__device__ __forceinline__ void phase_rs(const Args& a, unsigned char* lds, int G) {
    SchedRs S{XcdSplit{(T / 256) * 3, G, (int)blockIdx.x}, (unsigned)WS_H2, (unsigned)WS_WCAT};
    EpiRs E{(float*)(a.ws + WS_LOG), (bf16*)(a.ws + WS_HS)};
    pg::gemm_phase<EpiRs, SchedRs, false>((LAS unsigned char*)lds, a.ws, DM * 2, S, E);
    transpose_filler(a, lds, G, 1);
}

#define DPPF(v, ctrl) __int_as_float(__builtin_amdgcn_update_dpp(0, __float_as_int(v), (ctrl), 0xf, 0xf, true))
__device__ __forceinline__ float wave_max_dpp(float v) {
    v = fmaxf(v, DPPF(v, 0xB1)); v = fmaxf(v, DPPF(v, 0x4E)); v = fmaxf(v, DPPF(v, 0x141)); v = fmaxf(v, DPPF(v, 0x140));
    const float r0 = __int_as_float(__builtin_amdgcn_readlane(__float_as_int(v), 0)), r1 = __int_as_float(__builtin_amdgcn_readlane(__float_as_int(v), 16));
    const float r2 = __int_as_float(__builtin_amdgcn_readlane(__float_as_int(v), 32)), r3 = __int_as_float(__builtin_amdgcn_readlane(__float_as_int(v), 48));
    return fmaxf(fmaxf(r0, r1), fmaxf(r2, r3));
}
__device__ __forceinline__ void phase_route(const Args& a, unsigned char* lds, int G) {
    const float* logits = (const float*)(a.ws + WS_LOG); const float* rbias = a.in[14];
    int* gcount = (int*)(a.ws + WS_GCNT); int* rdst = (int*)(a.ws + WS_RDST); float* ew = (float*)(a.ws + WS_EW); int* rer = (int*)(a.ws + WS_RER);
    const int tid = threadIdx.x, lane = tid & 63, wid = tid >> 6;
    int* hist = (int*)lds; int* base = hist + 256; int* pe = hist + 512; float* pw = (float*)(hist + 512 + 2048);
    __syncthreads();
    if (tid < NE) hist[tid] = 0;
    __syncthreads();
    const int chunk = (T + G - 1) / G, tbeg = blockIdx.x * chunk, tend = min(T, tbeg + chunk);
    const f32x4 bv = *(const f32x4*)(rbias + 4 * lane);
    for (int t = tbeg + wid; t < tend; t += NWAVES) {
        const f32x4 lg = *(const f32x4*)(logits + (size_t)t * NE + 4 * lane);
        float sc[4], v[4];
#pragma unroll
        for (int i = 0; i < 4; ++i) { sc[i] = sigmoidf_ref(lg[i]); v[i] = sc[i] + bv[i]; }
        float a1 = fmaxf(v[0], v[1]), a2 = fminf(v[0], v[1]);
        { const float c1 = fmaxf(v[2], v[3]), c2 = fminf(v[2], v[3]); const float n1 = fmaxf(a1, c1), n2 = fmaxf(fminf(a1, c1), fmaxf(a2, c2)); a1 = n1; a2 = n2; }
        { const float c1 = DPPF(a1, 0xB1), c2 = DPPF(a2, 0xB1); const float n1 = fmaxf(a1, c1), n2 = fmaxf(fminf(a1, c1), fmaxf(a2, c2)); a1 = n1; a2 = n2; }
        { const float c1 = DPPF(a1, 0x4E), c2 = DPPF(a2, 0x4E); const float n1 = fmaxf(a1, c1), n2 = fmaxf(fminf(a1, c1), fmaxf(a2, c2)); a1 = n1; a2 = n2; }
        { const float c1 = DPPF(a1, 0x141), c2 = DPPF(a2, 0x141); const float n1 = fmaxf(a1, c1), n2 = fmaxf(fminf(a1, c1), fmaxf(a2, c2)); a1 = n1; a2 = n2; }
        const float gs = a1 + a2; const int mg = lane >> 3; int rank = 0;
#pragma unroll
        for (int g = 0; g < 8; ++g) { const float o = __int_as_float(__builtin_amdgcn_readlane(__float_as_int(gs), 8 * g)); rank += (o > gs || (o == gs && g < mg)) ? 1 : 0; }
        if (rank >= 4) { v[0] = -INFINITY; v[1] = -INFINITY; v[2] = -INFINITY; v[3] = -INFINITY; }
        int my_e = 0; float my_w = 0.f, wsum = 0.f;
#pragma unroll
        for (int r = 0; r < TOPK; ++r) {
            const float m = fmaxf(fmaxf(v[0], v[1]), fmaxf(v[2], v[3]));
            const float M = wave_max_dpp(m);
            const unsigned long long mask = __ballot(m == M);
            const int L = __builtin_amdgcn_readfirstlane((int)__builtin_ctzll(mask));
            const int li = (v[0] == M) ? 0 : (v[1] == M) ? 1 : (v[2] == M) ? 2 : 3;
            const float ls = (li == 0) ? sc[0] : (li == 1) ? sc[1] : (li == 2) ? sc[2] : sc[3];
            const int wi = __builtin_amdgcn_readlane(li, L);
            const float wv = __int_as_float(__builtin_amdgcn_readlane(__float_as_int(ls), L));
            if (lane == L) { if (li == 0) v[0] = -INFINITY; else if (li == 1) v[1] = -INFINITY; else if (li == 2) v[2] = -INFINITY; else v[3] = -INFINITY; }
            wsum += wv;
            if (lane == r) { my_e = 4 * L + wi; my_w = wv; }
        }
        if (lane < TOPK) {
            const int p = (t - tbeg) * TOPK + lane;
            pe[p] = my_e; pw[p] = my_w / wsum * 2.5f;
            atomicAdd(&hist[my_e], 1);
        }
    }
    __syncthreads();
    if (tid < NE) { const int h = hist[tid]; base[tid] = h ? __hip_atomic_fetch_add(&gcount[tid], h, __ATOMIC_RELAXED, __HIP_MEMORY_SCOPE_AGENT) : 0; hist[tid] = 0; }
    __syncthreads();
    const int np = (tend - tbeg) * TOPK;
    for (int i = tid; i < np; i += NTHREADS) {
        const int e = pe[i];
        const int r = base[e] + atomicAdd(&hist[e], 1);
        rdst[(size_t)e * RCAP + r] = tbeg * TOPK + i; ew[tbeg * TOPK + i] = pw[i]; rer[tbeg * TOPK + i] = (e << 16) | r;
    }
}

__device__ __forceinline__ int moe_prefix(const int* gcount, int* pref, int* scr) {
    const int tid = threadIdx.x;
    __syncthreads();
    int nt_e = 0;
    if (tid < NE) { nt_e = (gcount[tid] + 255) >> 8; scr[tid] = nt_e; }
    __syncthreads();
    int cur = 0;
    for (int o = 1; o < NE; o <<= 1) {
        if (tid < NE) scr[(cur ^ 1) * 256 + tid] = scr[cur * 256 + tid] + ((tid >= o) ? scr[cur * 256 + tid - o] : 0);
        cur ^= 1;
        __syncthreads();
    }
    if (tid < NE) { const int incl = scr[cur * 256 + tid]; pref[tid] = incl - nt_e; if (tid == NE - 1) pref[NE] = incl; }
    __syncthreads();
    return pref[NE];
}
__device__ __forceinline__ int moe_tile_expert(const int* pref, int tile) {
    int lo = 0, hi = NE - 1;
    while (lo < hi) { const int mid = (lo + hi + 1) >> 1; if (pref[mid] <= tile) lo = mid; else hi = mid - 1; }
    return lo;
}

constexpr int LIST_OFF = pg::PG_STAGE_BYTES, MAX_LISTS = 12, PREF_OFF = LIST_OFF + MAX_LISTS * 1024, DESC_OFF = PREF_OFF + 1040, MAX_DESC = 48;
struct SchedMoe1 {
    XcdSplit xs; unsigned A, Wg, Wu; const int* desc; const int* lists;
    __device__ __forceinline__ bool next(int i, pg::Unit& u) const {
        int idx; if (!xs.unit(i, idx)) return false; const int e = __builtin_amdgcn_readfirstlane(desc[2 * i]), tile = idx >> 1, j = idx & 1;
        u.a = A; u.r0 = tile * 256; u.c = j; u.aux = i; u.nv = 0;
        u.b0 = Wg + (unsigned)(e * 256 + 128 * j) * 1024; u.b1 = Wu + (unsigned)(e * 256 + 128 * j) * 1024; return true; }
    __device__ __forceinline__ int row(const pg::Unit& u, int r) const { return lists[u.aux * 256 + r]; }
};
struct EpiMoe1 {
    static constexpr int NST = 8;
    unsigned char* H8;
    __device__ __forceinline__ void operator()(const acc_t& acc, const pg::Unit& u, int wr, int wc, int fr, int fq) const {
        const int row0 = u.r0 + wr * 64 + fr;
#pragma unroll
        for (int ai = 0; ai < 2; ++ai)
#pragma unroll
            for (int m = 0; m < 4; ++m) { unsigned char* rowp = H8 + (size_t)(row0 + ai * 128 + m * 16) * FE + 128 * u.c + wc * 32 + 8 * fq;
                f32x4 r0, r1;
#pragma unroll
                for (int q = 0; q < 4; ++q) { r0[q] = siluf_(acc[ai][0][m][0][q]) * acc[ai][1][m][0][q]; r1[q] = siluf_(acc[ai][0][m][1][q]) * acc[ai][1][m][1][q]; }
                u32x2 o; o.x = pk4_fp8(r0, H8_SCALE); o.y = pk4_fp8(r1, H8_SCALE); *(u32x2*)rowp = o; }
    }
};
__device__ __forceinline__ void phase_moe1(const Args& a, unsigned char* lds, int G) {
    const int* gcount = (const int*)(a.ws + WS_GCNT); const int* rdst = (const int*)(a.ws + WS_RDST);
    int* lists = (int*)(lds + LIST_OFF); int* pref = (int*)(lds + PREF_OFF); int* desc = (int*)(lds + DESC_OFF);
    const int ntiles = moe_prefix(gcount, pref, (int*)lds);
    XcdSplit xs{ntiles * 2, G, (int)blockIdx.x};
    for (int i = 0; i < MAX_LISTS; ++i) {
        int idx; if (!xs.unit(i, idx)) break;
        const int tile = idx >> 1, e = moe_tile_expert(pref, tile), tin = tile - pref[e], cnt = gcount[e];
        if (threadIdx.x < 256) { const int pos = tin * 256 + (int)threadIdx.x; lists[i * 256 + threadIdx.x] = (pos < cnt) ? (rdst[(size_t)e * RCAP + pos] >> 3) : 0; }
        if (threadIdx.x == 0) { desc[2 * i] = e; desc[2 * i + 1] = tin; }
    }
    __syncthreads();
    SchedMoe1 S{xs, (unsigned)WS_H2Q, (unsigned)WS_WGT8, (unsigned)WS_WUT8, desc, lists};
    EpiMoe1 E{a.ws + WS_H8};
    pg::gemm_phase<EpiMoe1, SchedMoe1, true, 0, true, 122, 127>((LAS unsigned char*)lds, a.ws, DM, S, E);
}

struct SchedMoe2 {
    XcdSplit xs; unsigned Hb, Wd; const int* desc;
    __device__ __forceinline__ bool next(int i, pg::Unit& u) const {
        int idx; if (!xs.unit(i, idx)) return false;
        const int tile = idx >> 2, jn = idx & 3, e = __builtin_amdgcn_readfirstlane(desc[2 * i]), nv = __builtin_amdgcn_readfirstlane(desc[2 * i + 1]);
        u.a = Hb + (unsigned)tile * 256 * 256; u.r0 = tile * 256; u.c = jn; u.aux = e; u.nv = nv;
        u.b0 = Wd + (unsigned)(e * 1024 + 256 * jn) * 256; u.b1 = u.b0 + 8 * 256;
        return true; }
    __device__ __forceinline__ int row(const pg::Unit&, int) const { return 0; }
};
struct SchedSd {
    XcdSplit xs; unsigned hs, Wds;
    __device__ __forceinline__ bool next(int i, pg::Unit& u) const {
        int idx; if (!xs.unit(i, idx)) return false; int pm, pn; dense_pmpn(idx, 4, pm, pn);
        u.a = hs + (unsigned)pm * 256 * 512; u.r0 = pm * 256; u.c = pn; u.aux = -1; u.nv = 0;
        u.b0 = Wds + (unsigned)(256 * pn) * 512; u.b1 = u.b0 + 8 * 512;
        return true; }
    __device__ __forceinline__ int row(const pg::Unit&, int) const { return 0; }
};
struct EpiMoe2 {
    static constexpr int NST = 8;
    unsigned char* Y; bf16* SD; int flags;
    __device__ __forceinline__ void operator()(const acc_t& acc, const pg::Unit& u, int wr, int wc, int fr, int fq) const {
        const int col0 = 256 * u.c + wc * 64 + 16 * fq, row0 = u.r0 + wr * 64 + fr;
        if (u.aux >= 0) {
#pragma unroll
            for (int ai = 0; ai < 2; ++ai)
#pragma unroll
                for (int m = 0; m < 4; ++m) {
                    u32x4 o; o.x = pk4_fp8(acc[ai][0][m][0], Y_SCALE); o.y = pk4_fp8(acc[ai][0][m][1], Y_SCALE); o.z = pk4_fp8(acc[ai][1][m][0], Y_SCALE); o.w = pk4_fp8(acc[ai][1][m][1], Y_SCALE);
                    if (!(flags & 1)) *(u32x4*)(Y + (size_t)(row0 + ai * 128 + m * 16) * DM + col0) = o; }
        } else {
#pragma unroll
            for (int ai = 0; ai < 2; ++ai)
#pragma unroll
                for (int m = 0; m < 4; ++m) { bf16* rowp = SD + (size_t)(row0 + ai * 128 + m * 16) * DM + col0;
#pragma unroll
                    for (int bj = 0; bj < 2; ++bj) store8_bf16(rowp + 8 * bj, acc[ai][bj][m][0], acc[ai][bj][m][1]); }
        }
    }
};
__device__ __forceinline__ void phase_moe2(const Args& a, unsigned char* lds, int G) {
    const int* gcount = (const int*)(a.ws + WS_GCNT);
    int* pref = (int*)(lds + PREF_OFF); int* desc = (int*)(lds + DESC_OFF);
    const int ntiles = moe_prefix(gcount, pref, (int*)lds);
    const int NU2 = ntiles * 4;
    XcdSplit xs{NU2, G, (int)blockIdx.x};
    if (threadIdx.x == 0) {
        for (int i = 0; i < MAX_DESC; ++i) { int idx; if (!xs.unit(i, idx)) break;
            const int e = moe_tile_expert(pref, idx >> 2); desc[2 * i] = e; desc[2 * i + 1] = gcount[e]; }
    }
    __syncthreads();
    EpiMoe2 E{(unsigned char*)(a.ws + WS_Y), (bf16*)(a.ws + WS_SD), a.flags};
    { SchedMoe2 S{xs, (unsigned)WS_H8, (unsigned)WS_WDT8, desc};
      pg::gemm_phase<EpiMoe2, SchedMoe2, false, 1, true, 122, 124>((LAS unsigned char*)lds, a.ws, FE, S, E); }
    { SchedSd S{XcdSplit{(T / 256) * 4, G, (int)blockIdx.x}, (unsigned)WS_HS, (unsigned)WS_WDST};
      pg::gemm_phase<EpiMoe2, SchedSd, false, 1>((LAS unsigned char*)lds, a.ws, FE * 2, S, E); }
}

__device__ __forceinline__ void phase_final(const Args& a, unsigned char* lds, int G) {
    const float* mod = (const float*)(a.ws + WS_MOD); float* out = a.out;
    const bf16* SD = (const bf16*)(a.ws + WS_SD); const unsigned char* Y = (const unsigned char*)(a.ws + WS_Y); const bf16* x1b = (const bf16*)(a.ws + WS_X1B);
    const int* rer = (const int*)(a.ws + WS_RER); const float* ew = (const float*)(a.ws + WS_EW);
    const float* lg = a.in[21]; const float* lb = a.in[22];
    int* pref = (int*)(lds + PREF_OFF);
    (void)moe_prefix((const int*)(a.ws + WS_GCNT), pref, (int*)lds);
    const int lane = threadIdx.x & 63, wid = threadIdx.x >> 6, n0 = 16 * lane;
    const int m0 = blockIdx.x * NWAVES + wid, mstep = G * NWAVES;
    int nq = 0; float nw = 0.f;
    if (lane < TOPK && m0 < T) { nq = rer[(size_t)m0 * TOPK + lane]; nw = ew[(size_t)m0 * TOPK + lane]; }
    for (int m = m0; m < T; m += mstep) {
        const int bb = m >> 12; float* rowp = out + (size_t)m * DM + n0;
        const int myrow = pref[nq >> 16] * 256 + (nq & 0xffff); const float myw = nw * (1.0f / Y_SCALE);
        if (lane < TOPK && m + mstep < T) { nq = rer[(size_t)(m + mstep) * TOPK + lane]; nw = ew[(size_t)(m + mstep) * TOPK + lane]; }
        u32x4 yw[TOPK]; float wk[TOPK];
#pragma unroll
        for (int k = 0; k < TOPK; ++k) { const int r = __builtin_amdgcn_readlane(myrow, k); wk[k] = __int_as_float(__builtin_amdgcn_readlane(__float_as_int(myw), k)); yw[k] = *(const u32x4*)(Y + (size_t)r * DM + n0); }
        const u32x4 sa = *(const u32x4*)(SD + (size_t)m * DM + n0), sb = *(const u32x4*)(SD + (size_t)m * DM + n0 + 8);
        const u32x4 xa = *(const u32x4*)(x1b + (size_t)m * DM + n0), xb = *(const u32x4*)(x1b + (size_t)m * DM + n0 + 8);
        f32x4 f[4];
#pragma unroll
        for (int q = 0; q < 4; ++q) f[q] = (f32x4){0.f, 0.f, 0.f, 0.f};
#pragma unroll
        for (int k = 0; k < TOPK; ++k)
#pragma unroll
            for (int q = 0; q < 4; ++q) { const int w = (int)yw[k][q]; const f32x2v lo = __builtin_amdgcn_cvt_pk_f32_fp8(w, false), hi = __builtin_amdgcn_cvt_pk_f32_fp8(w, true);
                f[q][0] += wk[k] * lo.x; f[q][1] += wk[k] * lo.y; f[q][2] += wk[k] * hi.x; f[q][3] += wk[k] * hi.y; }
        f32x4 v[4]; float s = 0.f;
#pragma unroll
        for (int q = 0; q < 4; ++q) {
            const unsigned s0 = (q < 2) ? sa[2 * q] : sb[2 * q - 4], s1 = (q < 2) ? sa[2 * q + 1] : sb[2 * q - 3];
            const unsigned x0 = (q < 2) ? xa[2 * q] : xb[2 * q - 4], x1w = (q < 2) ? xa[2 * q + 1] : xb[2 * q - 3];
            const f32x4 ffn = f[q] + (f32x4){bflo(s0), bfhi(s0), bflo(s1), bfhi(s1)};
            const f32x4 x1 = (f32x4){bflo(x0), bfhi(x0), bflo(x1w), bfhi(x1w)};
            v[q] = x1 * ALPHA + (*(const f32x4*)(mod + bb * 6144 + 5120 + n0 + 4 * q) + 1.0f) * ffn;
            s += (v[q][0] + v[q][1]) + (v[q][2] + v[q][3]);
        }
        const float mean = wave_sum(s) * (1.0f / DM); float s2 = 0.f;
#pragma unroll
        for (int q = 0; q < 4; ++q) { v[q] = v[q] - mean; s2 += (v[q][0] * v[q][0] + v[q][1] * v[q][1]) + (v[q][2] * v[q][2] + v[q][3] * v[q][3]); }
        const float rstd = rsqrtf(wave_sum(s2) * (1.0f / DM) + LN_EPS);
#pragma unroll
        for (int q = 0; q < 4; ++q) *(f32x4*)(rowp + 4 * q) = v[q] * rstd * *(const f32x4*)(lg + n0 + 4 * q) + *(const f32x4*)(lb + n0 + 4 * q);
    }
}

constexpr int NPHASES = 11;
__global__ void __launch_bounds__(NTHREADS, 2) fwd_kernel(Args a) {
    extern __shared__ __attribute__((aligned(16))) unsigned char lds[];
    const int G = gridDim.x;
    volatile LAS unsigned* misc = (volatile LAS unsigned*)(LAS unsigned char*)(lds + LDS_BYTES - 64);
    if (threadIdx.x < 16) misc[threadIdx.x] = 0u;
    __syncthreads();
    XcdBarrier bar; bar.bar = (unsigned*)(a.ws + WS_CTL); bar.x = 0; bar.st = nullptr;
    const bool multi = (a.ph_hi - a.ph_lo) > 1;
    if (multi) bar = xcd_barrier_post((unsigned*)(a.ws + WS_CTL), misc);
#define IN(k) (a.ph_lo <= (k) && (k) < a.ph_hi)
#define SEAM(k) do { if (IN(k) && IN((k) + 1)) xcd_barrier(bar); } while (0)
#ifndef REPEAT_MASK
#define REPEAT_MASK 0
#endif
#define REP(k, call) do { if (IN(k)) { call; if ((REPEAT_MASK >> (k)) & 1) { xcd_barrier(bar); Args a2 = a; a2.flags = PROBE_FLAGS; { const Args& a = a2; call; } } } } while (0)
#ifndef PROBE_FLAGS
#define PROBE_FLAGS 0
#endif
    REP(0, phase_prep(a, lds, G));
    SEAM(0);
    REP(1, phase_hmod(a, G));
    SEAM(1);
    REP(2, phase_proj(a, lds, G));
    SEAM(2);
    REP(3, phase_mixer(a, lds, G));
    SEAM(3);
    REP(4, phase_wo(a, lds, G));
    SEAM(4);
    REP(5, phase_ln1(a, G));
    SEAM(5);
    REP(6, phase_rs(a, lds, G));
    SEAM(6);
    REP(7, phase_route(a, lds, G));
    SEAM(7);
    REP(8, phase_moe1(a, lds, G));
    SEAM(8);
    REP(9, phase_moe2(a, lds, G));
    SEAM(9);
    REP(10, phase_final(a, lds, G));
#undef IN
#undef SEAM
}

extern "C" void kernel_launch(void* const* d_in, const int* in_sizes, int n_in, void* d_out, int out_size, void* d_ws, size_t ws_size, hipStream_t stream) {
    static int grid = 0;
    if (grid == 0) {
        if (n_in != 23 || out_size != T * DM || ws_size < WS_END) { fprintf(stderr, "kernel_launch: unexpected shapes (n_in %d out %d ws %zu)\n", n_in, out_size, ws_size); grid = -1; return; }
        int dev = 0, cus = 0;
        if (hipGetDevice(&dev) != hipSuccess || hipDeviceGetAttribute(&cus, hipDeviceAttributeMultiprocessorCount, dev) != hipSuccess) { grid = -1; return; }
        if (hipFuncSetAttribute((const void*)fwd_kernel, hipFuncAttributeMaxDynamicSharedMemorySize, LDS_BYTES) != hipSuccess) { fprintf(stderr, "kernel_launch: hipFuncSetAttribute failed\n"); grid = -1; return; }
        int per_cu = 0;
        (void)hipOccupancyMaxActiveBlocksPerMultiprocessor(&per_cu, (const void*)fwd_kernel, NTHREADS, LDS_BYTES);
        (void)hipGetLastError();
        grid = cus > 512 ? 512 : cus;
        if (per_cu < 1) fprintf(stderr, "kernel_launch: occupancy query reports %d blocks per CU\n", per_cu);
    }
    if (grid < 0) return;
    (void)hipMemsetAsync((char*)d_ws + WS_CTL, 0, CTL_ZERO_BYTES, stream);
    Args a{};
    for (int i = 0; i < 23; ++i) a.in[i] = (const float*)d_in[i];
    a.out = (float*)d_out; a.ws = (unsigned char*)d_ws;
#if N_LAUNCH_MODE == 1
    a.ph_lo = 0; a.ph_hi = NPHASES;
    hipLaunchKernelGGL(fwd_kernel, dim3(grid), dim3(NTHREADS), LDS_BYTES, stream, a);
#else
    for (int p = 0; p < NPHASES; ++p) { a.ph_lo = p; a.ph_hi = p + 1; hipLaunchKernelGGL(fwd_kernel, dim3(grid), dim3(NTHREADS), LDS_BYTES, stream, a); }
#endif
}
```

```cpp
#include <hip/hip_runtime.h>
#include <cstdio>
#include <cstdint>

#define LAS __attribute__((address_space(3)))
typedef unsigned short bf16;
typedef short bf16x8 __attribute__((ext_vector_type(8)));
typedef short bf16x4v __attribute__((ext_vector_type(4)));
typedef float f32x4 __attribute__((ext_vector_type(4)));
typedef unsigned u32x4 __attribute__((ext_vector_type(4)));
typedef unsigned u32x2 __attribute__((ext_vector_type(2)));
typedef float f32x2v __attribute__((ext_vector_type(2)));

#ifndef N_LAUNCH_MODE
#define N_LAUNCH_MODE 1
#endif

constexpr int NB = 8, SEQ = 4096, DM = 1024, T = NB * SEQ;
constexpr int HD = 64, NQH = 8, NKVH = 2;
constexpr int INC = 1792, QW = 1280;
constexpr int NE = 256, TOPK = 8, FE = 256;
constexpr int CK = 31, CW = 512;
constexpr int BM = 256, BN = 128;
constexpr int MAXROWS = T * TOPK + NE * BM;
constexpr int MAXTILES = MAXROWS / BM;
constexpr float LN_EPS = 1e-5f;
constexpr float ALPHA = 1.18920711500272106672f;
constexpr int NTHREADS = 512, NWAVES = 8;
constexpr int LDS_BYTES = 147456;

constexpr size_t MiB = 1u << 20;
constexpr size_t WS_CTL = 0, CTL_ZERO_BYTES = 64 * 1024;
constexpr size_t WS_MOD = 1 * MiB;
constexpr size_t WS_WINT = 12 * MiB;
constexpr size_t WS_WOT = 16 * MiB;
constexpr size_t WS_WCAT = 18 * MiB;
constexpr size_t WS_WDST = 20 * MiB;
constexpr size_t WS_WDT8 = 24 * MiB;
constexpr size_t WS_H8 = 88 * MiB;
constexpr size_t WS_HS = 168 * MiB;
constexpr size_t WS_SD = 184 * MiB;
constexpr size_t WS_X1B = 248 * MiB;
constexpr size_t WS_RDST = 312 * MiB;
constexpr size_t WS_Y = 344 * MiB;
constexpr size_t WS_WGT8 = 344 * MiB;
constexpr size_t WS_WUT8 = 408 * MiB;
constexpr size_t WS_H2Q = 472 * MiB;
constexpr size_t WS_LOG = 504 * MiB;
constexpr size_t WS_H2 = 600 * MiB;
constexpr size_t WS_QKVG = 664 * MiB;
constexpr size_t WS_MIX = 664 * MiB;
constexpr size_t WS_AC = 744 * MiB;
constexpr size_t WS_EW = 2 * MiB;
constexpr size_t WS_RER = 3 * MiB;
constexpr size_t WS_END = 808 * MiB;
constexpr size_t WS_GCNT = 32768;
constexpr int RCAP = T;

__device__ __forceinline__ unsigned f2bf(float f) { unsigned u = __float_as_uint(f); return (u + 0x7fffu + ((u >> 16) & 1u)) >> 16; }
__device__ __forceinline__ unsigned pk2(float lo, float hi) { unsigned r; asm volatile("v_cvt_pk_bf16_f32 %0, %1, %2" : "=v"(r) : "v"(lo), "v"(hi)); return r; }
__device__ __forceinline__ float bf2f(unsigned h) { return __uint_as_float(h << 16); }
__device__ __forceinline__ float bflo(unsigned w) { return __uint_as_float(w << 16); }
__device__ __forceinline__ float bfhi(unsigned w) { return __uint_as_float(w & 0xffff0000u); }
__device__ __forceinline__ float sigmoidf_(float v) { return __builtin_amdgcn_rcpf(1.0f + __builtin_amdgcn_exp2f(-1.44269504089f * v)); }
__device__ __forceinline__ float sigmoidf_ref(float v) { return 1.0f / (1.0f + __expf(-v)); }
__device__ __forceinline__ float siluf_(float v) { return v * __builtin_amdgcn_rcpf(1.0f + __builtin_amdgcn_exp2f(-1.44269504089f * v)); }
__device__ __forceinline__ float wave_sum(float v) {
#pragma unroll
    for (int o = 1; o < 64; o <<= 1) v += __shfl_xor(v, o);
    return v;
}
__device__ __forceinline__ int perm32(int rho) { const int n = rho >> 4, i = rho & 15; return 8 * (i >> 2) + 4 * n + (i & 3); }

#define XB_TMO      128
#define XB_XCNT(j)  (256  + 64 * (j))
#define XB_XSUB(j)  (1280 + 64 * (j))
#define XB_XGEN(j)  (2304 + 64 * (j))
#define XB_TOP      3328
#define XB_TOPGEN   3392
#define XCD_BAR_WORDS 3456
#define XB_SPIN_CAP (1u << 22)
__device__ __forceinline__ unsigned xb_ld(unsigned* p)              { return __hip_atomic_load(p, __ATOMIC_RELAXED, __HIP_MEMORY_SCOPE_AGENT); }
__device__ __forceinline__ unsigned xb_add(unsigned* p, unsigned v) { return __hip_atomic_fetch_add(p, v, __ATOMIC_RELAXED, __HIP_MEMORY_SCOPE_AGENT); }
__device__ __forceinline__ unsigned xb_xcc_id() { return (unsigned)__builtin_amdgcn_s_getreg((3 << 11) | 20) & 0xFu; }
#define XB_SPIN(cond, bar) do { unsigned _sp = 0; while (cond) { __builtin_amdgcn_s_sleep(1); \
    if ((++_sp & 255u) == 0u) { if (xb_ld(&(bar)[XB_TMO])) break; if (_sp > XB_SPIN_CAP) { atomicAdd(&(bar)[XB_TMO], 1u); break; } } } } while (0)
struct XcdBarrier { unsigned* bar; unsigned x; volatile LAS unsigned* st; };
__device__ __forceinline__ XcdBarrier xcd_barrier_post(unsigned* bar, volatile LAS unsigned* st) {
    XcdBarrier b; b.bar = bar; b.x = xb_xcc_id(); b.st = st;
    if (threadIdx.x == 0) (void)xb_add(&bar[XB_XCNT(b.x)], 1u);
    return b;
}
__device__ __forceinline__ void xcd_barrier_complete(unsigned* bar, unsigned x, unsigned& nloc, unsigned& nx) {
    const unsigned G = gridDim.x * gridDim.y * gridDim.z;
    unsigned sum, cnt, mine, sp = 0u;
    for (;;) {
        sum = 0u; cnt = 0u; mine = 0u;
#pragma unroll
        for (unsigned j = 0; j < 16; ++j) { const unsigned c = xb_ld(&bar[XB_XCNT(j)]); sum += c; cnt += (c > 0u) ? 1u : 0u; mine = (j == x) ? c : mine; }
        if (sum == G) break;
        __builtin_amdgcn_s_sleep(1);
        if ((++sp & 255u) == 0u) { if (xb_ld(&bar[XB_TMO])) break; if (sp > XB_SPIN_CAP) { atomicAdd(&bar[XB_TMO], 1u); break; } }
    }
    nloc = mine > 0u ? mine : 1u; nx = cnt > 0u ? cnt : 1u;
}
__device__ __forceinline__ void xcd_barrier(const XcdBarrier& b) {
    asm volatile("s_waitcnt vmcnt(0)" ::: "memory");
    __syncthreads();
    if (threadIdx.x == 0) {
        unsigned* bar = b.bar;
        __builtin_amdgcn_s_waitcnt(0);
        unsigned nloc = b.st[0], nx = b.st[1];
        if (nloc == 0u) { xcd_barrier_complete(bar, b.x, nloc, nx); b.st[0] = nloc; b.st[1] = nx; }
        const unsigned old = xb_add(&bar[XB_XSUB(b.x)], 1u);
        const unsigned gen = old / nloc;
        if (old + 1u == (gen + 1u) * nloc) {
            __builtin_amdgcn_fence(__ATOMIC_RELEASE, "agent");
            asm volatile("s_waitcnt vmcnt(0)" ::: "memory");
            const unsigned og = xb_add(&bar[XB_TOP], 1u);
            const unsigned tg = og / nx;
            if (og + 1u == (tg + 1u) * nx) xb_add(&bar[XB_TOPGEN], 1u);
            else XB_SPIN(xb_ld(&bar[XB_TOPGEN]) == tg, bar);
            __builtin_amdgcn_fence(__ATOMIC_ACQUIRE, "agent");
            xb_add(&bar[XB_XGEN(b.x)], 1u);
            asm volatile("s_waitcnt vmcnt(0)" ::: "memory");
        } else {
            XB_SPIN(xb_ld(&bar[XB_XGEN(b.x)]) == gen, bar);
            __builtin_amdgcn_fence(__ATOMIC_ACQUIRE, "agent");
            asm volatile("s_waitcnt vmcnt(0)" ::: "memory");
        }
    }
    __syncthreads();
}

struct Args {
    const float* in[23];
    float* out;
    unsigned char* ws;
    int ph_lo, ph_hi, flags, pad;
};

namespace pg {
constexpr int HALF = 128, HTB = HALF * 64 * 2, PG_STAGE_BYTES = 8 * HTB;
__device__ __forceinline__ int lds_byte(int r, int c) { const int st = (r >> 4) * 2 + (c >> 5), rr = r & 15, cc = c & 31, ob = rr * 64 + cc * 2; return st * 1024 + (ob ^ (((ob >> 9) & 1) << 5)); }
__device__ __forceinline__ void stage_rc(int b, int& R, int& C) { const int st = b / 1024, sb = b % 1024, swz = sb ^ (((sb >> 9) & 1) << 5); R = (st >> 1) * 16 + swz / 64; C = (st & 1) * 32 + (swz % 64) / 2; }
struct Unit { unsigned a, b0, b1; int r0, c, aux, nv; };
typedef int i32x8 __attribute__((ext_vector_type(8)));
typedef int i32x4 __attribute__((ext_vector_type(4)));
__device__ __forceinline__ bf16x8 lo8(const i32x8& v) { return __builtin_bit_cast(bf16x8, (i32x4)__builtin_shufflevector(v, v, 0, 1, 2, 3)); }
__device__ __forceinline__ bf16x8 hi8(const i32x8& v) { return __builtin_bit_cast(bf16x8, (i32x4)__builtin_shufflevector(v, v, 4, 5, 6, 7)); }
__device__ __forceinline__ i32x8 cat8(const bf16x8 lo, const bf16x8 hi) { const i32x4 a = __builtin_bit_cast(i32x4, lo), b = __builtin_bit_cast(i32x4, hi); return __builtin_shufflevector(a, b, 0, 1, 2, 3, 4, 5, 6, 7); }
typedef __amdgpu_buffer_rsrc_t rsrc_t;

template <class Epi, class Sched, bool GATHER, int BMAP = 0, bool F8 = false, int SCW = 127, int SCA = 127>
__device__ __forceinline__ void gemm_phase(LAS unsigned char* lds, unsigned char* wsbase, const int ROWB, const Sched& S, const Epi& E) {
    const rsrc_t rs = __builtin_amdgcn_make_buffer_rsrc((void*)wsbase, 0, 0x7fffffff, 0x00020000);
    const int tid = threadIdx.x, wid = __builtin_amdgcn_readfirstlane(tid >> 6), lane = tid & 63, wr = wid >> 2, wc = wid & 3, fr = lane & 15, fq = lane >> 4;
    int nt = ROWB / 128; asm volatile("" : "+s"(nt));
    int Rr[2], Cc[2]; unsigned voffB[2], vA[2][2], nvA[2][2];
#pragma unroll
    for (int i = 0; i < 2; ++i) { stage_rc(tid * 16 + i * 8192, Rr[i], Cc[i]); const int Rb = BMAP ? (64 * (Rr[i] >> 5) + 16 * ((Rr[i] & 15) >> 2) + 4 * ((Rr[i] >> 4) & 1) + (Rr[i] & 3)) : ((Rr[i] & ~31) + perm32(Rr[i] & 31)); voffB[i] = (unsigned)(Rb * ROWB + Cc[i] * 2); }
    const unsigned kstep = 128;
    const unsigned ldsw = (unsigned)wid * 1024u;
    const int aoff = lds_byte(wr * 64 + fr, fq * 8), boff = lds_byte(wc * 32 + fr, fq * 8);
#define PG_SA(b, h) (((b) * 2 + (h)) * pg::HTB)
#define PG_SB(b, h) ((4 + (b) * 2 + (h)) * pg::HTB)
#define PG_STG(bufoff, gbase, v0, v1) do { \
        __builtin_amdgcn_raw_ptr_buffer_load_lds(rs, (LAS unsigned*)(lds + (bufoff) + ldsw), 16, (int)(v0), (int)(gbase), 0, 0); \
        __builtin_amdgcn_raw_ptr_buffer_load_lds(rs, (LAS unsigned*)(lds + (bufoff) + ldsw + 8192), 16, (int)(v1), (int)(gbase), 0, 0); } while (0)
#define PG_STGB(bufoff, gbase) PG_STG(bufoff, gbase, voffB[0], voffB[1])
#define PG_LD16(off) (*(const LAS bf16x8*)(lds + (off)))
#define PG_LDA(dst, b, h) do { _Pragma("unroll") for (int m = 0; m < 4; ++m) dst[m] = pg::cat8(PG_LD16(PG_SA(b, h) + aoff + m * 2048), PG_LD16(PG_SA(b, h) + aoff + m * 2048 + 1024)); } while (0)
#define PG_LDB(dst, b, h) do { _Pragma("unroll") for (int n = 0; n < 2; ++n) dst[n] = pg::cat8(PG_LD16(PG_SB(b, h) + boff + n * 2048), PG_LD16(PG_SB(b, h) + boff + n * 2048 + 1024)); } while (0)
#define PG_MMA(ai, bj, At, Bt) do { __builtin_amdgcn_s_setprio(1); \
        if (F8) { _Pragma("unroll") for (int m = 0; m < 4; ++m) _Pragma("unroll") for (int n = 0; n < 2; ++n) \
            asm volatile("v_mfma_scale_f32_16x16x128_f8f6f4 %0, %1, %2, %0, %3, %4 op_sel_hi:[0,0,0]" : "+v"(acc[ai][bj][m][n]) : "v"(Bt[n]), "v"(At[m]), "v"(scw), "v"(sca)); } \
        else { _Pragma("unroll") for (int m = 0; m < 4; ++m) _Pragma("unroll") for (int n = 0; n < 2; ++n) { \
            acc[ai][bj][m][n] = __builtin_amdgcn_mfma_f32_16x16x32_bf16(pg::lo8(Bt[n]), pg::lo8(At[m]), acc[ai][bj][m][n], 0, 0, 0); \
            acc[ai][bj][m][n] = __builtin_amdgcn_mfma_f32_16x16x32_bf16(pg::hi8(Bt[n]), pg::hi8(At[m]), acc[ai][bj][m][n], 0, 0, 0); } } \
        __builtin_amdgcn_s_setprio(0); } while (0)
#define PG_WAIT_V(n) asm volatile("s_waitcnt vmcnt(" #n ")" ::: "memory")
#define PG_WAIT_L(n) asm volatile("s_waitcnt lgkmcnt(" #n ")" ::: "memory")
#define PG_BAR __builtin_amdgcn_s_barrier()
#define PG_SCHED __builtin_amdgcn_sched_barrier(0)
#define PG_VA(dst, u) do { _Pragma("unroll") for (int h = 0; h < 2; ++h) _Pragma("unroll") for (int i = 0; i < 2; ++i) \
        dst[h][i] = GATHER ? (unsigned)(S.row(u, h * pg::HALF + Rr[i]) * ROWB + Cc[i] * 2) : (unsigned)((h * pg::HALF + Rr[i]) * ROWB + Cc[i] * 2); } while (0)
    Unit cur, nxt; int ui = 0;
    if (!S.next(0, cur)) return;
    f32x4 acc[2][2][4][2];
#pragma unroll
    for (int a = 0; a < 2; ++a)
#pragma unroll
        for (int b = 0; b < 2; ++b)
#pragma unroll
            for (int m = 0; m < 4; ++m)
#pragma unroll
                for (int n = 0; n < 2; ++n) acc[a][b][m][n] = (f32x4){0.f, 0.f, 0.f, 0.f};
    pg::i32x8 At[4], B0[2], B1[2];
    int scw = SCW * 0x01010101, sca = SCA * 0x01010101; asm volatile("" : "+v"(scw), "+v"(sca));
    PG_VA(vA, cur);
#pragma unroll
    for (int h = 0; h < 2; ++h)
#pragma unroll
        for (int i = 0; i < 2; ++i) nvA[h][i] = vA[h][i];
    unsigned cA = cur.a, cB0 = cur.b0, cB1 = cur.b1;
    PG_STGB(PG_SB(0, 0), cB0); PG_STGB(PG_SB(0, 1), cB1); PG_STG(PG_SA(0, 0), cA, vA[0][0], vA[0][1]); PG_STG(PG_SA(0, 1), cA, vA[1][0], vA[1][1]);
    if (wr == 1) PG_BAR;
    PG_WAIT_V(2); PG_BAR;
    PG_STGB(PG_SB(1, 0), cB0 + kstep); PG_STG(PG_SA(1, 0), cA + kstep, vA[0][0], vA[0][1]); PG_STGB(PG_SB(1, 1), cB1 + kstep);
    PG_WAIT_V(6); PG_BAR;
    for (;;) {
        const bool has_next = S.next(ui + 1, nxt);
        const unsigned nA = has_next ? nxt.a : cA, nB0 = has_next ? nxt.b0 : cB0, nB1 = has_next ? nxt.b1 : cB1;
#pragma unroll 1
        for (int t = 0; t < nt; t += 2) {
            const bool last = (t == nt - 2);
            const unsigned a1 = cA + (unsigned)(t + 1) * kstep;
            const unsigned a2 = last ? nA : cA + (unsigned)(t + 2) * kstep;
            const unsigned b20 = last ? nB0 : cB0 + (unsigned)(t + 2) * kstep, b21 = last ? nB1 : cB1 + (unsigned)(t + 2) * kstep;
            const unsigned a3 = a2 + kstep, b30 = b20 + kstep, b31 = b21 + kstep;
            unsigned wA[2][2];
            if (GATHER) {
                if (last && has_next) PG_VA(nvA, nxt);
#pragma unroll
                for (int h = 0; h < 2; ++h)
#pragma unroll
                    for (int i = 0; i < 2; ++i) wA[h][i] = (last && has_next) ? nvA[h][i] : vA[h][i];
            } else {
#pragma unroll
                for (int h = 0; h < 2; ++h)
#pragma unroll
                    for (int i = 0; i < 2; ++i) wA[h][i] = vA[h][i];
            }
            const bool after_epi = (t == 0) && (ui > 0);
            PG_LDB(B0, 0, 0); PG_LDB(B1, 0, 1); PG_SCHED; PG_LDA(At, 0, 0); PG_STG(PG_SA(1, 1), a1, vA[1][0], vA[1][1]);
            if (after_epi && Epi::NST >= 16) PG_WAIT_V(24); else if (after_epi && Epi::NST >= 8) PG_WAIT_V(16); else PG_WAIT_V(8);
            PG_WAIT_L(0); PG_BAR; PG_MMA(0, 0, At, B0); PG_MMA(0, 1, At, B1); PG_BAR; PG_SCHED;
            PG_LDA(At, 0, 1); PG_STGB(PG_SB(0, 0), b20); PG_STGB(PG_SB(0, 1), b21); PG_STG(PG_SA(0, 0), a2, wA[0][0], wA[0][1]);
            if (after_epi && Epi::NST >= 16) PG_WAIT_V(24); else if (after_epi && Epi::NST >= 8) PG_WAIT_V(16); else PG_WAIT_V(8);
            PG_WAIT_L(0); PG_BAR; PG_MMA(1, 0, At, B0); PG_MMA(1, 1, At, B1); PG_BAR; PG_SCHED;
            PG_LDB(B0, 1, 0); PG_LDB(B1, 1, 1); PG_SCHED; PG_LDA(At, 1, 0); PG_STG(PG_SA(0, 1), a2, wA[1][0], wA[1][1]);
            PG_WAIT_V(8); PG_WAIT_L(0); PG_BAR; PG_MMA(0, 0, At, B0); PG_MMA(0, 1, At, B1); PG_BAR; PG_SCHED;
            PG_LDA(At, 1, 1); PG_STGB(PG_SB(1, 0), b30); PG_STGB(PG_SB(1, 1), b31); PG_STG(PG_SA(1, 0), a3, wA[0][0], wA[0][1]);
            PG_WAIT_V(8); PG_WAIT_L(0); PG_BAR; PG_MMA(1, 0, At, B0); PG_MMA(1, 1, At, B1); PG_BAR; PG_SCHED;
        }
        if (F8) asm volatile("s_nop 15\n\ts_nop 15" ::: "memory");
        if (wr == 0) PG_BAR;
        E(acc, cur, wr, wc, fr, fq);
        if (!has_next) break;
#pragma unroll
        for (int a = 0; a < 2; ++a)
#pragma unroll
            for (int b = 0; b < 2; ++b)
#pragma unroll
                for (int m = 0; m < 4; ++m)
#pragma unroll
                    for (int n = 0; n < 2; ++n) acc[a][b][m][n] = (f32x4){0.f, 0.f, 0.f, 0.f};
        cur = nxt; cA = nA; cB0 = nB0; cB1 = nB1; ++ui;
        if (GATHER) {
#pragma unroll
            for (int h = 0; h < 2; ++h)
#pragma unroll
                for (int i = 0; i < 2; ++i) vA[h][i] = nvA[h][i];
        }
        if (wr == 1) PG_BAR;
    }
    PG_WAIT_V(0);
    PG_BAR;
#undef PG_SA
#undef PG_SB
#undef PG_STG
#undef PG_STGB
#undef PG_LD16
#undef PG_LDA
#undef PG_LDB
#undef PG_MMA
#undef PG_WAIT_V
#undef PG_WAIT_L
#undef PG_BAR
#undef PG_SCHED
#undef PG_VA
}
}

struct XcdSplit {
    int NU, G, bx;
    __device__ __forceinline__ bool unit(int i, int& u) const {
        if (G & 7) { u = bx + i * G; return u < NU; }
        const int x = bx & 7, li = bx >> 3, per = G >> 3, q = NU >> 3, r = NU & 7;
        const int start = x * q + (x < r ? x : r), len = q + (x < r ? 1 : 0), k = li + i * per;
        if (k >= len) return false;
        u = start + k; return true;
    }
};
__device__ __forceinline__ void dense_pmpn(int idx, int nN, int& pm, int& pn) { const int nig = 8 * nN, gid = idx / nig, rem = idx % nig; pm = gid * 8 + (rem & 7); pn = rem >> 3; }

__device__ __forceinline__ void store8_bf16(bf16* p, const f32x4& a, const f32x4& b) {
    u32x4 w; w.x = pk2(a[0], a[1]); w.y = pk2(a[2], a[3]); w.z = pk2(b[0], b[1]); w.w = pk2(b[2], b[3]); *(u32x4*)p = w;
}
typedef f32x4 acc_t[2][2][4][2];

__device__ __forceinline__ unsigned pk4_fp8(const f32x4& v, float sc) {
    int w = 0;
    w = __builtin_amdgcn_cvt_pk_fp8_f32(__builtin_amdgcn_fmed3f(v[0] * sc, -440.f, 440.f), __builtin_amdgcn_fmed3f(v[1] * sc, -440.f, 440.f), w, false);
    w = __builtin_amdgcn_cvt_pk_fp8_f32(__builtin_amdgcn_fmed3f(v[2] * sc, -440.f, 440.f), __builtin_amdgcn_fmed3f(v[3] * sc, -440.f, 440.f), w, true);
    return (unsigned)w;
}
constexpr float Y_SCALE = 64.0f;
constexpr float W8_SCALE = 32.0f, H8_SCALE = 8.0f;
__device__ __forceinline__ void transpose_item(const float* src, int K, int N, bf16* dst, int item, float* scr, int lane) {
    const int nblk = N / 64, kb = item / nblk, nb = item % nblk, k0 = kb * 64, n0 = nb * 64;
    const int lr = lane >> 4, lc = (lane & 15) * 4;
    f32x4 v[16];
    const float* sp = src + (size_t)(k0 + lr) * N + n0 + lc;
#pragma unroll
    for (int i = 0; i < 16; ++i) v[i] = __builtin_nontemporal_load((const f32x4*)(sp + (size_t)(4 * i) * N));
#pragma unroll
    for (int i = 0; i < 16; ++i) { float* d = scr + (4 * i + lr) * 65 + lc; d[0] = v[i][0]; d[1] = v[i][1]; d[2] = v[i][2]; d[3] = v[i][3]; }
    asm volatile("s_waitcnt lgkmcnt(0)" ::: "memory");
    const int c = lane & 7;
#pragma unroll
    for (int j = 0; j < 8; ++j) {
        const int n = (lane >> 3) + 8 * j; const float* s = scr + (8 * c) * 65 + n;
        u32x4 o; o.x = pk2(s[0], s[65]); o.y = pk2(s[2 * 65], s[3 * 65]); o.z = pk2(s[4 * 65], s[5 * 65]); o.w = pk2(s[6 * 65], s[7 * 65]);
        *(u32x4*)(dst + (size_t)(n0 + n) * K + k0 + 8 * c) = o;
    }
    asm volatile("s_waitcnt lgkmcnt(0)" ::: "memory");
}

__device__ __forceinline__ void transpose_item_f8(const float* src, int K, int N, unsigned char* dst, int item, float* scr, int lane) {
    const int nblk = N / 64, kb = item / nblk, nb = item % nblk, k0 = kb * 64, n0 = nb * 64;
    const int lr = lane >> 4, lc = (lane & 15) * 4;
    f32x4 v[16];
    const float* sp = src + (size_t)(k0 + lr) * N + n0 + lc;
#pragma unroll
    for (int i = 0; i < 16; ++i) v[i] = __builtin_nontemporal_load((const f32x4*)(sp + (size_t)(4 * i) * N));
#pragma unroll
    for (int i = 0; i < 16; ++i) { float* d = scr + (4 * i + lr) * 65 + lc; d[0] = v[i][0]; d[1] = v[i][1]; d[2] = v[i][2]; d[3] = v[i][3]; }
    asm volatile("s_waitcnt lgkmcnt(0)" ::: "memory");
    const int c = lane & 7;
#pragma unroll
    for (int j = 0; j < 8; ++j) {
        const int n = (lane >> 3) + 8 * j; const float* sx = scr + (8 * c) * 65 + n;
        u32x2 o; o.x = pk4_fp8((f32x4){sx[0], sx[65], sx[2 * 65], sx[3 * 65]}, W8_SCALE); o.y = pk4_fp8((f32x4){sx[4 * 65], sx[5 * 65], sx[6 * 65], sx[7 * 65]}, W8_SCALE);
        *(u32x2*)(dst + (size_t)(n0 + n) * K + k0 + 8 * c) = o;
    }
    asm volatile("s_waitcnt lgkmcnt(0)" ::: "memory");
}

constexpr int TR_I_IN = 16 * 28, TR_I_O = 16 * 16, TR_I_S = 16 * 4, TR_I_DS = 4 * 16, TR_I_E = 16 * 4 * NE;
constexpr int TR_NITEMS = TR_I_IN + TR_I_O + 3 * TR_I_S + TR_I_DS + 3 * TR_I_E;
constexpr int FILL_ITEMS = 7168;
__device__ __forceinline__ void transpose_dispatch(const Args& a, int it, float* scr, int lane) {
    unsigned char* ws = a.ws; int r = it;
    if (r < TR_I_IN) { transpose_item(a.in[4], 1024, INC, (bf16*)(ws + WS_WINT), r, scr, lane); return; } r -= TR_I_IN;
    if (r < TR_I_O) { transpose_item(a.in[10], 1024, 1024, (bf16*)(ws + WS_WOT), r, scr, lane); return; } r -= TR_I_O;
    if (r < TR_I_S) { transpose_item(a.in[13], 1024, 256, (bf16*)(ws + WS_WCAT), r, scr, lane); return; } r -= TR_I_S;
    if (r < TR_I_S) { transpose_item(a.in[18], 1024, 256, (bf16*)(ws + WS_WCAT) + 256 * 1024, r, scr, lane); return; } r -= TR_I_S;
    if (r < TR_I_S) { transpose_item(a.in[19], 1024, 256, (bf16*)(ws + WS_WCAT) + 512 * 1024, r, scr, lane); return; } r -= TR_I_S;
    if (r < TR_I_DS) { transpose_item(a.in[20], 256, 1024, (bf16*)(ws + WS_WDST), r, scr, lane); return; } r -= TR_I_DS;
    if (r < TR_I_E) { const int e = r >> 6; transpose_item_f8(a.in[15] + (size_t)e * 262144, 1024, 256, ws + WS_WGT8 + (size_t)e * 262144, r & 63, scr, lane); return; } r -= TR_I_E;
    if (r < TR_I_E) { const int e = r >> 6; transpose_item_f8(a.in[16] + (size_t)e * 262144, 1024, 256, ws + WS_WUT8 + (size_t)e * 262144, r & 63, scr, lane); return; } r -= TR_I_E;
    { const int e = r >> 6; transpose_item_f8(a.in[17] + (size_t)e * 262144, 256, 1024, ws + WS_WDT8 + (size_t)e * 262144, r & 63, scr, lane); }
}
__device__ __forceinline__ void phase_prep(const Args& a, unsigned char* lds, int G) {
    const int tid = threadIdx.x, lane = tid & 63, wid = tid >> 6, bx = blockIdx.x;
    unsigned char* ws = a.ws;
    {
        float* sc = (float*)lds;
        float* red = (float*)(lds + 32768);
        const float* c = a.in[1]; const float* w_ada = a.in[2]; const float* b_ada = a.in[3];
        float* mod = (float*)(ws + WS_MOD);
        for (int cb = bx; cb < 6144 / 32; cb += G) {
            __syncthreads();
            for (int i = tid; i < 8 * 1024; i += NTHREADS) sc[i] = siluf_(c[i]);
            __syncthreads();
            const int kg = tid >> 5, cl = tid & 31, col = cb * 32 + cl;
            float acc[8];
#pragma unroll
            for (int b = 0; b < 8; ++b) acc[b] = 0.f;
            for (int k = kg; k < 1024; k += 16) {
                const float wv = w_ada[(size_t)k * 6144 + col];
#pragma unroll
                for (int b = 0; b < 8; ++b) acc[b] += sc[b * 1024 + k] * wv;
            }
#pragma unroll
            for (int b = 0; b < 8; ++b) red[(kg * 8 + b) * 32 + cl] = acc[b];
            __syncthreads();
            if (tid < 256) {
                const int b = tid >> 5; float s = 0.f;
#pragma unroll
                for (int g = 0; g < 16; ++g) s += red[(g * 8 + b) * 32 + cl];
                mod[b * 6144 + col] = s + b_ada[col];
            }
        }
        __syncthreads();
    }
    {
        float* scr = (float*)(lds + wid * 16640);
        const int gw = bx * NWAVES + wid, NGW = G * NWAVES;
        for (int it = gw; it < TR_NITEMS - 2 * FILL_ITEMS; it += NGW) transpose_dispatch(a, it, scr, lane);
    }
}
__device__ __forceinline__ void transpose_filler(const Args& a, unsigned char* lds, int G, int part) {
    if ((G & 7) || (int)(blockIdx.x >> 3) < (G >> 4)) return;
    __syncthreads();
    const int lane = threadIdx.x & 63, wid = threadIdx.x >> 6;
    float* scr = (float*)(lds + wid * 16640);
    const int nidle = G >> 1, w = ((int)(blockIdx.x & 7) * (G >> 4) + ((int)(blockIdx.x >> 3) - (G >> 4))) * NWAVES + wid;
    const int base = TR_NITEMS - (2 - part) * FILL_ITEMS;
    for (int it = w; it < FILL_ITEMS; it += nidle * NWAVES) transpose_dispatch(a, base + it, scr, lane);
}

__device__ __forceinline__ void phase_hmod(const Args& a, int G) {
    const float* x = a.in[0]; const float* mod = (const float*)(a.ws + WS_MOD); bf16* h = (bf16*)(a.ws + WS_H2);
    const int lane = threadIdx.x & 63, wid = threadIdx.x >> 6, n0 = 16 * lane;
    const int rows_per = (T + G - 1) / G, mbeg = blockIdx.x * rows_per, mend = min(T, mbeg + rows_per);
    int cur_b = -1; f32x4 sc4[4], sh4[4];
    for (int m = mbeg + wid; m < mend; m += NWAVES) {
        const int bb = m >> 12; const float* xr = x + (size_t)m * DM + n0;
        if (bb != cur_b) { cur_b = bb;
#pragma unroll
            for (int q = 0; q < 4; ++q) { sc4[q] = *(const f32x4*)(mod + bb * 6144 + 1024 + n0 + 4 * q) + 1.0f; sh4[q] = *(const f32x4*)(mod + bb * 6144 + n0 + 4 * q); } }
        f32x4 v[4];
#pragma unroll
        for (int q = 0; q < 4; ++q) v[q] = *(const f32x4*)(xr + 4 * q) * sc4[q] + sh4[q];
        store8_bf16(h + (size_t)m * DM + n0, v[0], v[1]); store8_bf16(h + (size_t)m * DM + n0 + 8, v[2], v[3]);
    }
}

struct SchedProj {
    XcdSplit xs; unsigned A, Bt;
    __device__ __forceinline__ bool next(int i, pg::Unit& u) const {
        int idx; if (!xs.unit(i, idx)) return false; int pm, pn; dense_pmpn(idx, 7, pm, pn);
        u.a = A + (unsigned)pm * 256 * 2048; u.r0 = pm * 256; u.c = pn; u.aux = 0; u.nv = 0;
        if (pn < 3) { u.b0 = Bt + (unsigned)(256 * pn) * 2048; u.b1 = u.b0 + 128 * 2048; }
        else { const int j = pn - 3; u.b0 = Bt + (unsigned)(768 + 128 * j) * 2048; u.b1 = Bt + (unsigned)(1280 + 128 * j) * 2048; }
        return true; }
    __device__ __forceinline__ int row(const pg::Unit&, int) const { return 0; }
};
struct EpiProj {
    static constexpr int NST = 8;
    bf16* O;
    __device__ __forceinline__ void operator()(const acc_t& acc, const pg::Unit& u, int wr, int wc, int fr, int fq) const {
        const int row0 = u.r0 + wr * 64 + fr;
        if (u.c < 3) {
#pragma unroll
            for (int ai = 0; ai < 2; ++ai)
#pragma unroll
                for (int m = 0; m < 4; ++m) { bf16* rowp = O + (size_t)(row0 + ai * 128 + m * 16) * QW + 256 * u.c + wc * 32 + 8 * fq;
#pragma unroll
                    for (int bj = 0; bj < 2; ++bj) store8_bf16(rowp + bj * 128, acc[ai][bj][m][0], acc[ai][bj][m][1]); }
        } else {
            const int j = u.c - 3;
#pragma unroll
            for (int ai = 0; ai < 2; ++ai)
#pragma unroll
                for (int m = 0; m < 4; ++m) { bf16* rowp = O + (size_t)(row0 + ai * 128 + m * 16) * QW + 768 + 128 * j + wc * 32 + 8 * fq;
                    f32x4 r0, r1;
#pragma unroll
                    for (int q = 0; q < 4; ++q) { r0[q] = acc[ai][0][m][0][q] * sigmoidf_(acc[ai][1][m][0][q]); r1[q] = acc[ai][0][m][1][q] * sigmoidf_(acc[ai][1][m][1][q]); }
                    store8_bf16(rowp, r0, r1); }
        }
    }
};
__device__ __forceinline__ void phase_proj(const Args& a, unsigned char* lds, int G) {
    SchedProj S{XcdSplit{(T / 256) * 7, G, (int)blockIdx.x}, (unsigned)WS_H2, (unsigned)WS_WINT};
    EpiProj E{(bf16*)(a.ws + WS_QKVG)};
    pg::gemm_phase<EpiProj, SchedProj, false>((LAS unsigned char*)lds, a.ws, DM * 2, S, E);
    transpose_filler(a, lds, G, 0);
}

constexpr int VT_STRIDE = 280;
__device__ __forceinline__ void attn_unit(const Args& a, unsigned char* lds, int unit) {
    const bf16* QK = (const bf16*)(a.ws + WS_QKVG); bf16* AC = (bf16*)(a.ws + WS_AC);
    const int tid = threadIdx.x, lane = tid & 63, w = __builtin_amdgcn_readfirstlane(tid >> 6), fr = lane & 15, fq = lane >> 4;
    const int kh = unit & 1, nblk = (unit >> 1) & 31, b = unit >> 6;
    const int tok0 = b * SEQ + nblk * 128;
    unsigned char* Kl = lds;
    bf16* Vt = (bf16*)(lds + 272 * 128);
    __syncthreads();
#pragma unroll 1
    for (int idx = tid; idx < 272 * 8; idx += NTHREADS) {
        const int key = idx >> 3, c = idx & 7;
        u32x4 kv = (u32x4){0u, 0u, 0u, 0u}, vv = (u32x4){0u, 0u, 0u, 0u};
        if (key < 256 && (nblk > 0 || key >= 128)) {
            const bf16* rowp = QK + (size_t)(tok0 - 128 + key) * QW + 512 + 64 * kh + 8 * c;
            kv = *(const u32x4*)rowp; vv = *(const u32x4*)(rowp + 128);
        }
        *(u32x4*)(Kl + key * 128 + ((c ^ (key & 7)) * 16)) = kv;
        bf16* vp = Vt + (8 * c) * VT_STRIDE + key;
        vp[0] = (bf16)(vv.x & 0xffffu); vp[VT_STRIDE] = (bf16)(vv.x >> 16);
        vp[2 * VT_STRIDE] = (bf16)(vv.y & 0xffffu); vp[3 * VT_STRIDE] = (bf16)(vv.y >> 16);
        vp[4 * VT_STRIDE] = (bf16)(vv.z & 0xffffu); vp[5 * VT_STRIDE] = (bf16)(vv.z >> 16);
        vp[6 * VT_STRIDE] = (bf16)(vv.w & 0xffffu); vp[7 * VT_STRIDE] = (bf16)(vv.w >> 16);
    }
    __syncthreads();
    const float* sinks = a.in[5];
#pragma unroll 1
    for (int g = 0; g < 4; ++g) {
        const int h = kh * 4 + g;
        int lofs = 0; asm volatile("" : "+v"(lofs));
        const float slope = exp2f(-(float)(h + 1)), sink = sinks[h];
        const bf16* qp = QK + (size_t)(tok0 + 16 * w + fr) * QW + 64 * h + 8 * fq;
        const bf16x8 q0 = *(const bf16x8*)qp, q1 = *(const bf16x8*)(qp + 32);
        f32x4 st[10];
#pragma unroll
        for (int i = 0; i < 10; ++i) {
            const int key = 16 * (w + i) + fr;
            const unsigned char* kp = Kl + key * 128 + lofs;
            const bf16x8 k0 = *(const bf16x8*)(kp + ((fq ^ (fr & 7)) * 16)), k1 = *(const bf16x8*)(kp + (((fq + 4) ^ (fr & 7)) * 16));
            f32x4 s = (f32x4){0.f, 0.f, 0.f, 0.f};
            s = __builtin_amdgcn_mfma_f32_16x16x32_bf16(k0, q0, s, 0, 0, 0);
            s = __builtin_amdgcn_mfma_f32_16x16x32_bf16(k1, q1, s, 0, 0, 0);
            st[i] = s;
        }
        float mx = -INFINITY;
#pragma unroll
        for (int i = 0; i < 10; ++i)
#pragma unroll
            for (int r = 0; r < 4; ++r) {
                const int dist = 128 + fr - 16 * i - 4 * fq - r;
                const int kj = 16 * (w + i) + 4 * fq + r;
                const bool valid = (dist >= 0) && (dist < 128) && (nblk > 0 || kj >= 128);
                const float s = valid ? (st[i][r] * 0.125f - slope * (float)dist) : -INFINITY;
                st[i][r] = s; mx = fmaxf(mx, s);
            }
        mx = fmaxf(mx, __shfl_xor(mx, 16)); mx = fmaxf(mx, __shfl_xor(mx, 32));
        mx = fmaxf(mx, sink);
        float sum = 0.f;
#pragma unroll
        for (int i = 0; i < 10; ++i)
#pragma unroll
            for (int r = 0; r < 4; ++r) { const float p = __expf(st[i][r] - mx); st[i][r] = p; sum += p; }
        sum += __shfl_xor(sum, 16); sum += __shfl_xor(sum, 32);
        const float inv = 1.0f / (sum + __expf(sink - mx));
        f32x4 o[4];
#pragma unroll
        for (int nt = 0; nt < 4; ++nt) o[nt] = (f32x4){0.f, 0.f, 0.f, 0.f};
#pragma unroll
        for (int s5 = 0; s5 < 5; ++s5) {
            u32x4 pw; pw.x = pk2(st[2 * s5][0], st[2 * s5][1]); pw.y = pk2(st[2 * s5][2], st[2 * s5][3]); pw.z = pk2(st[2 * s5 + 1][0], st[2 * s5 + 1][1]); pw.w = pk2(st[2 * s5 + 1][2], st[2 * s5 + 1][3]);
            const bf16x8 pf = __builtin_bit_cast(bf16x8, pw);
#pragma unroll
            for (int nt = 0; nt < 4; ++nt) {
                const bf16* vp = Vt + (16 * nt + fr) * VT_STRIDE + 16 * (w + 2 * s5) + 4 * fq + lofs;
                const u32x2 va = *(const u32x2*)vp, vb = *(const u32x2*)(vp + 16);
                u32x4 vw; vw.x = va.x; vw.y = va.y; vw.z = vb.x; vw.w = vb.y;
                o[nt] = __builtin_amdgcn_mfma_f32_16x16x32_bf16(__builtin_bit_cast(bf16x8, vw), pf, o[nt], 0, 0, 0);
            }
        }
        bf16* op = AC + (size_t)(tok0 + 16 * w + fr) * DM + 64 * h + 4 * fq;
#pragma unroll
        for (int nt = 0; nt < 4; ++nt) { u32x2 ow; ow.x = pk2(o[nt][0] * inv, o[nt][1] * inv); ow.y = pk2(o[nt][2] * inv, o[nt][3] * inv); *(u32x2*)(op + 16 * nt) = ow; }
    }
}

typedef float f32x2c __attribute__((ext_vector_type(2)));
__device__ __forceinline__ void conv_prefetch(const bf16* QK, int unit, int tid, u32x4 (&pf)[8]) {
    const int t0 = unit * 32, b = t0 >> 12, s0 = t0 & 4095;
#pragma unroll
    for (int q = 0; q < 8; ++q) {
        const int idx = tid + q * NTHREADS, i = idx >> 6, ch = idx & 63, sq = s0 - 30 + i;
        pf[q] = (u32x4){0u, 0u, 0u, 0u};
        if (i < 62 && sq >= 0) pf[q] = *(const u32x4*)(QK + (size_t)(b * SEQ + sq) * QW + 768 + 8 * ch);
    }
}
__device__ __forceinline__ void phase_conv(const Args& a, unsigned char* lds, int G) {
    const bf16* QK = (const bf16*)(a.ws + WS_QKVG); bf16* AC = (bf16*)(a.ws + WS_AC);
    const int tid = threadIdx.x, lane = tid & 63, wid = tid >> 6, c = tid;
    bf16* inp = (bf16*)lds;
    float* yb = (float*)(lds + 62 * CW * 2);
    const float* cw = a.in[6];
    f32x2c W2[32];
#pragma unroll
    for (int idx = 0; idx < 32; ++idx) {
        const float lo = (idx >= 1) ? cw[(31 - idx) * CW + c] : 0.f;
        const float hi = (idx <= 30) ? cw[(30 - idx) * CW + c] : 0.f;
        W2[idx] = (f32x2c){lo, hi};
    }
    const float bias = a.in[7][c];
    const float* lg = a.in[8]; const float* lb = a.in[9];
    const f32x4 g0 = *(const f32x4*)(lg + 8 * lane), g1 = *(const f32x4*)(lg + 8 * lane + 4), b0 = *(const f32x4*)(lb + 8 * lane), b1 = *(const f32x4*)(lb + 8 * lane + 4);
    u32x4 pf[8];
    int unit = blockIdx.x;
    if (unit < T / 32) conv_prefetch(QK, unit, tid, pf);
    for (; unit < T / 32; unit += G) {
        const int t0 = unit * 32;
        __syncthreads();
#pragma unroll
        for (int q = 0; q < 8; ++q) { const int idx = tid + q * NTHREADS, i = idx >> 6, ch = idx & 63; if (i < 62) *(u32x4*)(inp + i * CW + 8 * ch) = pf[q]; }
        __syncthreads();
        if (unit + G < T / 32) conv_prefetch(QK, unit + G, tid, pf);
        f32x2c acc[16];
#pragma unroll
        for (int tp = 0; tp < 16; ++tp) acc[tp] = (f32x2c){bias, bias};
#pragma unroll
        for (int i = 0; i < 62; ++i) {
            const float v = bf2f(inp[i * CW + c]); const f32x2c v2 = (f32x2c){v, v};
#pragma unroll
            for (int tp = 0; tp < 16; ++tp) { const int idx = 31 - i + 2 * tp;
                if (idx >= 0 && idx <= 31) acc[tp] = __builtin_elementwise_fma(v2, W2[idx], acc[tp]); }
        }
#pragma unroll
        for (int tp = 0; tp < 16; ++tp) { yb[(2 * tp) * CW + c] = acc[tp].x; yb[(2 * tp + 1) * CW + c] = acc[tp].y; }
        __syncthreads();
#pragma unroll
        for (int q = 0; q < 4; ++q) {
            const int t = wid * 4 + q;
            f32x4 v0 = *(const f32x4*)(yb + t * CW + 8 * lane), v1 = *(const f32x4*)(yb + t * CW + 8 * lane + 4);
            const float mean = wave_sum((v0[0] + v0[1]) + (v0[2] + v0[3]) + (v1[0] + v1[1]) + (v1[2] + v1[3])) * (1.0f / CW);
            v0 = v0 - mean; v1 = v1 - mean;
            const float var = wave_sum((v0[0] * v0[0] + v0[1] * v0[1]) + (v0[2] * v0[2] + v0[3] * v0[3]) + (v1[0] * v1[0] + v1[1] * v1[1]) + (v1[2] * v1[2] + v1[3] * v1[3])) * (1.0f / CW);
            const float rstd = rsqrtf(var + LN_EPS);
            f32x4 r0 = v0 * rstd * g0 + b0, r1 = v1 * rstd * g1 + b1;
#pragma unroll
            for (int e = 0; e < 4; ++e) { r0[e] = siluf_(r0[e]); r1[e] = siluf_(r1[e]); }
            store8_bf16(AC + (size_t)(t0 + t) * DM + 512 + 8 * lane, r0, r1);
        }
    }
}

__device__ __forceinline__ void phase_mixer(const Args& a, unsigned char* lds, int G) {
    if (!(a.flags & 2)) for (int u = blockIdx.x; u < NB * 32 * NKVH; u += G) attn_unit(a, lds, u);
    if (!(a.flags & 4)) phase_conv(a, lds, G);
}

struct SchedWo {
    XcdSplit xs; unsigned A, Bt;
    __device__ __forceinline__ bool next(int i, pg::Unit& u) const {
        int idx; if (!xs.unit(i, idx)) return false; int pm, pn; dense_pmpn(idx, 4, pm, pn);
        u.a = A + (unsigned)pm * 256 * 2048; u.r0 = pm * 256; u.c = pn; u.aux = 0; u.nv = 0;
        u.b0 = Bt + (unsigned)(256 * pn) * 2048; u.b1 = u.b0 + 128 * 2048; return true; }
    __device__ __forceinline__ int row(const pg::Unit&, int) const { return 0; }
};
struct EpiWo {
    static constexpr int NST = 16;
    const float* mod; bf16* mix;
    __device__ __forceinline__ void operator()(const acc_t& acc, const pg::Unit& u, int wr, int wc, int fr, int fq) const {
        const int row0 = u.r0 + wr * 64 + fr, bb = u.r0 >> 12, col0 = 256 * u.c + wc * 32 + 8 * fq;
        f32x4 g[2][2];
#pragma unroll
        for (int bj = 0; bj < 2; ++bj)
#pragma unroll
            for (int n = 0; n < 2; ++n) g[bj][n] = *(const f32x4*)(mod + bb * 6144 + 2048 + col0 + 128 * bj + 4 * n) + 1.0f;
#pragma unroll
        for (int ai = 0; ai < 2; ++ai)
#pragma unroll
            for (int m = 0; m < 4; ++m) { bf16* rowp = mix + (size_t)(row0 + ai * 128 + m * 16) * DM + col0;
#pragma unroll
                for (int bj = 0; bj < 2; ++bj) store8_bf16(rowp + 128 * bj, g[bj][0] * acc[ai][bj][m][0], g[bj][1] * acc[ai][bj][m][1]); }
    }
};
__device__ __forceinline__ void phase_wo(const Args& a, unsigned char* lds, int G) {
    SchedWo S{XcdSplit{(T / 256) * 4, G, (int)blockIdx.x}, (unsigned)WS_AC, (unsigned)WS_WOT};
    EpiWo E{(const float*)(a.ws + WS_MOD), (bf16*)(a.ws + WS_MIX)};
    pg::gemm_phase<EpiWo, SchedWo, false>((LAS unsigned char*)lds, a.ws, DM * 2, S, E);
}

__device__ __forceinline__ void phase_ln1(const Args& a, int G) {
    const float* mod = (const float*)(a.ws + WS_MOD); const float* x = a.in[0]; const bf16* mix = (const bf16*)(a.ws + WS_MIX);
    bf16* x1b = (bf16*)(a.ws + WS_X1B); bf16* h2 = (bf16*)(a.ws + WS_H2); unsigned char* h2q = a.ws + WS_H2Q;
    const float* lg = a.in[11]; const float* lb = a.in[12];
    const int lane = threadIdx.x & 63, wid = threadIdx.x >> 6, n0 = 16 * lane;
    f32x4 g4[4], b4[4];
#pragma unroll
    for (int q = 0; q < 4; ++q) { g4[q] = *(const f32x4*)(lg + n0 + 4 * q); b4[q] = *(const f32x4*)(lb + n0 + 4 * q); }
    const int rows_per = (T + G - 1) / G, mbeg = blockIdx.x * rows_per, mend = min(T, mbeg + rows_per);
    int cur_b = -1; f32x4 sc4[4], sh4[4];
    for (int m = mbeg + wid; m < mend; m += NWAVES) {
        const int bb = m >> 12; const float* xr = x + (size_t)m * DM + n0;
        if (bb != cur_b) { cur_b = bb;
#pragma unroll
            for (int q = 0; q < 4; ++q) { sc4[q] = *(const f32x4*)(mod + bb * 6144 + 4096 + n0 + 4 * q) + 1.0f; sh4[q] = *(const f32x4*)(mod + bb * 6144 + 3072 + n0 + 4 * q); } }
        const u32x4 ma = *(const u32x4*)(mix + (size_t)m * DM + n0), mb = *(const u32x4*)(mix + (size_t)m * DM + n0 + 8);
        f32x4 v[4]; float s = 0.f;
#pragma unroll
        for (int q = 0; q < 4; ++q) { const unsigned w0 = (q < 2) ? ma[2 * q] : mb[2 * q - 4], w1 = (q < 2) ? ma[2 * q + 1] : mb[2 * q - 3];
            v[q] = *(const f32x4*)(xr + 4 * q) * ALPHA + (f32x4){bflo(w0), bfhi(w0), bflo(w1), bfhi(w1)}; s += (v[q][0] + v[q][1]) + (v[q][2] + v[q][3]); }
        const float mean = wave_sum(s) * (1.0f / DM); float s2 = 0.f;
#pragma unroll
        for (int q = 0; q < 4; ++q) { v[q] = v[q] - mean; s2 += (v[q][0] * v[q][0] + v[q][1] * v[q][1]) + (v[q][2] * v[q][2] + v[q][3] * v[q][3]); }
        const float rstd = rsqrtf(wave_sum(s2) * (1.0f / DM) + LN_EPS);
        u32x4 xo[2], ho[2], qo;
#pragma unroll
        for (int q = 0; q < 4; ++q) {
            const f32x4 x1 = v[q] * rstd * g4[q] + b4[q];
            const f32x4 hh = x1 * sc4[q] + sh4[q];
            xo[q >> 1][2 * (q & 1)] = pk2(x1[0], x1[1]); xo[q >> 1][2 * (q & 1) + 1] = pk2(x1[2], x1[3]);
            ho[q >> 1][2 * (q & 1)] = pk2(hh[0], hh[1]); ho[q >> 1][2 * (q & 1) + 1] = pk2(hh[2], hh[3]);
            qo[q] = pk4_fp8(hh, 1.0f);
        }
        *(u32x4*)(x1b + (size_t)m * DM + n0) = xo[0]; *(u32x4*)(x1b + (size_t)m * DM + n0 + 8) = xo[1];
        *(u32x4*)(h2 + (size_t)m * DM + n0) = ho[0]; *(u32x4*)(h2 + (size_t)m * DM + n0 + 8) = ho[1];
        *(u32x4*)(h2q + (size_t)m * DM + n0) = qo;
    }
}

struct SchedRs {
    XcdSplit xs; unsigned A, Bt;
    __device__ __forceinline__ bool next(int i, pg::Unit& u) const {
        int idx; if (!xs.unit(i, idx)) return false; int pm, pn; dense_pmpn(idx, 3, pm, pn);
        u.a = A + (unsigned)pm * 256 * 2048; u.r0 = pm * 256; u.c = pn; u.aux = 0; u.nv = 0;
        if (pn == 0) { u.b0 = Bt; u.b1 = Bt + 128 * 2048; }
        else { const int j = pn - 1; u.b0 = Bt + (unsigned)(256 + 128 * j) * 2048; u.b1 = Bt + (unsigned)(512 + 128 * j) * 2048; }
        return true; }
    __device__ __forceinline__ int row(const pg::Unit&, int) const { return 0; }
};
struct EpiRs {
    static constexpr int NST = 8;
    float* logits; bf16* hs;
    __device__ __forceinline__ void operator()(const acc_t& acc, const pg::Unit& u, int wr, int wc, int fr, int fq) const {
        const int row0 = u.r0 + wr * 64 + fr;
        if (u.c == 0) {
#pragma unroll
            for (int ai = 0; ai < 2; ++ai)
#pragma unroll
                for (int m = 0; m < 4; ++m) { float* rowp = logits + (size_t)(row0 + ai * 128 + m * 16) * NE + wc * 32 + 8 * fq;
#pragma unroll
                    for (int bj = 0; bj < 2; ++bj) { *(f32x4*)(rowp + 128 * bj) = acc[ai][bj][m][0]; *(f32x4*)(rowp + 128 * bj + 4) = acc[ai][bj][m][1]; } }
        } else {
            const int j = u.c - 1;
#pragma unroll
            for (int ai = 0; ai < 2; ++ai)
#pragma unroll
                for (int m = 0; m < 4; ++m) { bf16* rowp = hs + (size_t)(row0 + ai * 128 + m * 16) * FE + 128 * j + wc * 32 + 8 * fq;
                    f32x4 r0, r1;
#pragma unroll
                    for (int q = 0; q < 4; ++q) { r0[q] = siluf_(acc[ai][0][m][0][q]) * acc[ai][1][m][0][q]; r1[q] = siluf_(acc[ai][0][m][1][q]) * acc[ai][1][m][1][q]; }
                    store8_bf16(rowp, r0, r1); }
        }
    }
};
__device__ __forceinline__ void phase_rs(const Args& a, unsigned char* lds, int G) {
    SchedRs S{XcdSplit{(T / 256) * 3, G, (int)blockIdx.x}, (unsigned)WS_H2, (unsigned)WS_WCAT};
    EpiRs E{(float*)(a.ws + WS_LOG), (bf16*)(a.ws + WS_HS)};
    pg::gemm_phase<EpiRs, SchedRs, false>((LAS unsigned char*)lds, a.ws, DM * 2, S, E);
    transpose_filler(a, lds, G, 1);
}

#define DPPF(v, ctrl) __int_as_float(__builtin_amdgcn_update_dpp(0, __float_as_int(v), (ctrl), 0xf, 0xf, true))
__device__ __forceinline__ float wave_max_dpp(float v) {
    v = fmaxf(v, DPPF(v, 0xB1)); v = fmaxf(v, DPPF(v, 0x4E)); v = fmaxf(v, DPPF(v, 0x141)); v = fmaxf(v, DPPF(v, 0x140));
    const float r0 = __int_as_float(__builtin_amdgcn_readlane(__float_as_int(v), 0)), r1 = __int_as_float(__builtin_amdgcn_readlane(__float_as_int(v), 16));
    const float r2 = __int_as_float(__builtin_amdgcn_readlane(__float_as_int(v), 32)), r3 = __int_as_float(__builtin_amdgcn_readlane(__float_as_int(v), 48));
    return fmaxf(fmaxf(r0, r1), fmaxf(r2, r3));
}
__device__ __forceinline__ void phase_route(const Args& a, unsigned char* lds, int G) {
    const float* logits = (const float*)(a.ws + WS_LOG); const float* rbias = a.in[14];
    int* gcount = (int*)(a.ws + WS_GCNT); int* rdst = (int*)(a.ws + WS_RDST); float* ew = (float*)(a.ws + WS_EW); int* rer = (int*)(a.ws + WS_RER);
    const int tid = threadIdx.x, lane = tid & 63, wid = tid >> 6;
    int* hist = (int*)lds; int* base = hist + 256; int* pe = hist + 512; float* pw = (float*)(hist + 512 + 2048);
    __syncthreads();
    if (tid < NE) hist[tid] = 0;
    __syncthreads();
    const int chunk = (T + G - 1) / G, tbeg = blockIdx.x * chunk, tend = min(T, tbeg + chunk);
    const f32x4 bv = *(const f32x4*)(rbias + 4 * lane);
    for (int t = tbeg + wid; t < tend; t += NWAVES) {
        const f32x4 lg = *(const f32x4*)(logits + (size_t)t * NE + 4 * lane);
        float sc[4], v[4];
#pragma unroll
        for (int i = 0; i < 4; ++i) { sc[i] = sigmoidf_ref(lg[i]); v[i] = sc[i] + bv[i]; }
        float a1 = fmaxf(v[0], v[1]), a2 = fminf(v[0], v[1]);
        { const float c1 = fmaxf(v[2], v[3]), c2 = fminf(v[2], v[3]); const float n1 = fmaxf(a1, c1), n2 = fmaxf(fminf(a1, c1), fmaxf(a2, c2)); a1 = n1; a2 = n2; }
        { const float c1 = DPPF(a1, 0xB1), c2 = DPPF(a2, 0xB1); const float n1 = fmaxf(a1, c1), n2 = fmaxf(fminf(a1, c1), fmaxf(a2, c2)); a1 = n1; a2 = n2; }
        { const float c1 = DPPF(a1, 0x4E), c2 = DPPF(a2, 0x4E); const float n1 = fmaxf(a1, c1), n2 = fmaxf(fminf(a1, c1), fmaxf(a2, c2)); a1 = n1; a2 = n2; }
        { const float c1 = DPPF(a1, 0x141), c2 = DPPF(a2, 0x141); const float n1 = fmaxf(a1, c1), n2 = fmaxf(fminf(a1, c1), fmaxf(a2, c2)); a1 = n1; a2 = n2; }
        const float gs = a1 + a2; const int mg = lane >> 3; int rank = 0;
#pragma unroll
        for (int g = 0; g < 8; ++g) { const float o = __int_as_float(__builtin_amdgcn_readlane(__float_as_int(gs), 8 * g)); rank += (o > gs || (o == gs && g < mg)) ? 1 : 0; }
        if (rank >= 4) { v[0] = -INFINITY; v[1] = -INFINITY; v[2] = -INFINITY; v[3] = -INFINITY; }
        int my_e = 0; float my_w = 0.f, wsum = 0.f;
#pragma unroll
        for (int r = 0; r < TOPK; ++r) {
            const float m = fmaxf(fmaxf(v[0], v[1]), fmaxf(v[2], v[3]));
            const float M = wave_max_dpp(m);
            const unsigned long long mask = __ballot(m == M);
            const int L = __builtin_amdgcn_readfirstlane((int)__builtin_ctzll(mask));
            const int li = (v[0] == M) ? 0 : (v[1] == M) ? 1 : (v[2] == M) ? 2 : 3;
            const float ls = (li == 0) ? sc[0] : (li == 1) ? sc[1] : (li == 2) ? sc[2] : sc[3];
            const int wi = __builtin_amdgcn_readlane(li, L);
            const float wv = __int_as_float(__builtin_amdgcn_readlane(__float_as_int(ls), L));
            if (lane == L) { if (li == 0) v[0] = -INFINITY; else if (li == 1) v[1] = -INFINITY; else if (li == 2) v[2] = -INFINITY; else v[3] = -INFINITY; }
            wsum += wv;
            if (lane == r) { my_e = 4 * L + wi; my_w = wv; }
        }
        if (lane < TOPK) {
            const int p = (t - tbeg) * TOPK + lane;
            pe[p] = my_e; pw[p] = my_w / wsum * 2.5f;
            atomicAdd(&hist[my_e], 1);
        }
    }
    __syncthreads();
    if (tid < NE) { const int h = hist[tid]; base[tid] = h ? __hip_atomic_fetch_add(&gcount[tid], h, __ATOMIC_RELAXED, __HIP_MEMORY_SCOPE_AGENT) : 0; hist[tid] = 0; }
    __syncthreads();
    const int np = (tend - tbeg) * TOPK;
    for (int i = tid; i < np; i += NTHREADS) {
        const int e = pe[i];
        const int r = base[e] + atomicAdd(&hist[e], 1);
        rdst[(size_t)e * RCAP + r] = tbeg * TOPK + i; ew[tbeg * TOPK + i] = pw[i]; rer[tbeg * TOPK + i] = (e << 16) | r;
    }
}

__device__ __forceinline__ int moe_prefix(const int* gcount, int* pref, int* scr) {
    const int tid = threadIdx.x;
    __syncthreads();
    int nt_e = 0;
    if (tid < NE) { nt_e = (gcount[tid] + 255) >> 8; scr[tid] = nt_e; }
    __syncthreads();
    int cur = 0;
    for (int o = 1; o < NE; o <<= 1) {
        if (tid < NE) scr[(cur ^ 1) * 256 + tid] = scr[cur * 256 + tid] + ((tid >= o) ? scr[cur * 256 + tid - o] : 0);
        cur ^= 1;
        __syncthreads();
    }
    if (tid < NE) { const int incl = scr[cur * 256 + tid]; pref[tid] = incl - nt_e; if (tid == NE - 1) pref[NE] = incl; }
    __syncthreads();
    return pref[NE];
}
__device__ __forceinline__ int moe_tile_expert(const int* pref, int tile) {
    int lo = 0, hi = NE - 1;
    while (lo < hi) { const int mid = (lo + hi + 1) >> 1; if (pref[mid] <= tile) lo = mid; else hi = mid - 1; }
    return lo;
}

constexpr int LIST_OFF = pg::PG_STAGE_BYTES, MAX_LISTS = 12, PREF_OFF = LIST_OFF + MAX_LISTS * 1024, DESC_OFF = PREF_OFF + 1040, MAX_DESC = 48;
struct SchedMoe1 {
    XcdSplit xs; unsigned A, Wg, Wu; const int* desc; const int* lists;
    __device__ __forceinline__ bool next(int i, pg::Unit& u) const {
        int idx; if (!xs.unit(i, idx)) return false; const int e = __builtin_amdgcn_readfirstlane(desc[2 * i]), tile = idx >> 1, j = idx & 1;
        u.a = A; u.r0 = tile * 256; u.c = j; u.aux = i; u.nv = 0;
        u.b0 = Wg + (unsigned)(e * 256 + 128 * j) * 1024; u.b1 = Wu + (unsigned)(e * 256 + 128 * j) * 1024; return true; }
    __device__ __forceinline__ int row(const pg::Unit& u, int r) const { return lists[u.aux * 256 + r]; }
};
struct EpiMoe1 {
    static constexpr int NST = 8;
    unsigned char* H8;
    __device__ __forceinline__ void operator()(const acc_t& acc, const pg::Unit& u, int wr, int wc, int fr, int fq) const {
        const int row0 = u.r0 + wr * 64 + fr;
#pragma unroll
        for (int ai = 0; ai < 2; ++ai)
#pragma unroll
            for (int m = 0; m < 4; ++m) { unsigned char* rowp = H8 + (size_t)(row0 + ai * 128 + m * 16) * FE + 128 * u.c + wc * 32 + 8 * fq;
                f32x4 r0, r1;
#pragma unroll
                for (int q = 0; q < 4; ++q) { r0[q] = siluf_(acc[ai][0][m][0][q]) * acc[ai][1][m][0][q]; r1[q] = siluf_(acc[ai][0][m][1][q]) * acc[ai][1][m][1][q]; }
                u32x2 o; o.x = pk4_fp8(r0, H8_SCALE); o.y = pk4_fp8(r1, H8_SCALE); *(u32x2*)rowp = o; }
    }
};
__device__ __forceinline__ void phase_moe1(const Args& a, unsigned char* lds, int G) {
    const int* gcount = (const int*)(a.ws + WS_GCNT); const int* rdst = (const int*)(a.ws + WS_RDST);
    int* lists = (int*)(lds + LIST_OFF); int* pref = (int*)(lds + PREF_OFF); int* desc = (int*)(lds + DESC_OFF);
    const int ntiles = moe_prefix(gcount, pref, (int*)lds);
    XcdSplit xs{ntiles * 2, G, (int)blockIdx.x};
    for (int i = 0; i < MAX_LISTS; ++i) {
        int idx; if (!xs.unit(i, idx)) break;
        const int tile = idx >> 1, e = moe_tile_expert(pref, tile), tin = tile - pref[e], cnt = gcount[e];
        if (threadIdx.x < 256) { const int pos = tin * 256 + (int)threadIdx.x; lists[i * 256 + threadIdx.x] = (pos < cnt) ? (rdst[(size_t)e * RCAP + pos] >> 3) : 0; }
        if (threadIdx.x == 0) { desc[2 * i] = e; desc[2 * i + 1] = tin; }
    }
    __syncthreads();
    SchedMoe1 S{xs, (unsigned)WS_H2Q, (unsigned)WS_WGT8, (unsigned)WS_WUT8, desc, lists};
    EpiMoe1 E{a.ws + WS_H8};
    pg::gemm_phase<EpiMoe1, SchedMoe1, true, 0, true, 122, 127>((LAS unsigned char*)lds, a.ws, DM, S, E);
}

struct SchedMoe2 {
    XcdSplit xs; unsigned Hb, Wd; const int* desc;
    __device__ __forceinline__ bool next(int i, pg::Unit& u) const {
        int idx; if (!xs.unit(i, idx)) return false;
        const int tile = idx >> 2, jn = idx & 3, e = __builtin_amdgcn_readfirstlane(desc[2 * i]), nv = __builtin_amdgcn_readfirstlane(desc[2 * i + 1]);
        u.a = Hb + (unsigned)tile * 256 * 256; u.r0 = tile * 256; u.c = jn; u.aux = e; u.nv = nv;
        u.b0 = Wd + (unsigned)(e * 1024 + 256 * jn) * 256; u.b1 = u.b0 + 8 * 256;
        return true; }
    __device__ __forceinline__ int row(const pg::Unit&, int) const { return 0; }
};
struct SchedSd {
    XcdSplit xs; unsigned hs, Wds;
    __device__ __forceinline__ bool next(int i, pg::Unit& u) const {
        int idx; if (!xs.unit(i, idx)) return false; int pm, pn; dense_pmpn(idx, 4, pm, pn);
        u.a = hs + (unsigned)pm * 256 * 512; u.r0 = pm * 256; u.c = pn; u.aux = -1; u.nv = 0;
        u.b0 = Wds + (unsigned)(256 * pn) * 512; u.b1 = u.b0 + 8 * 512;
        return true; }
    __device__ __forceinline__ int row(const pg::Unit&, int) const { return 0; }
};
struct EpiMoe2 {
    static constexpr int NST = 8;
    unsigned char* Y; bf16* SD; int flags;
    __device__ __forceinline__ void operator()(const acc_t& acc, const pg::Unit& u, int wr, int wc, int fr, int fq) const {
        const int col0 = 256 * u.c + wc * 64 + 16 * fq, row0 = u.r0 + wr * 64 + fr;
        if (u.aux >= 0) {
#pragma unroll
            for (int ai = 0; ai < 2; ++ai)
#pragma unroll
                for (int m = 0; m < 4; ++m) {
                    u32x4 o; o.x = pk4_fp8(acc[ai][0][m][0], Y_SCALE); o.y = pk4_fp8(acc[ai][0][m][1], Y_SCALE); o.z = pk4_fp8(acc[ai][1][m][0], Y_SCALE); o.w = pk4_fp8(acc[ai][1][m][1], Y_SCALE);
                    if (!(flags & 1)) *(u32x4*)(Y + (size_t)(row0 + ai * 128 + m * 16) * DM + col0) = o; }
        } else {
#pragma unroll
            for (int ai = 0; ai < 2; ++ai)
#pragma unroll
                for (int m = 0; m < 4; ++m) { bf16* rowp = SD + (size_t)(row0 + ai * 128 + m * 16) * DM + col0;
#pragma unroll
                    for (int bj = 0; bj < 2; ++bj) store8_bf16(rowp + 8 * bj, acc[ai][bj][m][0], acc[ai][bj][m][1]); }
        }
    }
};
__device__ __forceinline__ void phase_moe2(const Args& a, unsigned char* lds, int G) {
    const int* gcount = (const int*)(a.ws + WS_GCNT);
    int* pref = (int*)(lds + PREF_OFF); int* desc = (int*)(lds + DESC_OFF);
    const int ntiles = moe_prefix(gcount, pref, (int*)lds);
    const int NU2 = ntiles * 4;
    XcdSplit xs{NU2, G, (int)blockIdx.x};
    if (threadIdx.x == 0) {
        for (int i = 0; i < MAX_DESC; ++i) { int idx; if (!xs.unit(i, idx)) break;
            const int e = moe_tile_expert(pref, idx >> 2); desc[2 * i] = e; desc[2 * i + 1] = gcount[e]; }
    }
    __syncthreads();
    EpiMoe2 E{(unsigned char*)(a.ws + WS_Y), (bf16*)(a.ws + WS_SD), a.flags};
    { SchedMoe2 S{xs, (unsigned)WS_H8, (unsigned)WS_WDT8, desc};
      pg::gemm_phase<EpiMoe2, SchedMoe2, false, 1, true, 122, 124>((LAS unsigned char*)lds, a.ws, FE, S, E); }
    { SchedSd S{XcdSplit{(T / 256) * 4, G, (int)blockIdx.x}, (unsigned)WS_HS, (unsigned)WS_WDST};
      pg::gemm_phase<EpiMoe2, SchedSd, false, 1>((LAS unsigned char*)lds, a.ws, FE * 2, S, E); }
}

__device__ __forceinline__ void phase_final(const Args& a, unsigned char* lds, int G) {
    const float* mod = (const float*)(a.ws + WS_MOD); float* out = a.out;
    const bf16* SD = (const bf16*)(a.ws + WS_SD); const unsigned char* Y = (const unsigned char*)(a.ws + WS_Y); const bf16* x1b = (const bf16*)(a.ws + WS_X1B);
    const int* rer = (const int*)(a.ws + WS_RER); const float* ew = (const float*)(a.ws + WS_EW);
    const float* lg = a.in[21]; const float* lb = a.in[22];
    int* pref = (int*)(lds + PREF_OFF);
    (void)moe_prefix((const int*)(a.ws + WS_GCNT), pref, (int*)lds);
    const int lane = threadIdx.x & 63, wid = threadIdx.x >> 6, n0 = 16 * lane;
    const int rows_per = (T + G - 1) / G, mbeg = blockIdx.x * rows_per, mend = min(T, mbeg + rows_per);
    const int m0 = mbeg + wid, mstep = NWAVES;
    int nq = 0; float nw = 0.f;
    if (lane < TOPK && m0 < mend) { nq = rer[(size_t)m0 * TOPK + lane]; nw = ew[(size_t)m0 * TOPK + lane]; }
    f32x4 lg4[4], lb4[4], g24[4]; int cur_b = -1;
#pragma unroll
    for (int q = 0; q < 4; ++q) { lg4[q] = *(const f32x4*)(lg + n0 + 4 * q); lb4[q] = *(const f32x4*)(lb + n0 + 4 * q); }
    for (int m = m0; m < mend; m += mstep) {
        const int bb = m >> 12; float* rowp = out + (size_t)m * DM + n0;
        if (bb != cur_b) { cur_b = bb;
#pragma unroll
            for (int q = 0; q < 4; ++q) g24[q] = *(const f32x4*)(mod + bb * 6144 + 5120 + n0 + 4 * q) + 1.0f; }
        const int myrow = pref[nq >> 16] * 256 + (nq & 0xffff); const float myw = nw * (1.0f / Y_SCALE);
        if (lane < TOPK && m + mstep < mend) { nq = rer[(size_t)(m + mstep) * TOPK + lane]; nw = ew[(size_t)(m + mstep) * TOPK + lane]; }
        u32x4 yw[TOPK]; float wk[TOPK];
#pragma unroll
        for (int k = 0; k < TOPK; ++k) { const int r = __builtin_amdgcn_readlane(myrow, k); wk[k] = __int_as_float(__builtin_amdgcn_readlane(__float_as_int(myw), k)); yw[k] = *(const u32x4*)(Y + (size_t)r * DM + n0); }
        const u32x4 sa = *(const u32x4*)(SD + (size_t)m * DM + n0), sb = *(const u32x4*)(SD + (size_t)m * DM + n0 + 8);
        const u32x4 xa = *(const u32x4*)(x1b + (size_t)m * DM + n0), xb = *(const u32x4*)(x1b + (size_t)m * DM + n0 + 8);
        f32x4 f[4];
#pragma unroll
        for (int q = 0; q < 4; ++q) f[q] = (f32x4){0.f, 0.f, 0.f, 0.f};
#pragma unroll
        for (int k = 0; k < TOPK; ++k)
#pragma unroll
            for (int q = 0; q < 4; ++q) { const int w = (int)yw[k][q]; const f32x2v lo = __builtin_amdgcn_cvt_pk_f32_fp8(w, false), hi = __builtin_amdgcn_cvt_pk_f32_fp8(w, true);
                f[q][0] += wk[k] * lo.x; f[q][1] += wk[k] * lo.y; f[q][2] += wk[k] * hi.x; f[q][3] += wk[k] * hi.y; }
        f32x4 v[4]; float s = 0.f;
#pragma unroll
        for (int q = 0; q < 4; ++q) {
            const unsigned s0 = (q < 2) ? sa[2 * q] : sb[2 * q - 4], s1 = (q < 2) ? sa[2 * q + 1] : sb[2 * q - 3];
            const unsigned x0 = (q < 2) ? xa[2 * q] : xb[2 * q - 4], x1w = (q < 2) ? xa[2 * q + 1] : xb[2 * q - 3];
            const f32x4 ffn = f[q] + (f32x4){bflo(s0), bfhi(s0), bflo(s1), bfhi(s1)};
            const f32x4 x1 = (f32x4){bflo(x0), bfhi(x0), bflo(x1w), bfhi(x1w)};
            v[q] = x1 * ALPHA + g24[q] * ffn;
            s += (v[q][0] + v[q][1]) + (v[q][2] + v[q][3]);
        }
        const float mean = wave_sum(s) * (1.0f / DM); float s2 = 0.f;
#pragma unroll
        for (int q = 0; q < 4; ++q) { v[q] = v[q] - mean; s2 += (v[q][0] * v[q][0] + v[q][1] * v[q][1]) + (v[q][2] * v[q][2] + v[q][3] * v[q][3]); }
        const float rstd = rsqrtf(wave_sum(s2) * (1.0f / DM) + LN_EPS);
#pragma unroll
        for (int q = 0; q < 4; ++q) *(f32x4*)(rowp + 4 * q) = v[q] * rstd * lg4[q] + lb4[q];
    }
}

constexpr int NPHASES = 11;
__global__ void __launch_bounds__(NTHREADS, 2) fwd_kernel(Args a) {
    extern __shared__ __attribute__((aligned(16))) unsigned char lds[];
    const int G = gridDim.x;
    volatile LAS unsigned* misc = (volatile LAS unsigned*)(LAS unsigned char*)(lds + LDS_BYTES - 64);
    if (threadIdx.x < 16) misc[threadIdx.x] = 0u;
    __syncthreads();
    XcdBarrier bar; bar.bar = (unsigned*)(a.ws + WS_CTL); bar.x = 0; bar.st = nullptr;
    const bool multi = (a.ph_hi - a.ph_lo) > 1;
    if (multi) bar = xcd_barrier_post((unsigned*)(a.ws + WS_CTL), misc);
#define IN(k) (a.ph_lo <= (k) && (k) < a.ph_hi)
#define SEAM(k) do { if (IN(k) && IN((k) + 1)) xcd_barrier(bar); } while (0)
#ifndef REPEAT_MASK
#define REPEAT_MASK 0
#endif
#define REP(k, call) do { if (IN(k)) { call; if ((REPEAT_MASK >> (k)) & 1) { xcd_barrier(bar); Args a2 = a; a2.flags = PROBE_FLAGS; { const Args& a = a2; call; } } } } while (0)
#ifndef PROBE_FLAGS
#define PROBE_FLAGS 0
#endif
    REP(0, phase_prep(a, lds, G));
    SEAM(0);
    REP(1, phase_hmod(a, G));
    SEAM(1);
    REP(2, phase_proj(a, lds, G));
    SEAM(2);
    REP(3, phase_mixer(a, lds, G));
    SEAM(3);
    REP(4, phase_wo(a, lds, G));
    SEAM(4);
    REP(5, phase_ln1(a, G));
    SEAM(5);
    REP(6, phase_rs(a, lds, G));
    SEAM(6);
    REP(7, phase_route(a, lds, G));
    SEAM(7);
    REP(8, phase_moe1(a, lds, G));
    SEAM(8);
    REP(9, phase_moe2(a, lds, G));
    SEAM(9);
    REP(10, phase_final(a, lds, G));
#undef IN
#undef SEAM
}

extern "C" void kernel_launch(void* const* d_in, const int* in_sizes, int n_in, void* d_out, int out_size, void* d_ws, size_t ws_size, hipStream_t stream) {
    static int grid = 0;
    if (grid == 0) {
        if (n_in != 23 || out_size != T * DM || ws_size < WS_END) { fprintf(stderr, "kernel_launch: unexpected shapes (n_in %d out %d ws %zu)\n", n_in, out_size, ws_size); grid = -1; return; }
        int dev = 0, cus = 0;
        if (hipGetDevice(&dev) != hipSuccess || hipDeviceGetAttribute(&cus, hipDeviceAttributeMultiprocessorCount, dev) != hipSuccess) { grid = -1; return; }
        if (hipFuncSetAttribute((const void*)fwd_kernel, hipFuncAttributeMaxDynamicSharedMemorySize, LDS_BYTES) != hipSuccess) { fprintf(stderr, "kernel_launch: hipFuncSetAttribute failed\n"); grid = -1; return; }
        int per_cu = 0;
        (void)hipOccupancyMaxActiveBlocksPerMultiprocessor(&per_cu, (const void*)fwd_kernel, NTHREADS, LDS_BYTES);
        (void)hipGetLastError();
        grid = cus > 512 ? 512 : cus;
        if (per_cu < 1) fprintf(stderr, "kernel_launch: occupancy query reports %d blocks per CU\n", per_cu);
    }
    if (grid < 0) return;
    (void)hipMemsetAsync((char*)d_ws + WS_CTL, 0, CTL_ZERO_BYTES, stream);
    Args a{};
    for (int i = 0; i < 23; ++i) a.in[i] = (const float*)d_in[i];
    a.out = (float*)d_out; a.ws = (unsigned char*)d_ws;
#if N_LAUNCH_MODE == 1
    a.ph_lo = 0; a.ph_hi = NPHASES;
    hipLaunchKernelGGL(fwd_kernel, dim3(grid), dim3(NTHREADS), LDS_BYTES, stream, a);
#else
    for (int p = 0; p < NPHASES; ++p) { a.ph_lo = p; a.ph_hi = p + 1; hipLaunchKernelGGL(fwd_kernel, dim3(grid), dim3(NTHREADS), LDS_BYTES, stream, a); }
#endif
}
```

```cpp
#include <hip/hip_runtime.h>
#include <cstdio>
#include <cstdint>

#define LAS __attribute__((address_space(3)))
typedef unsigned short bf16;
typedef short bf16x8 __attribute__((ext_vector_type(8)));
typedef short bf16x4v __attribute__((ext_vector_type(4)));
typedef float f32x4 __attribute__((ext_vector_type(4)));
typedef unsigned u32x4 __attribute__((ext_vector_type(4)));
typedef unsigned u32x2 __attribute__((ext_vector_type(2)));
typedef float f32x2v __attribute__((ext_vector_type(2)));

#ifndef N_LAUNCH_MODE
#define N_LAUNCH_MODE 1
#endif

constexpr int NB = 8, SEQ = 4096, DM = 1024, T = NB * SEQ;
constexpr int HD = 64, NQH = 8, NKVH = 2;
constexpr int INC = 1792, QW = 1280;
constexpr int NE = 256, TOPK = 8, FE = 256;
constexpr int CK = 31, CW = 512;
constexpr int BM = 256, BN = 128;
constexpr int MAXROWS = T * TOPK + NE * BM;
constexpr int MAXTILES = MAXROWS / BM;
constexpr float LN_EPS = 1e-5f;
constexpr float ALPHA = 1.18920711500272106672f;
constexpr int NTHREADS = 512, NWAVES = 8;
constexpr int LDS_BYTES = 147456;

constexpr size_t MiB = 1u << 20;
constexpr size_t WS_CTL = 0, CTL_ZERO_BYTES = 64 * 1024;
constexpr size_t WS_MOD = 1 * MiB;
constexpr size_t WS_WINT = 12 * MiB;
constexpr size_t WS_WOT = 16 * MiB;
constexpr size_t WS_WCAT = 18 * MiB;
constexpr size_t WS_WDST = 20 * MiB;
constexpr size_t WS_WDT8 = 24 * MiB;
constexpr size_t WS_H8 = 88 * MiB;
constexpr size_t WS_HS = 168 * MiB;
constexpr size_t WS_SD = 184 * MiB;
constexpr size_t WS_X1B = 248 * MiB;
constexpr size_t WS_RDST = 312 * MiB;
constexpr size_t WS_Y = 344 * MiB;
constexpr size_t WS_WGT8 = 344 * MiB;
constexpr size_t WS_WUT8 = 408 * MiB;
constexpr size_t WS_H2Q = 472 * MiB;
constexpr size_t WS_LOG = 504 * MiB;
constexpr size_t WS_H2 = 600 * MiB;
constexpr size_t WS_QKVG = 664 * MiB;
constexpr size_t WS_MIX = 664 * MiB;
constexpr size_t WS_AC = 744 * MiB;
constexpr size_t WS_EW = 2 * MiB;
constexpr size_t WS_RER = 3 * MiB;
constexpr size_t WS_END = 808 * MiB;
constexpr size_t WS_GCNT = 32768;
constexpr int RCAP = T;

__device__ __forceinline__ unsigned f2bf(float f) { unsigned u = __float_as_uint(f); return (u + 0x7fffu + ((u >> 16) & 1u)) >> 16; }
__device__ __forceinline__ unsigned pk2(float lo, float hi) { unsigned r; asm volatile("v_cvt_pk_bf16_f32 %0, %1, %2" : "=v"(r) : "v"(lo), "v"(hi)); return r; }
__device__ __forceinline__ float bf2f(unsigned h) { return __uint_as_float(h << 16); }
__device__ __forceinline__ float bflo(unsigned w) { return __uint_as_float(w << 16); }
__device__ __forceinline__ float bfhi(unsigned w) { return __uint_as_float(w & 0xffff0000u); }
__device__ __forceinline__ float sigmoidf_(float v) { return __builtin_amdgcn_rcpf(1.0f + __builtin_amdgcn_exp2f(-1.44269504089f * v)); }
__device__ __forceinline__ float sigmoidf_ref(float v) { return 1.0f / (1.0f + __expf(-v)); }
__device__ __forceinline__ float siluf_(float v) { return v * __builtin_amdgcn_rcpf(1.0f + __builtin_amdgcn_exp2f(-1.44269504089f * v)); }
__device__ __forceinline__ float wave_sum(float v) {
#pragma unroll
    for (int o = 1; o < 64; o <<= 1) v += __shfl_xor(v, o);
    return v;
}
__device__ __forceinline__ int perm32(int rho) { const int n = rho >> 4, i = rho & 15; return 8 * (i >> 2) + 4 * n + (i & 3); }

#define XB_TMO      128
#define XB_XCNT(j)  (256  + 64 * (j))
#define XB_XSUB(j)  (1280 + 64 * (j))
#define XB_XGEN(j)  (2304 + 64 * (j))
#define XB_TOP      3328
#define XB_TOPGEN   3392
#define XCD_BAR_WORDS 3456
#define XB_SPIN_CAP (1u << 22)
__device__ __forceinline__ unsigned xb_ld(unsigned* p)              { return __hip_atomic_load(p, __ATOMIC_RELAXED, __HIP_MEMORY_SCOPE_AGENT); }
__device__ __forceinline__ unsigned xb_add(unsigned* p, unsigned v) { return __hip_atomic_fetch_add(p, v, __ATOMIC_RELAXED, __HIP_MEMORY_SCOPE_AGENT); }
__device__ __forceinline__ unsigned xb_xcc_id() { return (unsigned)__builtin_amdgcn_s_getreg((3 << 11) | 20) & 0xFu; }
#define XB_SPIN(cond, bar) do { unsigned _sp = 0; while (cond) { __builtin_amdgcn_s_sleep(1); \
    if ((++_sp & 255u) == 0u) { if (xb_ld(&(bar)[XB_TMO])) break; if (_sp > XB_SPIN_CAP) { atomicAdd(&(bar)[XB_TMO], 1u); break; } } } } while (0)
struct XcdBarrier { unsigned* bar; unsigned x; volatile LAS unsigned* st; };
__device__ __forceinline__ XcdBarrier xcd_barrier_post(unsigned* bar, volatile LAS unsigned* st) {
    XcdBarrier b; b.bar = bar; b.x = xb_xcc_id(); b.st = st;
    if (threadIdx.x == 0) (void)xb_add(&bar[XB_XCNT(b.x)], 1u);
    return b;
}
__device__ __forceinline__ void xcd_barrier_complete(unsigned* bar, unsigned x, unsigned& nloc, unsigned& nx) {
    const unsigned G = gridDim.x * gridDim.y * gridDim.z;
    unsigned sum, cnt, mine, sp = 0u;
    for (;;) {
        sum = 0u; cnt = 0u; mine = 0u;
#pragma unroll
        for (unsigned j = 0; j < 16; ++j) { const unsigned c = xb_ld(&bar[XB_XCNT(j)]); sum += c; cnt += (c > 0u) ? 1u : 0u; mine = (j == x) ? c : mine; }
        if (sum == G) break;
        __builtin_amdgcn_s_sleep(1);
        if ((++sp & 255u) == 0u) { if (xb_ld(&bar[XB_TMO])) break; if (sp > XB_SPIN_CAP) { atomicAdd(&bar[XB_TMO], 1u); break; } }
    }
    nloc = mine > 0u ? mine : 1u; nx = cnt > 0u ? cnt : 1u;
}
__device__ __forceinline__ void xcd_barrier(const XcdBarrier& b) {
    asm volatile("s_waitcnt vmcnt(0)" ::: "memory");
    __syncthreads();
    if (threadIdx.x == 0) {
        unsigned* bar = b.bar;
        __builtin_amdgcn_s_waitcnt(0);
        unsigned nloc = b.st[0], nx = b.st[1];
        if (nloc == 0u) { xcd_barrier_complete(bar, b.x, nloc, nx); b.st[0] = nloc; b.st[1] = nx; }
        const unsigned old = xb_add(&bar[XB_XSUB(b.x)], 1u);
        const unsigned gen = old / nloc;
        if (old + 1u == (gen + 1u) * nloc) {
            __builtin_amdgcn_fence(__ATOMIC_RELEASE, "agent");
            asm volatile("s_waitcnt vmcnt(0)" ::: "memory");
            const unsigned og = xb_add(&bar[XB_TOP], 1u);
            const unsigned tg = og / nx;
            if (og + 1u == (tg + 1u) * nx) xb_add(&bar[XB_TOPGEN], 1u);
            else XB_SPIN(xb_ld(&bar[XB_TOPGEN]) == tg, bar);
            __builtin_amdgcn_fence(__ATOMIC_ACQUIRE, "agent");
            xb_add(&bar[XB_XGEN(b.x)], 1u);
            asm volatile("s_waitcnt vmcnt(0)" ::: "memory");
        } else {
            XB_SPIN(xb_ld(&bar[XB_XGEN(b.x)]) == gen, bar);
            __builtin_amdgcn_fence(__ATOMIC_ACQUIRE, "agent");
            asm volatile("s_waitcnt vmcnt(0)" ::: "memory");
        }
    }
    __syncthreads();
}

struct Args {
    const float* in[23];
    float* out;
    unsigned char* ws;
    int ph_lo, ph_hi, flags, pad;
};

namespace pg {
constexpr int HALF = 128, HTB = HALF * 64 * 2, PG_STAGE_BYTES = 8 * HTB;
__device__ __forceinline__ int lds_byte(int r, int c) { const int st = (r >> 4) * 2 + (c >> 5), rr = r & 15, cc = c & 31, ob = rr * 64 + cc * 2; return st * 1024 + (ob ^ (((ob >> 9) & 1) << 5)); }
__device__ __forceinline__ void stage_rc(int b, int& R, int& C) { const int st = b / 1024, sb = b % 1024, swz = sb ^ (((sb >> 9) & 1) << 5); R = (st >> 1) * 16 + swz / 64; C = (st & 1) * 32 + (swz % 64) / 2; }
struct Unit { unsigned a, b0, b1; int r0, c, aux, nv; };
typedef int i32x8 __attribute__((ext_vector_type(8)));
typedef int i32x4 __attribute__((ext_vector_type(4)));
__device__ __forceinline__ bf16x8 lo8(const i32x8& v) { return __builtin_bit_cast(bf16x8, (i32x4)__builtin_shufflevector(v, v, 0, 1, 2, 3)); }
__device__ __forceinline__ bf16x8 hi8(const i32x8& v) { return __builtin_bit_cast(bf16x8, (i32x4)__builtin_shufflevector(v, v, 4, 5, 6, 7)); }
__device__ __forceinline__ i32x8 cat8(const bf16x8 lo, const bf16x8 hi) { const i32x4 a = __builtin_bit_cast(i32x4, lo), b = __builtin_bit_cast(i32x4, hi); return __builtin_shufflevector(a, b, 0, 1, 2, 3, 4, 5, 6, 7); }
typedef __amdgpu_buffer_rsrc_t rsrc_t;

template <class Epi, class Sched, bool GATHER, int BMAP = 0, bool F8 = false, int SCW = 127, int SCA = 127>
__device__ __forceinline__ void gemm_phase(LAS unsigned char* lds, unsigned char* wsbase, const int ROWB, const Sched& S, const Epi& E) {
    const rsrc_t rs = __builtin_amdgcn_make_buffer_rsrc((void*)wsbase, 0, 0x7fffffff, 0x00020000);
    const int tid = threadIdx.x, wid = __builtin_amdgcn_readfirstlane(tid >> 6), lane = tid & 63, wr = wid >> 2, wc = wid & 3, fr = lane & 15, fq = lane >> 4;
    int nt = ROWB / 128; asm volatile("" : "+s"(nt));
    int Rr[2], Cc[2]; unsigned voffB[2], vA[2][2], nvA[2][2];
#pragma unroll
    for (int i = 0; i < 2; ++i) { stage_rc(tid * 16 + i * 8192, Rr[i], Cc[i]); const int Rb = BMAP ? (64 * (Rr[i] >> 5) + 16 * ((Rr[i] & 15) >> 2) + 4 * ((Rr[i] >> 4) & 1) + (Rr[i] & 3)) : ((Rr[i] & ~31) + perm32(Rr[i] & 31)); voffB[i] = (unsigned)(Rb * ROWB + Cc[i] * 2); }
    const unsigned kstep = 128;
    const unsigned ldsw = (unsigned)wid * 1024u;
    const int aoff = lds_byte(wr * 64 + fr, fq * 8), boff = lds_byte(wc * 32 + fr, fq * 8);
#define PG_SA(b, h) (((b) * 2 + (h)) * pg::HTB)
#define PG_SB(b, h) ((4 + (b) * 2 + (h)) * pg::HTB)
#define PG_STG(bufoff, gbase, v0, v1) do { \
        __builtin_amdgcn_raw_ptr_buffer_load_lds(rs, (LAS unsigned*)(lds + (bufoff) + ldsw), 16, (int)(v0), (int)(gbase), 0, 0); \
        __builtin_amdgcn_raw_ptr_buffer_load_lds(rs, (LAS unsigned*)(lds + (bufoff) + ldsw + 8192), 16, (int)(v1), (int)(gbase), 0, 0); } while (0)
#define PG_STGB(bufoff, gbase) PG_STG(bufoff, gbase, voffB[0], voffB[1])
#define PG_LD16(off) (*(const LAS bf16x8*)(lds + (off)))
#define PG_LDA(dst, b, h) do { _Pragma("unroll") for (int m = 0; m < 4; ++m) dst[m] = pg::cat8(PG_LD16(PG_SA(b, h) + aoff + m * 2048), PG_LD16(PG_SA(b, h) + aoff + m * 2048 + 1024)); } while (0)
#define PG_LDB(dst, b, h) do { _Pragma("unroll") for (int n = 0; n < 2; ++n) dst[n] = pg::cat8(PG_LD16(PG_SB(b, h) + boff + n * 2048), PG_LD16(PG_SB(b, h) + boff + n * 2048 + 1024)); } while (0)
#define PG_MMA(ai, bj, At, Bt) do { __builtin_amdgcn_s_setprio(1); \
        if (F8) { _Pragma("unroll") for (int m = 0; m < 4; ++m) _Pragma("unroll") for (int n = 0; n < 2; ++n) \
            asm volatile("v_mfma_scale_f32_16x16x128_f8f6f4 %0, %1, %2, %0, %3, %4 op_sel_hi:[0,0,0]" : "+v"(acc[ai][bj][m][n]) : "v"(Bt[n]), "v"(At[m]), "v"(scw), "v"(sca)); } \
        else { _Pragma("unroll") for (int m = 0; m < 4; ++m) _Pragma("unroll") for (int n = 0; n < 2; ++n) { \
            acc[ai][bj][m][n] = __builtin_amdgcn_mfma_f32_16x16x32_bf16(pg::lo8(Bt[n]), pg::lo8(At[m]), acc[ai][bj][m][n], 0, 0, 0); \
            acc[ai][bj][m][n] = __builtin_amdgcn_mfma_f32_16x16x32_bf16(pg::hi8(Bt[n]), pg::hi8(At[m]), acc[ai][bj][m][n], 0, 0, 0); } } \
        __builtin_amdgcn_s_setprio(0); } while (0)
#define PG_WAIT_V(n) asm volatile("s_waitcnt vmcnt(" #n ")" ::: "memory")
#define PG_WAIT_L(n) asm volatile("s_waitcnt lgkmcnt(" #n ")" ::: "memory")
#define PG_BAR __builtin_amdgcn_s_barrier()
#define PG_SCHED __builtin_amdgcn_sched_barrier(0)
#define PG_VA(dst, u) do { _Pragma("unroll") for (int h = 0; h < 2; ++h) _Pragma("unroll") for (int i = 0; i < 2; ++i) \
        dst[h][i] = GATHER ? (unsigned)(S.row(u, h * pg::HALF + Rr[i]) * ROWB + Cc[i] * 2) : (unsigned)((h * pg::HALF + Rr[i]) * ROWB + Cc[i] * 2); } while (0)
    Unit cur, nxt; int ui = 0;
    if (!S.next(0, cur)) return;
    f32x4 acc[2][2][4][2];
#pragma unroll
    for (int a = 0; a < 2; ++a)
#pragma unroll
        for (int b = 0; b < 2; ++b)
#pragma unroll
            for (int m = 0; m < 4; ++m)
#pragma unroll
                for (int n = 0; n < 2; ++n) acc[a][b][m][n] = (f32x4){0.f, 0.f, 0.f, 0.f};
    pg::i32x8 At[4], B0[2], B1[2];
    int scw = SCW * 0x01010101, sca = SCA * 0x01010101; asm volatile("" : "+v"(scw), "+v"(sca));
    PG_VA(vA, cur);
#pragma unroll
    for (int h = 0; h < 2; ++h)
#pragma unroll
        for (int i = 0; i < 2; ++i) nvA[h][i] = vA[h][i];
    unsigned cA = cur.a, cB0 = cur.b0, cB1 = cur.b1;
    PG_STGB(PG_SB(0, 0), cB0); PG_STGB(PG_SB(0, 1), cB1); PG_STG(PG_SA(0, 0), cA, vA[0][0], vA[0][1]); PG_STG(PG_SA(0, 1), cA, vA[1][0], vA[1][1]);
    if (wr == 1) PG_BAR;
    PG_WAIT_V(2); PG_BAR;
    PG_STGB(PG_SB(1, 0), cB0 + kstep); PG_STG(PG_SA(1, 0), cA + kstep, vA[0][0], vA[0][1]); PG_STGB(PG_SB(1, 1), cB1 + kstep);
    PG_WAIT_V(6); PG_BAR;
    for (;;) {
        const bool has_next = S.next(ui + 1, nxt);
        const unsigned nA = has_next ? nxt.a : cA, nB0 = has_next ? nxt.b0 : cB0, nB1 = has_next ? nxt.b1 : cB1;
#pragma unroll 1
        for (int t = 0; t < nt; t += 2) {
            const bool last = (t == nt - 2);
            const unsigned a1 = cA + (unsigned)(t + 1) * kstep;
            const unsigned a2 = last ? nA : cA + (unsigned)(t + 2) * kstep;
            const unsigned b20 = last ? nB0 : cB0 + (unsigned)(t + 2) * kstep, b21 = last ? nB1 : cB1 + (unsigned)(t + 2) * kstep;
            const unsigned a3 = a2 + kstep, b30 = b20 + kstep, b31 = b21 + kstep;
            unsigned wA[2][2];
            if (GATHER) {
                if (last && has_next) PG_VA(nvA, nxt);
#pragma unroll
                for (int h = 0; h < 2; ++h)
#pragma unroll
                    for (int i = 0; i < 2; ++i) wA[h][i] = (last && has_next) ? nvA[h][i] : vA[h][i];
            } else {
#pragma unroll
                for (int h = 0; h < 2; ++h)
#pragma unroll
                    for (int i = 0; i < 2; ++i) wA[h][i] = vA[h][i];
            }
            const bool after_epi = (t == 0) && (ui > 0);
            PG_LDB(B0, 0, 0); PG_LDB(B1, 0, 1); PG_SCHED; PG_LDA(At, 0, 0); PG_STG(PG_SA(1, 1), a1, vA[1][0], vA[1][1]);
            if (after_epi && Epi::NST >= 16) PG_WAIT_V(24); else if (after_epi && Epi::NST >= 8) PG_WAIT_V(16); else PG_WAIT_V(8);
            PG_WAIT_L(0); PG_BAR; PG_MMA(0, 0, At, B0); PG_MMA(0, 1, At, B1); PG_BAR; PG_SCHED;
            PG_LDA(At, 0, 1); PG_STGB(PG_SB(0, 0), b20); PG_STGB(PG_SB(0, 1), b21); PG_STG(PG_SA(0, 0), a2, wA[0][0], wA[0][1]);
            if (after_epi && Epi::NST >= 16) PG_WAIT_V(24); else if (after_epi && Epi::NST >= 8) PG_WAIT_V(16); else PG_WAIT_V(8);
            PG_WAIT_L(0); PG_BAR; PG_MMA(1, 0, At, B0); PG_MMA(1, 1, At, B1); PG_BAR; PG_SCHED;
            PG_LDB(B0, 1, 0); PG_LDB(B1, 1, 1); PG_SCHED; PG_LDA(At, 1, 0); PG_STG(PG_SA(0, 1), a2, wA[1][0], wA[1][1]);
            PG_WAIT_V(8); PG_WAIT_L(0); PG_BAR; PG_MMA(0, 0, At, B0); PG_MMA(0, 1, At, B1); PG_BAR; PG_SCHED;
            PG_LDA(At, 1, 1); PG_STGB(PG_SB(1, 0), b30); PG_STGB(PG_SB(1, 1), b31); PG_STG(PG_SA(1, 0), a3, wA[0][0], wA[0][1]);
            PG_WAIT_V(8); PG_WAIT_L(0); PG_BAR; PG_MMA(1, 0, At, B0); PG_MMA(1, 1, At, B1); PG_BAR; PG_SCHED;
        }
        if (F8) asm volatile("s_nop 15\n\ts_nop 15" ::: "memory");
        if (wr == 0) PG_BAR;
        E(acc, cur, wr, wc, fr, fq);
        if (!has_next) break;
#pragma unroll
        for (int a = 0; a < 2; ++a)
#pragma unroll
            for (int b = 0; b < 2; ++b)
#pragma unroll
                for (int m = 0; m < 4; ++m)
#pragma unroll
                    for (int n = 0; n < 2; ++n) acc[a][b][m][n] = (f32x4){0.f, 0.f, 0.f, 0.f};
        cur = nxt; cA = nA; cB0 = nB0; cB1 = nB1; ++ui;
        if (GATHER) {
#pragma unroll
            for (int h = 0; h < 2; ++h)
#pragma unroll
                for (int i = 0; i < 2; ++i) vA[h][i] = nvA[h][i];
        }
        if (wr == 1) PG_BAR;
    }
    PG_WAIT_V(0);
    PG_BAR;
#undef PG_SA
#undef PG_SB
#undef PG_STG
#undef PG_STGB
#undef PG_LD16
#undef PG_LDA
#undef PG_LDB
#undef PG_MMA
#undef PG_WAIT_V
#undef PG_WAIT_L
#undef PG_BAR
#undef PG_SCHED
#undef PG_VA
}
}

struct XcdSplit {
    int NU, G, bx;
    __device__ __forceinline__ bool unit(int i, int& u) const {
        if (G & 7) { u = bx + i * G; return u < NU; }
        const int x = bx & 7, li = bx >> 3, per = G >> 3, q = NU >> 3, r = NU & 7;
        const int start = x * q + (x < r ? x : r), len = q + (x < r ? 1 : 0), k = li + i * per;
        if (k >= len) return false;
        u = start + k; return true;
    }
};
__device__ __forceinline__ void dense_pmpn(int idx, int nN, int& pm, int& pn) { const int nig = 8 * nN, gid = idx / nig, rem = idx % nig; pm = gid * 8 + (rem & 7); pn = rem >> 3; }

__device__ __forceinline__ void store8_bf16(bf16* p, const f32x4& a, const f32x4& b) {
    u32x4 w; w.x = pk2(a[0], a[1]); w.y = pk2(a[2], a[3]); w.z = pk2(b[0], b[1]); w.w = pk2(b[2], b[3]); *(u32x4*)p = w;
}
typedef f32x4 acc_t[2][2][4][2];

__device__ __forceinline__ unsigned pk4_fp8(const f32x4& v, float sc) {
    int w = 0;
    w = __builtin_amdgcn_cvt_pk_fp8_f32(__builtin_amdgcn_fmed3f(v[0] * sc, -440.f, 440.f), __builtin_amdgcn_fmed3f(v[1] * sc, -440.f, 440.f), w, false);
    w = __builtin_amdgcn_cvt_pk_fp8_f32(__builtin_amdgcn_fmed3f(v[2] * sc, -440.f, 440.f), __builtin_amdgcn_fmed3f(v[3] * sc, -440.f, 440.f), w, true);
    return (unsigned)w;
}
constexpr float Y_SCALE = 64.0f;
constexpr float W8_SCALE = 32.0f, H8_SCALE = 8.0f;
__device__ __forceinline__ void transpose_item(const float* src, int K, int N, bf16* dst, int item, float* scr, int lane) {
    const int nblk = N / 64, kb = item / nblk, nb = item % nblk, k0 = kb * 64, n0 = nb * 64;
    const int lr = lane >> 4, lc = (lane & 15) * 4;
    f32x4 v[16];
    const float* sp = src + (size_t)(k0 + lr) * N + n0 + lc;
#pragma unroll
    for (int i = 0; i < 16; ++i) v[i] = __builtin_nontemporal_load((const f32x4*)(sp + (size_t)(4 * i) * N));
#pragma unroll
    for (int i = 0; i < 16; ++i) { float* d = scr + (4 * i + lr) * 65 + lc; d[0] = v[i][0]; d[1] = v[i][1]; d[2] = v[i][2]; d[3] = v[i][3]; }
    asm volatile("s_waitcnt lgkmcnt(0)" ::: "memory");
    const int c = lane & 7;
#pragma unroll
    for (int j = 0; j < 8; ++j) {
        const int n = (lane >> 3) + 8 * j; const float* s = scr + (8 * c) * 65 + n;
        u32x4 o; o.x = pk2(s[0], s[65]); o.y = pk2(s[2 * 65], s[3 * 65]); o.z = pk2(s[4 * 65], s[5 * 65]); o.w = pk2(s[6 * 65], s[7 * 65]);
        *(u32x4*)(dst + (size_t)(n0 + n) * K + k0 + 8 * c) = o;
    }
    asm volatile("s_waitcnt lgkmcnt(0)" ::: "memory");
}

__device__ __forceinline__ void transpose_item_f8(const float* src, int K, int N, unsigned char* dst, int item, float* scr, int lane) {
    const int nblk = N / 64, kb = item / nblk, nb = item % nblk, k0 = kb * 64, n0 = nb * 64;
    const int lr = lane >> 4, lc = (lane & 15) * 4;
    f32x4 v[16];
    const float* sp = src + (size_t)(k0 + lr) * N + n0 + lc;
#pragma unroll
    for (int i = 0; i < 16; ++i) v[i] = __builtin_nontemporal_load((const f32x4*)(sp + (size_t)(4 * i) * N));
#pragma unroll
    for (int i = 0; i < 16; ++i) { float* d = scr + (4 * i + lr) * 65 + lc; d[0] = v[i][0]; d[1] = v[i][1]; d[2] = v[i][2]; d[3] = v[i][3]; }
    asm volatile("s_waitcnt lgkmcnt(0)" ::: "memory");
    const int c = lane & 7;
#pragma unroll
    for (int j = 0; j < 8; ++j) {
        const int n = (lane >> 3) + 8 * j; const float* sx = scr + (8 * c) * 65 + n;
        u32x2 o; o.x = pk4_fp8((f32x4){sx[0], sx[65], sx[2 * 65], sx[3 * 65]}, W8_SCALE); o.y = pk4_fp8((f32x4){sx[4 * 65], sx[5 * 65], sx[6 * 65], sx[7 * 65]}, W8_SCALE);
        *(u32x2*)(dst + (size_t)(n0 + n) * K + k0 + 8 * c) = o;
    }
    asm volatile("s_waitcnt lgkmcnt(0)" ::: "memory");
}

constexpr int TR_I_IN = 16 * 28, TR_I_O = 16 * 16, TR_I_S = 16 * 4, TR_I_DS = 4 * 16, TR_I_E = 16 * 4 * NE;
constexpr int TR_NITEMS = TR_I_IN + TR_I_O + 3 * TR_I_S + TR_I_DS + 3 * TR_I_E;
constexpr int FILL_ITEMS = 7168;
__device__ __forceinline__ void transpose_dispatch(const Args& a, int it, float* scr, int lane) {
    unsigned char* ws = a.ws; int r = it;
    if (r < TR_I_IN) { transpose_item(a.in[4], 1024, INC, (bf16*)(ws + WS_WINT), r, scr, lane); return; } r -= TR_I_IN;
    if (r < TR_I_O) { transpose_item(a.in[10], 1024, 1024, (bf16*)(ws + WS_WOT), r, scr, lane); return; } r -= TR_I_O;
    if (r < TR_I_S) { transpose_item(a.in[13], 1024, 256, (bf16*)(ws + WS_WCAT), r, scr, lane); return; } r -= TR_I_S;
    if (r < TR_I_S) { transpose_item(a.in[18], 1024, 256, (bf16*)(ws + WS_WCAT) + 256 * 1024, r, scr, lane); return; } r -= TR_I_S;
    if (r < TR_I_S) { transpose_item(a.in[19], 1024, 256, (bf16*)(ws + WS_WCAT) + 512 * 1024, r, scr, lane); return; } r -= TR_I_S;
    if (r < TR_I_DS) { transpose_item(a.in[20], 256, 1024, (bf16*)(ws + WS_WDST), r, scr, lane); return; } r -= TR_I_DS;
    if (r < TR_I_E) { const int e = r >> 6; transpose_item_f8(a.in[15] + (size_t)e * 262144, 1024, 256, ws + WS_WGT8 + (size_t)e * 262144, r & 63, scr, lane); return; } r -= TR_I_E;
    if (r < TR_I_E) { const int e = r >> 6; transpose_item_f8(a.in[16] + (size_t)e * 262144, 1024, 256, ws + WS_WUT8 + (size_t)e * 262144, r & 63, scr, lane); return; } r -= TR_I_E;
    { const int e = r >> 6; transpose_item_f8(a.in[17] + (size_t)e * 262144, 256, 1024, ws + WS_WDT8 + (size_t)e * 262144, r & 63, scr, lane); }
}
__device__ __forceinline__ void phase_prep(const Args& a, unsigned char* lds, int G) {
    const int tid = threadIdx.x, lane = tid & 63, wid = tid >> 6, bx = blockIdx.x;
    unsigned char* ws = a.ws;
    {
        float* sc = (float*)lds;
        float* red = (float*)(lds + 32768);
        const float* c = a.in[1]; const float* w_ada = a.in[2]; const float* b_ada = a.in[3];
        float* mod = (float*)(ws + WS_MOD);
        for (int cb = bx; cb < 6144 / 32; cb += G) {
            __syncthreads();
            for (int i = tid; i < 8 * 1024; i += NTHREADS) sc[i] = siluf_(c[i]);
            __syncthreads();
            const int kg = tid >> 5, cl = tid & 31, col = cb * 32 + cl;
            float acc[8];
#pragma unroll
            for (int b = 0; b < 8; ++b) acc[b] = 0.f;
            for (int k = kg; k < 1024; k += 16) {
                const float wv = w_ada[(size_t)k * 6144 + col];
#pragma unroll
                for (int b = 0; b < 8; ++b) acc[b] += sc[b * 1024 + k] * wv;
            }
#pragma unroll
            for (int b = 0; b < 8; ++b) red[(kg * 8 + b) * 32 + cl] = acc[b];
            __syncthreads();
            if (tid < 256) {
                const int b = tid >> 5; float s = 0.f;
#pragma unroll
                for (int g = 0; g < 16; ++g) s += red[(g * 8 + b) * 32 + cl];
                mod[b * 6144 + col] = s + b_ada[col];
            }
        }
        __syncthreads();
    }
    {
        float* scr = (float*)(lds + wid * 16640);
        const int gw = bx * NWAVES + wid, NGW = G * NWAVES;
        for (int it = gw; it < TR_NITEMS - 2 * FILL_ITEMS; it += NGW) transpose_dispatch(a, it, scr, lane);
    }
}
__device__ __forceinline__ void transpose_filler(const Args& a, unsigned char* lds, int G, int part) {
    if ((G & 7) || (int)(blockIdx.x >> 3) < (G >> 4)) return;
    __syncthreads();
    const int lane = threadIdx.x & 63, wid = threadIdx.x >> 6;
    float* scr = (float*)(lds + wid * 16640);
    const int nidle = G >> 1, w = ((int)(blockIdx.x & 7) * (G >> 4) + ((int)(blockIdx.x >> 3) - (G >> 4))) * NWAVES + wid;
    const int base = TR_NITEMS - (2 - part) * FILL_ITEMS;
    for (int it = w; it < FILL_ITEMS; it += nidle * NWAVES) transpose_dispatch(a, base + it, scr, lane);
}

__device__ __forceinline__ void phase_hmod(const Args& a, int G) {
    const float* x = a.in[0]; const float* mod = (const float*)(a.ws + WS_MOD); bf16* h = (bf16*)(a.ws + WS_H2);
    const int lane = threadIdx.x & 63, wid = threadIdx.x >> 6, n0 = 16 * lane;
    const int rows_per = (T + G - 1) / G, mbeg = blockIdx.x * rows_per, mend = min(T, mbeg + rows_per);
    int cur_b = -1; f32x4 sc4[4], sh4[4];
    for (int m = mbeg + wid; m < mend; m += NWAVES) {
        const int bb = m >> 12; const float* xr = x + (size_t)m * DM + n0;
        if (bb != cur_b) { cur_b = bb;
#pragma unroll
            for (int q = 0; q < 4; ++q) { sc4[q] = *(const f32x4*)(mod + bb * 6144 + 1024 + n0 + 4 * q) + 1.0f; sh4[q] = *(const f32x4*)(mod + bb * 6144 + n0 + 4 * q); } }
        f32x4 v[4];
#pragma unroll
        for (int q = 0; q < 4; ++q) v[q] = *(const f32x4*)(xr + 4 * q) * sc4[q] + sh4[q];
        store8_bf16(h + (size_t)m * DM + n0, v[0], v[1]); store8_bf16(h + (size_t)m * DM + n0 + 8, v[2], v[3]);
    }
}

struct SchedProj {
    XcdSplit xs; unsigned A, Bt;
    __device__ __forceinline__ bool next(int i, pg::Unit& u) const {
        int idx; if (!xs.unit(i, idx)) return false; int pm, pn; dense_pmpn(idx, 7, pm, pn);
        u.a = A + (unsigned)pm * 256 * 2048; u.r0 = pm * 256; u.c = pn; u.aux = 0; u.nv = 0;
        if (pn < 3) { u.b0 = Bt + (unsigned)(256 * pn) * 2048; u.b1 = u.b0 + 128 * 2048; }
        else { const int j = pn - 3; u.b0 = Bt + (unsigned)(768 + 128 * j) * 2048; u.b1 = Bt + (unsigned)(1280 + 128 * j) * 2048; }
        return true; }
    __device__ __forceinline__ int row(const pg::Unit&, int) const { return 0; }
};
struct EpiProj {
    static constexpr int NST = 8;
    bf16* O;
    __device__ __forceinline__ void operator()(const acc_t& acc, const pg::Unit& u, int wr, int wc, int fr, int fq) const {
        const int row0 = u.r0 + wr * 64 + fr;
        if (u.c < 3) {
#pragma unroll
            for (int ai = 0; ai < 2; ++ai)
#pragma unroll
                for (int m = 0; m < 4; ++m) { bf16* rowp = O + (size_t)(row0 + ai * 128 + m * 16) * QW + 256 * u.c + wc * 32 + 8 * fq;
#pragma unroll
                    for (int bj = 0; bj < 2; ++bj) store8_bf16(rowp + bj * 128, acc[ai][bj][m][0], acc[ai][bj][m][1]); }
        } else {
            const int j = u.c - 3;
#pragma unroll
            for (int ai = 0; ai < 2; ++ai)
#pragma unroll
                for (int m = 0; m < 4; ++m) { bf16* rowp = O + (size_t)(row0 + ai * 128 + m * 16) * QW + 768 + 128 * j + wc * 32 + 8 * fq;
                    f32x4 r0, r1;
#pragma unroll
                    for (int q = 0; q < 4; ++q) { r0[q] = acc[ai][0][m][0][q] * sigmoidf_(acc[ai][1][m][0][q]); r1[q] = acc[ai][0][m][1][q] * sigmoidf_(acc[ai][1][m][1][q]); }
                    store8_bf16(rowp, r0, r1); }
        }
    }
};
__device__ __forceinline__ void phase_proj(const Args& a, unsigned char* lds, int G) {
    SchedProj S{XcdSplit{(T / 256) * 7, G, (int)blockIdx.x}, (unsigned)WS_H2, (unsigned)WS_WINT};
    EpiProj E{(bf16*)(a.ws + WS_QKVG)};
    pg::gemm_phase<EpiProj, SchedProj, false>((LAS unsigned char*)lds, a.ws, DM * 2, S, E);
    transpose_filler(a, lds, G, 0);
}

constexpr int VT_STRIDE = 280;
__device__ __forceinline__ void attn_unit(const Args& a, unsigned char* lds, int unit) {
    const bf16* QK = (const bf16*)(a.ws + WS_QKVG); bf16* AC = (bf16*)(a.ws + WS_AC);
    const int tid = threadIdx.x, lane = tid & 63, w = __builtin_amdgcn_readfirstlane(tid >> 6), fr = lane & 15, fq = lane >> 4;
    const int kh = unit & 1, nblk = (unit >> 1) & 31, b = unit >> 6;
    const int tok0 = b * SEQ + nblk * 128;
    unsigned char* Kl = lds;
    bf16* Vt = (bf16*)(lds + 272 * 128);
    __syncthreads();
#pragma unroll 1
    for (int idx = tid; idx < 272 * 8; idx += NTHREADS) {
        const int key = idx >> 3, c = idx & 7;
        u32x4 kv = (u32x4){0u, 0u, 0u, 0u}, vv = (u32x4){0u, 0u, 0u, 0u};
        if (key < 256 && (nblk > 0 || key >= 128)) {
            const bf16* rowp = QK + (size_t)(tok0 - 128 + key) * QW + 512 + 64 * kh + 8 * c;
            kv = *(const u32x4*)rowp; vv = *(const u32x4*)(rowp + 128);
        }
        *(u32x4*)(Kl + key * 128 + ((c ^ (key & 7)) * 16)) = kv;
        bf16* vp = Vt + (8 * c) * VT_STRIDE + key;
        vp[0] = (bf16)(vv.x & 0xffffu); vp[VT_STRIDE] = (bf16)(vv.x >> 16);
        vp[2 * VT_STRIDE] = (bf16)(vv.y & 0xffffu); vp[3 * VT_STRIDE] = (bf16)(vv.y >> 16);
        vp[4 * VT_STRIDE] = (bf16)(vv.z & 0xffffu); vp[5 * VT_STRIDE] = (bf16)(vv.z >> 16);
        vp[6 * VT_STRIDE] = (bf16)(vv.w & 0xffffu); vp[7 * VT_STRIDE] = (bf16)(vv.w >> 16);
    }
    __syncthreads();
    const float* sinks = a.in[5];
#pragma unroll 1
    for (int g = 0; g < 4; ++g) {
        const int h = kh * 4 + g;
        int lofs = 0; asm volatile("" : "+v"(lofs));
        const float slope = exp2f(-(float)(h + 1)), sink = sinks[h];
        const bf16* qp = QK + (size_t)(tok0 + 16 * w + fr) * QW + 64 * h + 8 * fq;
        const bf16x8 q0 = *(const bf16x8*)qp, q1 = *(const bf16x8*)(qp + 32);
        f32x4 st[10];
#pragma unroll
        for (int i = 0; i < 10; ++i) {
            const int key = 16 * (w + i) + fr;
            const unsigned char* kp = Kl + key * 128 + lofs;
            const bf16x8 k0 = *(const bf16x8*)(kp + ((fq ^ (fr & 7)) * 16)), k1 = *(const bf16x8*)(kp + (((fq + 4) ^ (fr & 7)) * 16));
            f32x4 s = (f32x4){0.f, 0.f, 0.f, 0.f};
            s = __builtin_amdgcn_mfma_f32_16x16x32_bf16(k0, q0, s, 0, 0, 0);
            s = __builtin_amdgcn_mfma_f32_16x16x32_bf16(k1, q1, s, 0, 0, 0);
            st[i] = s;
        }
        float mx = -INFINITY;
#pragma unroll
        for (int i = 0; i < 10; ++i)
#pragma unroll
            for (int r = 0; r < 4; ++r) {
                const int dist = 128 + fr - 16 * i - 4 * fq - r;
                const int kj = 16 * (w + i) + 4 * fq + r;
                const bool valid = (dist >= 0) && (dist < 128) && (nblk > 0 || kj >= 128);
                const float s = valid ? (st[i][r] * 0.125f - slope * (float)dist) : -INFINITY;
                st[i][r] = s; mx = fmaxf(mx, s);
            }
        mx = fmaxf(mx, __shfl_xor(mx, 16)); mx = fmaxf(mx, __shfl_xor(mx, 32));
        mx = fmaxf(mx, sink);
        float sum = 0.f;
#pragma unroll
        for (int i = 0; i < 10; ++i)
#pragma unroll
            for (int r = 0; r < 4; ++r) { const float p = __expf(st[i][r] - mx); st[i][r] = p; sum += p; }
        sum += __shfl_xor(sum, 16); sum += __shfl_xor(sum, 32);
        const float inv = 1.0f / (sum + __expf(sink - mx));
        f32x4 o[4];
#pragma unroll
        for (int nt = 0; nt < 4; ++nt) o[nt] = (f32x4){0.f, 0.f, 0.f, 0.f};
#pragma unroll
        for (int s5 = 0; s5 < 5; ++s5) {
            u32x4 pw; pw.x = pk2(st[2 * s5][0], st[2 * s5][1]); pw.y = pk2(st[2 * s5][2], st[2 * s5][3]); pw.z = pk2(st[2 * s5 + 1][0], st[2 * s5 + 1][1]); pw.w = pk2(st[2 * s5 + 1][2], st[2 * s5 + 1][3]);
            const bf16x8 pf = __builtin_bit_cast(bf16x8, pw);
#pragma unroll
            for (int nt = 0; nt < 4; ++nt) {
                const bf16* vp = Vt + (16 * nt + fr) * VT_STRIDE + 16 * (w + 2 * s5) + 4 * fq + lofs;
                const u32x2 va = *(const u32x2*)vp, vb = *(const u32x2*)(vp + 16);
                u32x4 vw; vw.x = va.x; vw.y = va.y; vw.z = vb.x; vw.w = vb.y;
                o[nt] = __builtin_amdgcn_mfma_f32_16x16x32_bf16(__builtin_bit_cast(bf16x8, vw), pf, o[nt], 0, 0, 0);
            }
        }
        bf16* op = AC + (size_t)(tok0 + 16 * w + fr) * DM + 64 * h + 4 * fq;
#pragma unroll
        for (int nt = 0; nt < 4; ++nt) { u32x2 ow; ow.x = pk2(o[nt][0] * inv, o[nt][1] * inv); ow.y = pk2(o[nt][2] * inv, o[nt][3] * inv); *(u32x2*)(op + 16 * nt) = ow; }
    }
}

typedef float f32x2c __attribute__((ext_vector_type(2)));
__device__ __forceinline__ void conv_prefetch(const bf16* QK, int unit, int tid, u32x4 (&pf)[8]) {
    const int t0 = unit * 32, b = t0 >> 12, s0 = t0 & 4095;
#pragma unroll
    for (int q = 0; q < 8; ++q) {
        const int idx = tid + q * NTHREADS, i = idx >> 6, ch = idx & 63, sq = s0 - 30 + i;
        pf[q] = (u32x4){0u, 0u, 0u, 0u};
        if (i < 62 && sq >= 0) pf[q] = *(const u32x4*)(QK + (size_t)(b * SEQ + sq) * QW + 768 + 8 * ch);
    }
}
__device__ __forceinline__ void phase_conv(const Args& a, unsigned char* lds, int G) {
    const bf16* QK = (const bf16*)(a.ws + WS_QKVG); bf16* AC = (bf16*)(a.ws + WS_AC);
    const int tid = threadIdx.x, lane = tid & 63, wid = tid >> 6, c = tid;
    bf16* inp = (bf16*)lds;
    float* yb = (float*)(lds + 62 * CW * 2);
    const float* cw = a.in[6];
    f32x2c W2[32];
#pragma unroll
    for (int idx = 0; idx < 32; ++idx) {
        const float lo = (idx >= 1) ? cw[(31 - idx) * CW + c] : 0.f;
        const float hi = (idx <= 30) ? cw[(30 - idx) * CW + c] : 0.f;
        W2[idx] = (f32x2c){lo, hi};
    }
    const float bias = a.in[7][c];
    const float* lg = a.in[8]; const float* lb = a.in[9];
    const f32x4 g0 = *(const f32x4*)(lg + 8 * lane), g1 = *(const f32x4*)(lg + 8 * lane + 4), b0 = *(const f32x4*)(lb + 8 * lane), b1 = *(const f32x4*)(lb + 8 * lane + 4);
    u32x4 pf[8];
    int unit = blockIdx.x;
    if (unit < T / 32) conv_prefetch(QK, unit, tid, pf);
    for (; unit < T / 32; unit += G) {
        const int t0 = unit * 32;
        __syncthreads();
#pragma unroll
        for (int q = 0; q < 8; ++q) { const int idx = tid + q * NTHREADS, i = idx >> 6, ch = idx & 63; if (i < 62) *(u32x4*)(inp + i * CW + 8 * ch) = pf[q]; }
        __syncthreads();
        if (unit + G < T / 32) conv_prefetch(QK, unit + G, tid, pf);
        f32x2c acc[16];
#pragma unroll
        for (int tp = 0; tp < 16; ++tp) acc[tp] = (f32x2c){bias, bias};
#pragma unroll
        for (int i = 0; i < 62; ++i) {
            const float v = bf2f(inp[i * CW + c]); const f32x2c v2 = (f32x2c){v, v};
#pragma unroll
            for (int tp = 0; tp < 16; ++tp) { const int idx = 31 - i + 2 * tp;
                if (idx >= 0 && idx <= 31) acc[tp] = __builtin_elementwise_fma(v2, W2[idx], acc[tp]); }
        }
#pragma unroll
        for (int tp = 0; tp < 16; ++tp) { yb[(2 * tp) * CW + c] = acc[tp].x; yb[(2 * tp + 1) * CW + c] = acc[tp].y; }
        __syncthreads();
#pragma unroll
        for (int q = 0; q < 4; ++q) {
            const int t = wid * 4 + q;
            f32x4 v0 = *(const f32x4*)(yb + t * CW + 8 * lane), v1 = *(const f32x4*)(yb + t * CW + 8 * lane + 4);
            const float mean = wave_sum((v0[0] + v0[1]) + (v0[2] + v0[3]) + (v1[0] + v1[1]) + (v1[2] + v1[3])) * (1.0f / CW);
            v0 = v0 - mean; v1 = v1 - mean;
            const float var = wave_sum((v0[0] * v0[0] + v0[1] * v0[1]) + (v0[2] * v0[2] + v0[3] * v0[3]) + (v1[0] * v1[0] + v1[1] * v1[1]) + (v1[2] * v1[2] + v1[3] * v1[3])) * (1.0f / CW);
            const float rstd = rsqrtf(var + LN_EPS);
            f32x4 r0 = v0 * rstd * g0 + b0, r1 = v1 * rstd * g1 + b1;
#pragma unroll
            for (int e = 0; e < 4; ++e) { r0[e] = siluf_(r0[e]); r1[e] = siluf_(r1[e]); }
            store8_bf16(AC + (size_t)(t0 + t) * DM + 512 + 8 * lane, r0, r1);
        }
    }
}

__device__ __forceinline__ void phase_mixer(const Args& a, unsigned char* lds, int G) {
    if (!(a.flags & 2)) for (int u = blockIdx.x; u < NB * 32 * NKVH; u += G) attn_unit(a, lds, u);
    if (!(a.flags & 4)) phase_conv(a, lds, G);
}

struct SchedWo {
    XcdSplit xs; unsigned A, Bt;
    __device__ __forceinline__ bool next(int i, pg::Unit& u) const {
        int idx; if (!xs.unit(i, idx)) return false; int pm, pn; dense_pmpn(idx, 4, pm, pn);
        u.a = A + (unsigned)pm * 256 * 2048; u.r0 = pm * 256; u.c = pn; u.aux = 0; u.nv = 0;
        u.b0 = Bt + (unsigned)(256 * pn) * 2048; u.b1 = u.b0 + 128 * 2048; return true; }
    __device__ __forceinline__ int row(const pg::Unit&, int) const { return 0; }
};
struct EpiWo {
    static constexpr int NST = 16;
    const float* mod; bf16* mix;
    __device__ __forceinline__ void operator()(const acc_t& acc, const pg::Unit& u, int wr, int wc, int fr, int fq) const {
        const int row0 = u.r0 + wr * 64 + fr, bb = u.r0 >> 12, col0 = 256 * u.c + wc * 32 + 8 * fq;
        f32x4 g[2][2];
#pragma unroll
        for (int bj = 0; bj < 2; ++bj)
#pragma unroll
            for (int n = 0; n < 2; ++n) g[bj][n] = *(const f32x4*)(mod + bb * 6144 + 2048 + col0 + 128 * bj + 4 * n) + 1.0f;
#pragma unroll
        for (int ai = 0; ai < 2; ++ai)
#pragma unroll
            for (int m = 0; m < 4; ++m) { bf16* rowp = mix + (size_t)(row0 + ai * 128 + m * 16) * DM + col0;
#pragma unroll
                for (int bj = 0; bj < 2; ++bj) store8_bf16(rowp + 128 * bj, g[bj][0] * acc[ai][bj][m][0], g[bj][1] * acc[ai][bj][m][1]); }
    }
};
__device__ __forceinline__ void phase_wo(const Args& a, unsigned char* lds, int G) {
    SchedWo S{XcdSplit{(T / 256) * 4, G, (int)blockIdx.x}, (unsigned)WS_AC, (unsigned)WS_WOT};
    EpiWo E{(const float*)(a.ws + WS_MOD), (bf16*)(a.ws + WS_MIX)};
    pg::gemm_phase<EpiWo, SchedWo, false>((LAS unsigned char*)lds, a.ws, DM * 2, S, E);
}

__device__ __forceinline__ void phase_ln1(const Args& a, int G) {
    const float* mod = (const float*)(a.ws + WS_MOD); const float* x = a.in[0]; const bf16* mix = (const bf16*)(a.ws + WS_MIX);
    bf16* x1b = (bf16*)(a.ws + WS_X1B); bf16* h2 = (bf16*)(a.ws + WS_H2); unsigned char* h2q = a.ws + WS_H2Q;
    const float* lg = a.in[11]; const float* lb = a.in[12];
    const int lane = threadIdx.x & 63, wid = threadIdx.x >> 6, n0 = 16 * lane;
    f32x4 g4[4], b4[4];
#pragma unroll
    for (int q = 0; q < 4; ++q) { g4[q] = *(const f32x4*)(lg + n0 + 4 * q); b4[q] = *(const f32x4*)(lb + n0 + 4 * q); }
    const int rows_per = (T + G - 1) / G, mbeg = blockIdx.x * rows_per, mend = min(T, mbeg + rows_per);
    int cur_b = -1; f32x4 sc4[4], sh4[4];
    for (int m = mbeg + wid; m < mend; m += NWAVES) {
        const int bb = m >> 12; const float* xr = x + (size_t)m * DM + n0;
        if (bb != cur_b) { cur_b = bb;
#pragma unroll
            for (int q = 0; q < 4; ++q) { sc4[q] = *(const f32x4*)(mod + bb * 6144 + 4096 + n0 + 4 * q) + 1.0f; sh4[q] = *(const f32x4*)(mod + bb * 6144 + 3072 + n0 + 4 * q); } }
        const u32x4 ma = *(const u32x4*)(mix + (size_t)m * DM + n0), mb = *(const u32x4*)(mix + (size_t)m * DM + n0 + 8);
        f32x4 v[4]; float s = 0.f;
#pragma unroll
        for (int q = 0; q < 4; ++q) { const unsigned w0 = (q < 2) ? ma[2 * q] : mb[2 * q - 4], w1 = (q < 2) ? ma[2 * q + 1] : mb[2 * q - 3];
            v[q] = *(const f32x4*)(xr + 4 * q) * ALPHA + (f32x4){bflo(w0), bfhi(w0), bflo(w1), bfhi(w1)}; s += (v[q][0] + v[q][1]) + (v[q][2] + v[q][3]); }
        const float mean = wave_sum(s) * (1.0f / DM); float s2 = 0.f;
#pragma unroll
        for (int q = 0; q < 4; ++q) { v[q] = v[q] - mean; s2 += (v[q][0] * v[q][0] + v[q][1] * v[q][1]) + (v[q][2] * v[q][2] + v[q][3] * v[q][3]); }
        const float rstd = rsqrtf(wave_sum(s2) * (1.0f / DM) + LN_EPS);
        u32x4 xo[2], ho[2], qo;
#pragma unroll
        for (int q = 0; q < 4; ++q) {
            const f32x4 x1 = v[q] * rstd * g4[q] + b4[q];
            const f32x4 hh = x1 * sc4[q] + sh4[q];
            xo[q >> 1][2 * (q & 1)] = pk2(x1[0], x1[1]); xo[q >> 1][2 * (q & 1) + 1] = pk2(x1[2], x1[3]);
            ho[q >> 1][2 * (q & 1)] = pk2(hh[0], hh[1]); ho[q >> 1][2 * (q & 1) + 1] = pk2(hh[2], hh[3]);
            qo[q] = pk4_fp8(hh, 1.0f);
        }
        *(u32x4*)(x1b + (size_t)m * DM + n0) = xo[0]; *(u32x4*)(x1b + (size_t)m * DM + n0 + 8) = xo[1];
        *(u32x4*)(h2 + (size_t)m * DM + n0) = ho[0]; *(u32x4*)(h2 + (size_t)m * DM + n0 + 8) = ho[1];
        *(u32x4*)(h2q + (size_t)m * DM + n0) = qo;
    }
}

struct SchedRs {
    XcdSplit xs; unsigned A, Bt;
    __device__ __forceinline__ bool next(int i, pg::Unit& u) const {
        int idx; if (!xs.unit(i, idx)) return false; int pm, pn; dense_pmpn(idx, 3, pm, pn);
        u.a = A + (unsigned)pm * 256 * 2048; u.r0 = pm * 256; u.c = pn; u.aux = 0; u.nv = 0;
        if (pn == 0) { u.b0 = Bt; u.b1 = Bt + 128 * 2048; }
        else { const int j = pn - 1; u.b0 = Bt + (unsigned)(256 + 128 * j) * 2048; u.b1 = Bt + (unsigned)(512 + 128 * j) * 2048; }
        return true; }
    __device__ __forceinline__ int row(const pg::Unit&, int) const { return 0; }
};
struct EpiRs {
    static constexpr int NST = 8;
    float* logits; bf16* hs;
    __device__ __forceinline__ void operator()(const acc_t& acc, const pg::Unit& u, int wr, int wc, int fr, int fq) const {
        const int row0 = u.r0 + wr * 64 + fr;
        if (u.c == 0) {
#pragma unroll
            for (int ai = 0; ai < 2; ++ai)
#pragma unroll
                for (int m = 0; m < 4; ++m) { float* rowp = logits + (size_t)(row0 + ai * 128 + m * 16) * NE + wc * 32 + 8 * fq;
#pragma unroll
                    for (int bj = 0; bj < 2; ++bj) { *(f32x4*)(rowp + 128 * bj) = acc[ai][bj][m][0]; *(f32x4*)(rowp + 128 * bj + 4) = acc[ai][bj][m][1]; } }
        } else {
            const int j = u.c - 1;
#pragma unroll
            for (int ai = 0; ai < 2; ++ai)
#pragma unroll
                for (int m = 0; m < 4; ++m) { bf16* rowp = hs + (size_t)(row0 + ai * 128 + m * 16) * FE + 128 * j + wc * 32 + 8 * fq;
                    f32x4 r0, r1;
#pragma unroll
                    for (int q = 0; q < 4; ++q) { r0[q] = siluf_(acc[ai][0][m][0][q]) * acc[ai][1][m][0][q]; r1[q] = siluf_(acc[ai][0][m][1][q]) * acc[ai][1][m][1][q]; }
                    store8_bf16(rowp, r0, r1); }
        }
    }
};
__device__ __forceinline__ void phase_rs(const Args& a, unsigned char* lds, int G) {
    SchedRs S{XcdSplit{(T / 256) * 3, G, (int)blockIdx.x}, (unsigned)WS_H2, (unsigned)WS_WCAT};
    EpiRs E{(float*)(a.ws + WS_LOG), (bf16*)(a.ws + WS_HS)};
    pg::gemm_phase<EpiRs, SchedRs, false>((LAS unsigned char*)lds, a.ws, DM * 2, S, E);
    transpose_filler(a, lds, G, 1);
}

#define DPPF(v, ctrl) __int_as_float(__builtin_amdgcn_update_dpp(0, __float_as_int(v), (ctrl), 0xf, 0xf, true))
__device__ __forceinline__ float wave_max_dpp(float v) {
    v = fmaxf(v, DPPF(v, 0xB1)); v = fmaxf(v, DPPF(v, 0x4E)); v = fmaxf(v, DPPF(v, 0x141)); v = fmaxf(v, DPPF(v, 0x140));
    const float r0 = __int_as_float(__builtin_amdgcn_readlane(__float_as_int(v), 0)), r1 = __int_as_float(__builtin_amdgcn_readlane(__float_as_int(v), 16));
    const float r2 = __int_as_float(__builtin_amdgcn_readlane(__float_as_int(v), 32)), r3 = __int_as_float(__builtin_amdgcn_readlane(__float_as_int(v), 48));
    return fmaxf(fmaxf(r0, r1), fmaxf(r2, r3));
}
__device__ __forceinline__ void phase_route(const Args& a, unsigned char* lds, int G) {
    const float* logits = (const float*)(a.ws + WS_LOG); const float* rbias = a.in[14];
    int* gcount = (int*)(a.ws + WS_GCNT); int* rdst = (int*)(a.ws + WS_RDST); float* ew = (float*)(a.ws + WS_EW); int* rer = (int*)(a.ws + WS_RER);
    const int tid = threadIdx.x, lane = tid & 63, wid = tid >> 6;
    int* hist = (int*)lds; int* base = hist + 256; int* pe = hist + 512; float* pw = (float*)(hist + 512 + 2048);
    __syncthreads();
    if (tid < NE) hist[tid] = 0;
    __syncthreads();
    const int chunk = (T + G - 1) / G, tbeg = blockIdx.x * chunk, tend = min(T, tbeg + chunk);
    const f32x4 bv = *(const f32x4*)(rbias + 4 * lane);
    f32x4 lgn = (f32x4){0.f, 0.f, 0.f, 0.f};
    if (tbeg + wid < tend) lgn = *(const f32x4*)(logits + (size_t)(tbeg + wid) * NE + 4 * lane);
    for (int t = tbeg + wid; t < tend; t += NWAVES) {
        const f32x4 lg = lgn;
        if (t + NWAVES < tend) lgn = *(const f32x4*)(logits + (size_t)(t + NWAVES) * NE + 4 * lane);
        float sc[4], v[4];
#pragma unroll
        for (int i = 0; i < 4; ++i) { sc[i] = sigmoidf_ref(lg[i]); v[i] = sc[i] + bv[i]; }
        float a1 = fmaxf(v[0], v[1]), a2 = fminf(v[0], v[1]);
        { const float c1 = fmaxf(v[2], v[3]), c2 = fminf(v[2], v[3]); const float n1 = fmaxf(a1, c1), n2 = fmaxf(fminf(a1, c1), fmaxf(a2, c2)); a1 = n1; a2 = n2; }
        { const float c1 = DPPF(a1, 0xB1), c2 = DPPF(a2, 0xB1); const float n1 = fmaxf(a1, c1), n2 = fmaxf(fminf(a1, c1), fmaxf(a2, c2)); a1 = n1; a2 = n2; }
        { const float c1 = DPPF(a1, 0x4E), c2 = DPPF(a2, 0x4E); const float n1 = fmaxf(a1, c1), n2 = fmaxf(fminf(a1, c1), fmaxf(a2, c2)); a1 = n1; a2 = n2; }
        { const float c1 = DPPF(a1, 0x141), c2 = DPPF(a2, 0x141); const float n1 = fmaxf(a1, c1), n2 = fmaxf(fminf(a1, c1), fmaxf(a2, c2)); a1 = n1; a2 = n2; }
        const float gs = a1 + a2; const int mg = lane >> 3; int rank = 0;
#pragma unroll
        for (int g = 0; g < 8; ++g) { const float o = __int_as_float(__builtin_amdgcn_readlane(__float_as_int(gs), 8 * g)); rank += (o > gs || (o == gs && g < mg)) ? 1 : 0; }
        if (rank >= 4) { v[0] = -INFINITY; v[1] = -INFINITY; v[2] = -INFINITY; v[3] = -INFINITY; }
        int my_e = 0; float my_w = 0.f, wsum = 0.f;
#pragma unroll
        for (int r = 0; r < TOPK; ++r) {
            const float m = fmaxf(fmaxf(v[0], v[1]), fmaxf(v[2], v[3]));
            const float M = wave_max_dpp(m);
            const unsigned long long mask = __ballot(m == M);
            const int L = __builtin_amdgcn_readfirstlane((int)__builtin_ctzll(mask));
            const int li = (v[0] == M) ? 0 : (v[1] == M) ? 1 : (v[2] == M) ? 2 : 3;
            const float ls = (li == 0) ? sc[0] : (li == 1) ? sc[1] : (li == 2) ? sc[2] : sc[3];
            const int wi = __builtin_amdgcn_readlane(li, L);
            const float wv = __int_as_float(__builtin_amdgcn_readlane(__float_as_int(ls), L));
            if (lane == L) { if (li == 0) v[0] = -INFINITY; else if (li == 1) v[1] = -INFINITY; else if (li == 2) v[2] = -INFINITY; else v[3] = -INFINITY; }
            wsum += wv;
            if (lane == r) { my_e = 4 * L + wi; my_w = wv; }
        }
        if (lane < TOPK) {
            const int p = (t - tbeg) * TOPK + lane;
            pe[p] = my_e; pw[p] = my_w / wsum * 2.5f;
            atomicAdd(&hist[my_e], 1);
        }
    }
    __syncthreads();
    if (tid < NE) { const int h = hist[tid]; base[tid] = h ? __hip_atomic_fetch_add(&gcount[tid], h, __ATOMIC_RELAXED, __HIP_MEMORY_SCOPE_AGENT) : 0; hist[tid] = 0; }
    __syncthreads();
    const int np = (tend - tbeg) * TOPK;
    for (int i = tid; i < np; i += NTHREADS) {
        const int e = pe[i];
        const int r = base[e] + atomicAdd(&hist[e], 1);
        rdst[(size_t)e * RCAP + r] = tbeg * TOPK + i; ew[tbeg * TOPK + i] = pw[i]; rer[tbeg * TOPK + i] = (e << 16) | r;
    }
}

__device__ __forceinline__ int moe_prefix(const int* gcount, int* pref, int* scr) {
    const int tid = threadIdx.x;
    __syncthreads();
    int nt_e = 0;
    if (tid < NE) { nt_e = (gcount[tid] + 255) >> 8; scr[tid] = nt_e; }
    __syncthreads();
    int cur = 0;
    for (int o = 1; o < NE; o <<= 1) {
        if (tid < NE) scr[(cur ^ 1) * 256 + tid] = scr[cur * 256 + tid] + ((tid >= o) ? scr[cur * 256 + tid - o] : 0);
        cur ^= 1;
        __syncthreads();
    }
    if (tid < NE) { const int incl = scr[cur * 256 + tid]; pref[tid] = incl - nt_e; if (tid == NE - 1) pref[NE] = incl; }
    __syncthreads();
    return pref[NE];
}
__device__ __forceinline__ int moe_tile_expert(const int* pref, int tile) {
    int lo = 0, hi = NE - 1;
    while (lo < hi) { const int mid = (lo + hi + 1) >> 1; if (pref[mid] <= tile) lo = mid; else hi = mid - 1; }
    return lo;
}

constexpr int LIST_OFF = pg::PG_STAGE_BYTES, MAX_LISTS = 12, PREF_OFF = LIST_OFF + MAX_LISTS * 1024, DESC_OFF = PREF_OFF + 1040, MAX_DESC = 48;
struct SchedMoe1 {
    XcdSplit xs; unsigned A, Wg, Wu; const int* desc; const int* lists;
    __device__ __forceinline__ bool next(int i, pg::Unit& u) const {
        int idx; if (!xs.unit(i, idx)) return false; const int e = __builtin_amdgcn_readfirstlane(desc[2 * i]), tile = idx >> 1, j = idx & 1;
        u.a = A; u.r0 = tile * 256; u.c = j; u.aux = i; u.nv = 0;
        u.b0 = Wg + (unsigned)(e * 256 + 128 * j) * 1024; u.b1 = Wu + (unsigned)(e * 256 + 128 * j) * 1024; return true; }
    __device__ __forceinline__ int row(const pg::Unit& u, int r) const { return lists[u.aux * 256 + r]; }
};
struct EpiMoe1 {
    static constexpr int NST = 8;
    unsigned char* H8;
    __device__ __forceinline__ void operator()(const acc_t& acc, const pg::Unit& u, int wr, int wc, int fr, int fq) const {
        const int row0 = u.r0 + wr * 64 + fr;
#pragma unroll
        for (int ai = 0; ai < 2; ++ai)
#pragma unroll
            for (int m = 0; m < 4; ++m) { unsigned char* rowp = H8 + (size_t)(row0 + ai * 128 + m * 16) * FE + 128 * u.c + wc * 32 + 8 * fq;
                f32x4 r0, r1;
#pragma unroll
                for (int q = 0; q < 4; ++q) { r0[q] = siluf_(acc[ai][0][m][0][q]) * acc[ai][1][m][0][q]; r1[q] = siluf_(acc[ai][0][m][1][q]) * acc[ai][1][m][1][q]; }
                u32x2 o; o.x = pk4_fp8(r0, H8_SCALE); o.y = pk4_fp8(r1, H8_SCALE); *(u32x2*)rowp = o; }
    }
};
__device__ __forceinline__ void phase_moe1(const Args& a, unsigned char* lds, int G) {
    const int* gcount = (const int*)(a.ws + WS_GCNT); const int* rdst = (const int*)(a.ws + WS_RDST);
    int* lists = (int*)(lds + LIST_OFF); int* pref = (int*)(lds + PREF_OFF); int* desc = (int*)(lds + DESC_OFF);
    const int ntiles = moe_prefix(gcount, pref, (int*)lds);
    XcdSplit xs{ntiles * 2, G, (int)blockIdx.x};
    for (int i = 0; i < MAX_LISTS; ++i) {
        int idx; if (!xs.unit(i, idx)) break;
        const int tile = idx >> 1, e = moe_tile_expert(pref, tile), tin = tile - pref[e], cnt = gcount[e];
        if (threadIdx.x < 256) { const int pos = tin * 256 + (int)threadIdx.x; lists[i * 256 + threadIdx.x] = (pos < cnt) ? (rdst[(size_t)e * RCAP + pos] >> 3) : 0; }
        if (threadIdx.x == 0) { desc[2 * i] = e; desc[2 * i + 1] = tin; }
    }
    __syncthreads();
    SchedMoe1 S{xs, (unsigned)WS_H2Q, (unsigned)WS_WGT8, (unsigned)WS_WUT8, desc, lists};
    EpiMoe1 E{a.ws + WS_H8};
    pg::gemm_phase<EpiMoe1, SchedMoe1, true, 0, true, 122, 127>((LAS unsigned char*)lds, a.ws, DM, S, E);
}

struct SchedMoe2 {
    XcdSplit xs; unsigned Hb, Wd; const int* desc;
    __device__ __forceinline__ bool next(int i, pg::Unit& u) const {
        int idx; if (!xs.unit(i, idx)) return false;
        const int tile = idx >> 2, jn = idx & 3, e = __builtin_amdgcn_readfirstlane(desc[2 * i]), nv = __builtin_amdgcn_readfirstlane(desc[2 * i + 1]);
        u.a = Hb + (unsigned)tile * 256 * 256; u.r0 = tile * 256; u.c = jn; u.aux = e; u.nv = nv;
        u.b0 = Wd + (unsigned)(e * 1024 + 256 * jn) * 256; u.b1 = u.b0 + 8 * 256;
        return true; }
    __device__ __forceinline__ int row(const pg::Unit&, int) const { return 0; }
};
struct SchedSd {
    XcdSplit xs; unsigned hs, Wds;
    __device__ __forceinline__ bool next(int i, pg::Unit& u) const {
        int idx; if (!xs.unit(i, idx)) return false; int pm, pn; dense_pmpn(idx, 4, pm, pn);
        u.a = hs + (unsigned)pm * 256 * 512; u.r0 = pm * 256; u.c = pn; u.aux = -1; u.nv = 0;
        u.b0 = Wds + (unsigned)(256 * pn) * 512; u.b1 = u.b0 + 8 * 512;
        return true; }
    __device__ __forceinline__ int row(const pg::Unit&, int) const { return 0; }
};
struct EpiMoe2 {
    static constexpr int NST = 0;
    unsigned char* Y; bf16* SD; int flags;
    __device__ __forceinline__ void operator()(const acc_t& acc, const pg::Unit& u, int wr, int wc, int fr, int fq) const {
        const int col0 = 256 * u.c + wc * 64 + 16 * fq, row0 = u.r0 + wr * 64 + fr;
        if (u.aux >= 0) {
#pragma unroll
            for (int ai = 0; ai < 2; ++ai)
#pragma unroll
                for (int m = 0; m < 4; ++m) {
                    u32x4 o; o.x = pk4_fp8(acc[ai][0][m][0], Y_SCALE); o.y = pk4_fp8(acc[ai][0][m][1], Y_SCALE); o.z = pk4_fp8(acc[ai][1][m][0], Y_SCALE); o.w = pk4_fp8(acc[ai][1][m][1], Y_SCALE);
                    if (!(flags & 1) && (wr * 64 + fr + ai * 128 + m * 16) < u.nv) *(u32x4*)(Y + (size_t)(row0 + ai * 128 + m * 16) * DM + col0) = o; }
        } else {
#pragma unroll
            for (int ai = 0; ai < 2; ++ai)
#pragma unroll
                for (int m = 0; m < 4; ++m) { bf16* rowp = SD + (size_t)(row0 + ai * 128 + m * 16) * DM + col0;
#pragma unroll
                    for (int bj = 0; bj < 2; ++bj) store8_bf16(rowp + 8 * bj, acc[ai][bj][m][0], acc[ai][bj][m][1]); }
        }
    }
};
__device__ __forceinline__ void phase_moe2(const Args& a, unsigned char* lds, int G) {
    const int* gcount = (const int*)(a.ws + WS_GCNT);
    int* pref = (int*)(lds + PREF_OFF); int* desc = (int*)(lds + DESC_OFF);
    const int ntiles = moe_prefix(gcount, pref, (int*)lds);
    const int NU2 = ntiles * 4;
    XcdSplit xs{NU2, G, (int)blockIdx.x};
    if (threadIdx.x == 0) {
        for (int i = 0; i < MAX_DESC; ++i) { int idx; if (!xs.unit(i, idx)) break;
            const int tile = idx >> 2, e = moe_tile_expert(pref, tile); desc[2 * i] = e; desc[2 * i + 1] = min(256, gcount[e] - (tile - pref[e]) * 256); }
    }
    __syncthreads();
    EpiMoe2 E{(unsigned char*)(a.ws + WS_Y), (bf16*)(a.ws + WS_SD), a.flags};
    { SchedMoe2 S{xs, (unsigned)WS_H8, (unsigned)WS_WDT8, desc};
      pg::gemm_phase<EpiMoe2, SchedMoe2, false, 1, true, 122, 124>((LAS unsigned char*)lds, a.ws, FE, S, E); }
    { SchedSd S{XcdSplit{(T / 256) * 4, G, (int)blockIdx.x}, (unsigned)WS_HS, (unsigned)WS_WDST};
      pg::gemm_phase<EpiMoe2, SchedSd, false, 1>((LAS unsigned char*)lds, a.ws, FE * 2, S, E); }
}

__device__ __forceinline__ void phase_final(const Args& a, unsigned char* lds, int G) {
    const float* mod = (const float*)(a.ws + WS_MOD); float* out = a.out;
    const bf16* SD = (const bf16*)(a.ws + WS_SD); const unsigned char* Y = (const unsigned char*)(a.ws + WS_Y); const bf16* x1b = (const bf16*)(a.ws + WS_X1B);
    const int* rer = (const int*)(a.ws + WS_RER); const float* ew = (const float*)(a.ws + WS_EW);
    const float* lg = a.in[21]; const float* lb = a.in[22];
    int* pref = (int*)(lds + PREF_OFF);
    (void)moe_prefix((const int*)(a.ws + WS_GCNT), pref, (int*)lds);
    const int lane = threadIdx.x & 63, wid = threadIdx.x >> 6, n0 = 16 * lane;
    const int rows_per = (T + G - 1) / G, mbeg = blockIdx.x * rows_per, mend = min(T, mbeg + rows_per);
    const int m0 = mbeg + wid, mstep = NWAVES;
    int nq = 0; float nw = 0.f;
    if (lane < TOPK && m0 < mend) { nq = rer[(size_t)m0 * TOPK + lane]; nw = ew[(size_t)m0 * TOPK + lane]; }
    f32x4 lg4[4], lb4[4], g24[4]; int cur_b = -1;
#pragma unroll
    for (int q = 0; q < 4; ++q) { lg4[q] = *(const f32x4*)(lg + n0 + 4 * q); lb4[q] = *(const f32x4*)(lb + n0 + 4 * q); }
    for (int m = m0; m < mend; m += mstep) {
        const int bb = m >> 12; float* rowp = out + (size_t)m * DM + n0;
        if (bb != cur_b) { cur_b = bb;
#pragma unroll
            for (int q = 0; q < 4; ++q) g24[q] = *(const f32x4*)(mod + bb * 6144 + 5120 + n0 + 4 * q) + 1.0f; }
        const int myrow = pref[nq >> 16] * 256 + (nq & 0xffff); const float myw = nw * (1.0f / Y_SCALE);
        if (lane < TOPK && m + mstep < mend) { nq = rer[(size_t)(m + mstep) * TOPK + lane]; nw = ew[(size_t)(m + mstep) * TOPK + lane]; }
        u32x4 yw[TOPK]; float wk[TOPK];
#pragma unroll
        for (int k = 0; k < TOPK; ++k) { const int r = __builtin_amdgcn_readlane(myrow, k); wk[k] = __int_as_float(__builtin_amdgcn_readlane(__float_as_int(myw), k)); yw[k] = *(const u32x4*)(Y + (size_t)r * DM + n0); }
        const u32x4 sa = *(const u32x4*)(SD + (size_t)m * DM + n0), sb = *(const u32x4*)(SD + (size_t)m * DM + n0 + 8);
        const u32x4 xa = *(const u32x4*)(x1b + (size_t)m * DM + n0), xb = *(const u32x4*)(x1b + (size_t)m * DM + n0 + 8);
        f32x4 f[4];
#pragma unroll
        for (int q = 0; q < 4; ++q) f[q] = (f32x4){0.f, 0.f, 0.f, 0.f};
#pragma unroll
        for (int k = 0; k < TOPK; ++k)
#pragma unroll
            for (int q = 0; q < 4; ++q) { const int w = (int)yw[k][q]; const f32x2v lo = __builtin_amdgcn_cvt_pk_f32_fp8(w, false), hi = __builtin_amdgcn_cvt_pk_f32_fp8(w, true);
                f[q][0] += wk[k] * lo.x; f[q][1] += wk[k] * lo.y; f[q][2] += wk[k] * hi.x; f[q][3] += wk[k] * hi.y; }
        f32x4 v[4]; float s = 0.f;
#pragma unroll
        for (int q = 0; q < 4; ++q) {
            const unsigned s0 = (q < 2) ? sa[2 * q] : sb[2 * q - 4], s1 = (q < 2) ? sa[2 * q + 1] : sb[2 * q - 3];
            const unsigned x0 = (q < 2) ? xa[2 * q] : xb[2 * q - 4], x1w = (q < 2) ? xa[2 * q + 1] : xb[2 * q - 3];
            const f32x4 ffn = f[q] + (f32x4){bflo(s0), bfhi(s0), bflo(s1), bfhi(s1)};
            const f32x4 x1 = (f32x4){bflo(x0), bfhi(x0), bflo(x1w), bfhi(x1w)};
            v[q] = x1 * ALPHA + g24[q] * ffn;
            s += (v[q][0] + v[q][1]) + (v[q][2] + v[q][3]);
        }
        const float mean = wave_sum(s) * (1.0f / DM); float s2 = 0.f;
#pragma unroll
        for (int q = 0; q < 4; ++q) { v[q] = v[q] - mean; s2 += (v[q][0] * v[q][0] + v[q][1] * v[q][1]) + (v[q][2] * v[q][2] + v[q][3] * v[q][3]); }
        const float rstd = rsqrtf(wave_sum(s2) * (1.0f / DM) + LN_EPS);
#pragma unroll
        for (int q = 0; q < 4; ++q) *(f32x4*)(rowp + 4 * q) = v[q] * rstd * lg4[q] + lb4[q];
    }
}

constexpr int NPHASES = 11;
__global__ void __launch_bounds__(NTHREADS, 2) fwd_kernel(Args a) {
    extern __shared__ __attribute__((aligned(16))) unsigned char lds[];
    const int G = gridDim.x;
    volatile LAS unsigned* misc = (volatile LAS unsigned*)(LAS unsigned char*)(lds + LDS_BYTES - 64);
    if (threadIdx.x < 16) misc[threadIdx.x] = 0u;
    __syncthreads();
    XcdBarrier bar; bar.bar = (unsigned*)(a.ws + WS_CTL); bar.x = 0; bar.st = nullptr;
    const bool multi = (a.ph_hi - a.ph_lo) > 1;
    if (multi) bar = xcd_barrier_post((unsigned*)(a.ws + WS_CTL), misc);
#define IN(k) (a.ph_lo <= (k) && (k) < a.ph_hi)
#define SEAM(k) do { if (IN(k) && IN((k) + 1)) xcd_barrier(bar); } while (0)
#ifndef REPEAT_MASK
#define REPEAT_MASK 0
#endif
#define REP(k, call) do { if (IN(k)) { call; if ((REPEAT_MASK >> (k)) & 1) { xcd_barrier(bar); Args a2 = a; a2.flags = PROBE_FLAGS; { const Args& a = a2; call; } } } } while (0)
#ifndef PROBE_FLAGS
#define PROBE_FLAGS 0
#endif
    REP(0, phase_prep(a, lds, G));
    SEAM(0);
    REP(1, phase_hmod(a, G));
    SEAM(1);
    REP(2, phase_proj(a, lds, G));
    SEAM(2);
    REP(3, phase_mixer(a, lds, G));
    SEAM(3);
    REP(4, phase_wo(a, lds, G));
    SEAM(4);
    REP(5, phase_ln1(a, G));
    SEAM(5);
    REP(6, phase_rs(a, lds, G));
    SEAM(6);
    REP(7, phase_route(a, lds, G));
    SEAM(7);
    REP(8, phase_moe1(a, lds, G));
    SEAM(8);
    REP(9, phase_moe2(a, lds, G));
    SEAM(9);
    REP(10, phase_final(a, lds, G));
#undef IN
#undef SEAM
}

extern "C" void kernel_launch(void* const* d_in, const int* in_sizes, int n_in, void* d_out, int out_size, void* d_ws, size_t ws_size, hipStream_t stream) {
    static int grid = 0;
    if (grid == 0) {
        if (n_in != 23 || out_size != T * DM || ws_size < WS_END) { fprintf(stderr, "kernel_launch: unexpected shapes (n_in %d out %d ws %zu)\n", n_in, out_size, ws_size); grid = -1; return; }
        int dev = 0, cus = 0;
        if (hipGetDevice(&dev) != hipSuccess || hipDeviceGetAttribute(&cus, hipDeviceAttributeMultiprocessorCount, dev) != hipSuccess) { grid = -1; return; }
        if (hipFuncSetAttribute((const void*)fwd_kernel, hipFuncAttributeMaxDynamicSharedMemorySize, LDS_BYTES) != hipSuccess) { fprintf(stderr, "kernel_launch: hipFuncSetAttribute failed\n"); grid = -1; return; }
        int per_cu = 0;
        (void)hipOccupancyMaxActiveBlocksPerMultiprocessor(&per_cu, (const void*)fwd_kernel, NTHREADS, LDS_BYTES);
        (void)hipGetLastError();
        grid = cus > 512 ? 512 : cus;
        if (per_cu < 1) fprintf(stderr, "kernel_launch: occupancy query reports %d blocks per CU\n", per_cu);
    }
    if (grid < 0) return;
    (void)hipMemsetAsync((char*)d_ws + WS_CTL, 0, CTL_ZERO_BYTES, stream);
    Args a{};
    for (int i = 0; i < 23; ++i) a.in[i] = (const float*)d_in[i];
    a.out = (float*)d_out; a.ws = (unsigned char*)d_ws;
#if N_LAUNCH_MODE == 1
    a.ph_lo = 0; a.ph_hi = NPHASES;
    hipLaunchKernelGGL(fwd_kernel, dim3(grid), dim3(NTHREADS), LDS_BYTES, stream, a);
#else
    for (int p = 0; p < NPHASES; ++p) { a.ph_lo = p; a.ph_hi = p + 1; hipLaunchKernelGGL(fwd_kernel, dim3(grid), dim3(NTHREADS), LDS_BYTES, stream, a); }
#endif
}
```
